# Optimizing an MI355X kernel written in HIP

```python
import math
import jax, jax.numpy as jnp
from jax import lax
import numpy as np

D_MODEL = 2048
BATCH = 4
SEQ = 2048
DEPTH = 4

D_MIX = D_MODEL
GROUP_W = D_MIX // 4

SSD_HEAD_DIM = 64
SSD_HEADS = GROUP_W // SSD_HEAD_DIM
SSD_NGROUPS = 2
SSD_STATE = 64
SSD_CONV = 4
SSD_CHUNK = 128
SSD_XBC = GROUP_W + 2 * SSD_NGROUPS * SSD_STATE
DT_MIN = 0.001
DT_MAX = 0.1

S5_CH = 16
S5_GROUPS = GROUP_W // S5_CH
S5_STATE = 64

GLA_HEADS = 4
GLA_DK = GROUP_W // 2 // GLA_HEADS
GLA_DV = GROUP_W // GLA_HEADS
GLA_GATE_RANK = 16
GLA_GATE_NORM = 16.0
GLA_CHUNK = 16

MLA_HEADS = 4
MLA_NOPE = 128
MLA_ROPE = 64
MLA_V = GROUP_W // MLA_HEADS
MLA_Q_RANK = 384
MLA_KV_RANK = 128
MLA_QBLOCK = 128
ROPE_THETA = 10000.0

NORM_EPS = 1e-6

IN_WIDTHS = (
    GROUP_W,
    SSD_XBC,
    SSD_HEADS,
    GROUP_W,
    GROUP_W,
    GLA_HEADS * GLA_DK,
    GLA_HEADS * GLA_DK,
    GLA_HEADS * GLA_DV,
    GROUP_W,
    GLA_GATE_RANK,
    MLA_Q_RANK,
    MLA_KV_RANK,
    MLA_ROPE,
    GROUP_W,
)
D_IN = sum(IN_WIDTHS)

kernel_name = "hybrid_ssd_s5_gla_mla_parallel_heads"


def rmsnorm(x, w):
    xf = x.astype(jnp.float32)
    xf = xf * lax.rsqrt(jnp.mean(xf * xf, axis=-1, keepdims=True) + NORM_EPS)
    return (xf * w.astype(jnp.float32)).astype(x.dtype)


def split_columns(p):
    idx = np.cumsum(np.array(IN_WIDTHS))[:-1].tolist()
    return jnp.split(p, idx, axis=-1)


def causal_depthwise_conv(x, w, b):
    k, c = w.shape
    y = lax.conv_general_dilated(
        x, w[:, None, :].astype(x.dtype), window_strides=(1,), padding=((k - 1, 0),),
        dimension_numbers=('NWC', 'WIO', 'NWC'), feature_group_count=c)
    return y + b


def segsum(a):
    t = a.shape[-1]
    cs = jnp.cumsum(a, axis=-1)
    diff = cs[..., :, None] - cs[..., None, :]
    mask = jnp.tril(jnp.ones((t, t), dtype=bool))
    return jnp.where(mask, diff, -jnp.inf)


def ssd_chunked(x, a, bm, cm):
    bsz, s, h, p = x.shape
    n = bm.shape[-1]
    nc = s // SSD_CHUNK
    x = x.reshape(bsz, nc, SSD_CHUNK, h, p)
    bm = bm.reshape(bsz, nc, SSD_CHUNK, h, n)
    cm = cm.reshape(bsz, nc, SSD_CHUNK, h, n)
    a = a.astype(jnp.float32).reshape(bsz, nc, SSD_CHUNK, h).transpose(0, 3, 1, 2)
    a_cs = jnp.cumsum(a, axis=-1)
    lmat = jnp.exp(segsum(a))
    scores = jnp.einsum('bclhn,bcshn->bhcls', cm, bm) * lmat
    y_diag = jnp.einsum('bhcls,bcshp->bclhp', scores, x)
    decay_states = jnp.exp(a_cs[..., -1:] - a_cs)
    states = jnp.einsum('bclhn,bhcl,bclhp->bchpn', bm, decay_states, x)
    states = jnp.concatenate([jnp.zeros_like(states[:, :1]), states], axis=1)
    decay_chunk = jnp.exp(segsum(jnp.pad(a_cs[..., -1], ((0, 0), (0, 0), (1, 0)))))
    states = jnp.einsum('bhzc,bchpn->bzhpn', decay_chunk, states)[:, :-1]
    y_off = jnp.einsum('bclhn,bchpn,bhcl->bclhp', cm, states, jnp.exp(a_cs))
    return (y_diag + y_off).reshape(bsz, s, h, p)


def ssd_branch(z, xbc, dt_raw, conv_w, conv_b, dt_bias, a_log, d_skip, norm_w):
    bsz, s, _ = xbc.shape
    xbc = jax.nn.silu(causal_depthwise_conv(xbc, conv_w, conv_b))
    xs, bm, cm = jnp.split(xbc, [GROUP_W, GROUP_W + SSD_NGROUPS * SSD_STATE], axis=-1)
    xs = xs.reshape(bsz, s, SSD_HEADS, SSD_HEAD_DIM)
    rep = SSD_HEADS // SSD_NGROUPS
    bm = jnp.repeat(bm.reshape(bsz, s, SSD_NGROUPS, SSD_STATE), rep, axis=2)
    cm = jnp.repeat(cm.reshape(bsz, s, SSD_NGROUPS, SSD_STATE), rep, axis=2)
    dt = jax.nn.softplus(dt_raw.astype(jnp.float32) + dt_bias.astype(jnp.float32))
    a = -jnp.exp(a_log.astype(jnp.float32))
    y = ssd_chunked(xs * dt[..., None], dt * a, bm, cm)
    y = y + d_skip[:, None] * xs
    y = y.reshape(bsz, s, GROUP_W)
    return rmsnorm(y * jax.nn.silu(z), norm_w)


def complex_affine_combine(e1, e2):
    a1r, a1i, b1r, b1i = e1
    a2r, a2i, b2r, b2i = e2
    return (a2r * a1r - a2i * a1i,
            a2r * a1i + a2i * a1r,
            a2r * b1r - a2i * b1i + b2r,
            a2r * b1i + a2i * b1r + b2i)


def s5_branch(u, gate, a_re, a_im, log_dt, b_re, b_im, c_re, c_im, d_skip, glu_w, glu_b):
    bsz, s, _ = u.shape
    f32 = jnp.float32
    uf = u.astype(f32).reshape(bsz, s, S5_GROUPS, S5_CH)
    a_re = a_re.astype(f32)
    a_im = a_im.astype(f32)
    delta = jnp.exp(log_dt.astype(f32))[:, None]
    mag = jnp.exp(a_re * delta)
    ab_re = mag * jnp.cos(a_im * delta)
    ab_im = mag * jnp.sin(a_im * delta)
    den = a_re * a_re + a_im * a_im
    coef_re = ((ab_re - 1.0) * a_re + ab_im * a_im) / den
    coef_im = (ab_im * a_re - (ab_re - 1.0) * a_im) / den
    b_re = b_re.astype(f32)
    b_im = b_im.astype(f32)
    bb_re = coef_re[..., None] * b_re - coef_im[..., None] * b_im
    bb_im = coef_re[..., None] * b_im + coef_im[..., None] * b_re
    bu_re = jnp.einsum('bsgi,gni->bsgn', uf, bb_re)
    bu_im = jnp.einsum('bsgi,gni->bsgn', uf, bb_im)
    shape = bu_re.shape
    elems = (jnp.broadcast_to(ab_re, shape), jnp.broadcast_to(ab_im, shape), bu_re, bu_im)
    _, _, h_re, h_im = lax.associative_scan(complex_affine_combine, elems, axis=1)
    y = (jnp.einsum('bsgn,gin->bsgi', h_re, c_re.astype(f32))
         - jnp.einsum('bsgn,gin->bsgi', h_im, c_im.astype(f32)))
    y = y.reshape(bsz, s, GROUP_W) + d_skip * uf.reshape(bsz, s, GROUP_W)
    y = jax.nn.gelu(y)
    y = y * jax.nn.sigmoid(y @ glu_w.astype(f32) + glu_b)
    return y * jax.nn.silu(gate)


def gla_branch(q, k, v, gate, glr, w2, gb, norm_w):
    bsz, s, _ = q.shape
    nc = s // GLA_CHUNK
    f32 = jnp.float32

    def heads(t, d):
        return t.reshape(bsz, nc, GLA_CHUNK, GLA_HEADS, d).transpose(0, 3, 1, 2, 4)

    q = heads(q, GLA_DK).astype(f32) * (GLA_DK ** -0.5)
    k = heads(k, GLA_DK).astype(f32)
    v = heads(v, GLA_DV).astype(f32)
    g = jax.nn.log_sigmoid((glr @ w2 + gb).astype(f32)) / GLA_GATE_NORM
    bcs = jnp.cumsum(heads(g, GLA_DK), axis=3)
    causal = jnp.tril(jnp.ones((GLA_CHUNK, GLA_CHUNK), dtype=bool))
    diff = bcs[..., :, None, :] - bcs[..., None, :, :]
    decay = jnp.exp(jnp.where(causal[..., None], diff, -jnp.inf))
    attn = jnp.einsum('bhcid,bhcjd,bhcijd->bhcij', q, k, decay)
    o_intra = jnp.einsum('bhcij,bhcjd->bhcid', attn, v)
    b_last = bcs[..., -1, :]
    q_dec = q * jnp.exp(bcs)
    k_dec = k * jnp.exp(b_last[..., None, :] - bcs)

    def step(state, inp):
        qd, kd, vc, bl = inp
        o = jnp.einsum('bhld,bhde->bhle', qd, state)
        state = jnp.exp(bl)[..., None] * state + jnp.einsum('bhld,bhle->bhde', kd, vc)
        return state, o

    xs = (jnp.moveaxis(q_dec, 2, 0), jnp.moveaxis(k_dec, 2, 0), jnp.moveaxis(v, 2, 0), jnp.moveaxis(b_last, 2, 0))
    init = jnp.zeros((bsz, GLA_HEADS, GLA_DK, GLA_DV), f32)
    _, o_inter = lax.scan(step, init, xs)
    o = o_intra + jnp.moveaxis(o_inter, 0, 2)
    o = rmsnorm(o, norm_w)
    o = o.transpose(0, 2, 3, 1, 4).reshape(bsz, s, GLA_HEADS * GLA_DV)
    return o * jax.nn.silu(gate)


def rope_tables(positions):
    inv_freq = ROPE_THETA ** (-jnp.arange(0, MLA_ROPE, 2, dtype=jnp.float32) / MLA_ROPE)
    ang = positions.astype(jnp.float32)[..., None] * inv_freq
    return jnp.cos(ang)[:, :, None, :], jnp.sin(ang)[:, :, None, :]


def apply_rope_tail(t, cos, sin):
    t_nope, t_rope = jnp.split(t, [t.shape[-1] - MLA_ROPE], axis=-1)
    x1, x2 = jnp.split(t_rope.astype(jnp.float32), 2, axis=-1)
    rot = jnp.concatenate([x1 * cos - x2 * sin, x2 * cos + x1 * sin], axis=-1).astype(t.dtype)
    return jnp.concatenate([t_nope, rot], axis=-1)


def causal_block_attention(q, k, v):
    bsz, h, s, dq = q.shape
    nb = s // MLA_QBLOCK
    scale = dq ** -0.5
    qb = q.reshape(bsz, h, nb, MLA_QBLOCK, dq).transpose(2, 0, 1, 3, 4)
    kpos = jnp.arange(s)

    def one(args):
        qblk, i = args
        sc = jnp.einsum('bhqd,bhkd->bhqk', qblk, k).astype(jnp.float32) * scale
        qpos = i * MLA_QBLOCK + jnp.arange(MLA_QBLOCK)
        sc = jnp.where(kpos[None, :] <= qpos[:, None], sc, -jnp.inf)
        p = jax.nn.softmax(sc, axis=-1)
        return jnp.einsum('bhqk,bhkd->bhqd', p.astype(v.dtype), v)

    out = lax.map(one, (qb, jnp.arange(nb)))
    return out.transpose(1, 2, 0, 3, 4).reshape(bsz, h, s, v.shape[-1])


def mla_branch(c_q, c_kv, k_pe, gate, cos, sin, q_norm_w, w_uq, kv_norm_w, w_ukv, qh_w, kh_w):
    bsz, s, _ = c_q.shape
    q = (rmsnorm(c_q, q_norm_w) @ w_uq).reshape(bsz, s, MLA_HEADS, MLA_NOPE + MLA_ROPE)
    kv = (rmsnorm(c_kv, kv_norm_w) @ w_ukv).reshape(bsz, s, MLA_HEADS, MLA_NOPE + MLA_V)
    k_nope, v = jnp.split(kv, [MLA_NOPE], axis=-1)
    k = jnp.concatenate([k_nope, jnp.broadcast_to(k_pe[:, :, None, :], (bsz, s, MLA_HEADS, MLA_ROPE))], axis=-1)
    q = apply_rope_tail(rmsnorm(q, qh_w), cos, sin)
    k = apply_rope_tail(rmsnorm(k, kh_w), cos, sin)
    out = causal_block_attention(q.transpose(0, 2, 1, 3), k.transpose(0, 2, 1, 3), v.transpose(0, 2, 1, 3))
    out = out.transpose(0, 2, 1, 3).reshape(bsz, s, MLA_HEADS * MLA_V)
    return out * jax.nn.silu(gate)


def setup_inputs(seed: int = 0) -> dict:
    key = jax.random.key(seed)
    ks = iter(jax.random.split(key, 40))
    f32 = jnp.float32

    def nrm(shape, scale):
        return scale * jax.random.normal(next(ks), shape, f32)

    def gain(shape):
        return 1.0 + nrm(shape, 0.02)

    L = DEPTH
    x = jax.random.normal(next(ks), (BATCH, SEQ, D_MODEL), f32)
    positions = (jnp.arange(SEQ, dtype=jnp.int32)[None, :]
                 + jax.random.randint(next(ks), (BATCH, 1), 0, 1024, dtype=jnp.int32))
    u_dt = jax.random.uniform(next(ks), (L, SSD_HEADS), f32)
    dt0 = jnp.exp(u_dt * (math.log(DT_MAX) - math.log(DT_MIN)) + math.log(DT_MIN))
    ssd_dt_bias = dt0 + jnp.log(-jnp.expm1(-dt0))
    ssd_a_log = jnp.log(jax.random.uniform(next(ks), (L, SSD_HEADS), f32, 1.0, 16.0))
    s5_a_re = -0.5 * jnp.exp(nrm((L, S5_GROUPS, S5_STATE), 0.02))
    s5_a_im = math.pi * jnp.arange(S5_STATE, dtype=f32) + nrm((L, S5_GROUPS, S5_STATE), 0.02)
    s5_log_dt = (jax.random.uniform(next(ks), (L, S5_GROUPS), f32)
                 * (math.log(DT_MAX) - math.log(DT_MIN)) + math.log(DT_MIN))
    return {
        'x': x,
        'positions': positions,
        'norm_w': gain((L, D_MODEL)),
        'w_in': nrm((L, D_MODEL, D_IN), D_MODEL ** -0.5),
        'w_out': nrm((L, D_MIX, D_MODEL), D_MIX ** -0.5),
        'ssd_conv_w': nrm((L, SSD_CONV, SSD_XBC), SSD_CONV ** -0.5),
        'ssd_conv_b': nrm((L, SSD_XBC), 0.02),
        'ssd_dt_bias': ssd_dt_bias,
        'ssd_a_log': ssd_a_log,
        'ssd_d': gain((L, SSD_HEADS)),
        'ssd_norm_w': gain((L, GROUP_W)),
        's5_a_re': s5_a_re,
        's5_a_im': s5_a_im,
        's5_log_dt': s5_log_dt,
        's5_b_re': nrm((L, S5_GROUPS, S5_STATE, S5_CH), (2 * S5_CH) ** -0.5),
        's5_b_im': nrm((L, S5_GROUPS, S5_STATE, S5_CH), (2 * S5_CH) ** -0.5),
        's5_c_re': nrm((L, S5_GROUPS, S5_CH, S5_STATE), S5_STATE ** -0.5),
        's5_c_im': nrm((L, S5_GROUPS, S5_CH, S5_STATE), S5_STATE ** -0.5),
        's5_d': nrm((L, GROUP_W), 1.0),
        's5_glu_w': nrm((L, GROUP_W, GROUP_W), GROUP_W ** -0.5),
        's5_glu_b': nrm((L, GROUP_W), 0.02),
        'gla_gate_w2': nrm((L, GLA_GATE_RANK, GLA_HEADS * GLA_DK), GLA_GATE_RANK ** -0.5),
        'gla_gate_b': nrm((L, GLA_HEADS * GLA_DK), 0.02),
        'gla_norm_w': gain((L, GLA_DV)),
        'mla_q_norm_w': gain((L, MLA_Q_RANK)),
        'mla_w_uq': nrm((L, MLA_Q_RANK, MLA_HEADS * (MLA_NOPE + MLA_ROPE)), MLA_Q_RANK ** -0.5),
        'mla_kv_norm_w': gain((L, MLA_KV_RANK)),
        'mla_w_ukv': nrm((L, MLA_KV_RANK, MLA_HEADS * (MLA_NOPE + MLA_V)), MLA_KV_RANK ** -0.5),
        'mla_q_head_norm_w': gain((L, MLA_NOPE + MLA_ROPE)),
        'mla_k_head_norm_w': gain((L, MLA_NOPE + MLA_ROPE)),
    }


def reference(x, positions, norm_w, w_in, w_out, ssd_conv_w, ssd_conv_b, ssd_dt_bias, ssd_a_log,
              ssd_d, ssd_norm_w, s5_a_re, s5_a_im, s5_log_dt, s5_b_re, s5_b_im, s5_c_re, s5_c_im,
              s5_d, s5_glu_w, s5_glu_b, gla_gate_w2, gla_gate_b, gla_norm_w, mla_q_norm_w, mla_w_uq,
              mla_kv_norm_w, mla_w_ukv, mla_q_head_norm_w, mla_k_head_norm_w):
    cos, sin = rope_tables(positions)
    h = x
    for l in range(DEPTH):
        u = rmsnorm(h, norm_w[l])
        (z, xbc, dt_raw, s5_u, s5_g, gq, gk, gv, gg, glr,
         cq, ckv, kpe, mg) = split_columns(u @ w_in[l])
        y_a = ssd_branch(z, xbc, dt_raw, ssd_conv_w[l], ssd_conv_b[l], ssd_dt_bias[l], ssd_a_log[l],
                         ssd_d[l], ssd_norm_w[l])
        y_b = s5_branch(s5_u, s5_g, s5_a_re[l], s5_a_im[l], s5_log_dt[l], s5_b_re[l], s5_b_im[l],
                        s5_c_re[l], s5_c_im[l], s5_d[l], s5_glu_w[l], s5_glu_b[l])
        y_c = gla_branch(gq, gk, gv, gg, glr, gla_gate_w2[l], gla_gate_b[l], gla_norm_w[l])
        y_d = mla_branch(cq, ckv, kpe, mg, cos, sin, mla_q_norm_w[l], mla_w_uq[l], mla_kv_norm_w[l],
                         mla_w_ukv[l], mla_q_head_norm_w[l], mla_k_head_norm_w[l])
        mix = jnp.concatenate([y_a.astype(h.dtype), y_b.astype(h.dtype), y_c.astype(h.dtype), y_d.astype(h.dtype)], axis=-1)
        h = h + mix @ w_out[l]
    return h
```

```cpp
#include <hip/hip_runtime.h>
#include <cstdio>
#include <cstdint>

#define LAS __attribute__((address_space(3)))
typedef unsigned short bf16_t;
typedef short bf16x8 __attribute__((ext_vector_type(8)));
typedef float f32x4 __attribute__((ext_vector_type(4)));
typedef unsigned u32x4 __attribute__((ext_vector_type(4)));
typedef unsigned u32x2 __attribute__((ext_vector_type(2)));

constexpr int DM = 2048, NB = 4, SEQ = 2048, DEPTH = 4, TOK = NB * SEQ;
constexpr int D_IN = 4952, NP = 5120;
constexpr float EPS = 1e-6f;
constexpr int C_Z = 0, C_XBC = 512, C_S5U = 1280, C_S5G = 1792, C_GQ = 2304, C_GK = 2560, C_GV = 2816, C_GG = 3328,
              C_CQ = 3840, C_CKV = 4224, C_KPE = 4352, C_DT = 4416, C_GLR = 4424, C_PAD = 4440, C_MG = 4608;
__host__ __device__ __forceinline__ int win_src_col(int n) {
    if (n < 1280) return n;
    if (n < C_GQ) return n + 8;
    if (n < C_CQ) return n + 8;
    if (n < C_KPE) return n + 24;
    if (n < C_DT) return n + 24;
    if (n < C_GLR) return n - C_DT + 1280;
    if (n < C_PAD) return n - C_GLR + 3848;
    if (n < C_MG) return -1;
    return n - C_MG + 4440;
}

__device__ __forceinline__ float bf2f(bf16_t v) { return __uint_as_float(((unsigned)v) << 16); }
__device__ __forceinline__ unsigned f2bf(float f) { unsigned u = __float_as_uint(f); return (u + 0x7fffu + ((u >> 16) & 1u)) >> 16; }
__device__ __forceinline__ unsigned pk2(float lo, float hi) { return f2bf(lo) | (f2bf(hi) << 16); }
__device__ __forceinline__ float wave_sum(float v) {
#pragma unroll
    for (int o = 1; o < 64; o <<= 1) v += __shfl_xor(v, o);
    return v;
}
__device__ __forceinline__ float sigmoidf_(float x) { return 1.0f / (1.0f + expf(-x)); }
__device__ __forceinline__ float siluf_(float x) { return x * sigmoidf_(x); }
__device__ __forceinline__ float softplusf_(float x) { return x > 20.f ? x : log1pf(expf(x)); }
__device__ __forceinline__ float gelu_tanh(float x) { const float c = 0.7978845608028654f; return 0.5f * x * (1.0f + tanhf(c * (x + 0.044715f * x * x * x))); }

namespace pg8 {
constexpr int BM = 256, BK = 64, HALF = 128, HTB = HALF * BK * 2, STAGE_BYTES = 8 * HTB, NXCD = 8, WGM = 8;
__host__ __device__ __forceinline__ int lds_byte(int r, int c) { const int st = (r >> 4) * 2 + (c >> 5), rr = r & 15, cc = c & 31, ob = rr * 64 + cc * 2; return st * 1024 + (ob ^ (((ob >> 9) & 1) << 5)); }
__host__ __device__ __forceinline__ void stage_rc(int b, int& R, int& C) { const int st = b / 1024, sb = b % 1024, swz = sb ^ (((sb >> 9) & 1) << 5); R = (st >> 1) * 16 + swz / 64; C = (st & 1) * 32 + (swz % 64) / 2; }
__host__ __device__ __forceinline__ int perm32(int rho) { const int n = rho >> 4, i = rho & 15; return 8 * (i >> 2) + 4 * n + (i & 3); }
struct Unit { int pm, pn; };
struct Gemm { const bf16_t* A; const bf16_t* Bt; int M, N, K, lda, ldb, pad; };
struct StaticOrder {
    int nM, nN, nwg, G, c;
    __host__ __device__ void init(int M, int N, int G_, int c_) { nM = M / BM; nN = N / BM; nwg = nM * nN; G = G_; c = c_; }
    __host__ __device__ bool next(int i, Unit& u) const {
        const long L = (long)i * G + c; if (L >= nwg) return false;
        int wgid = (int)L; { const int q = nwg / NXCD, r = nwg % NXCD, xcd = wgid % NXCD, off = wgid / NXCD; wgid = (xcd < r ? xcd * (q + 1) : r * (q + 1) + (xcd - r) * q) + off; }
        const int nig = WGM * nN, gid = wgid / nig, fm = gid * WGM, gsz = (nM - fm) < WGM ? (nM - fm) : WGM;
        u.pm = fm + ((wgid % nig) % gsz); u.pn = (wgid % nig) / gsz; return true;
    }
};
__device__ __forceinline__ unsigned cvt_pk_bf16(float lo, float hi) { unsigned r; asm volatile("v_cvt_pk_bf16_f32 %0, %1, %2" : "=v"(r) : "v"(lo), "v"(hi)); return r; }

template <class Epi, class Sched, bool ALIGN_EPI>
__device__ __forceinline__ void gemm_phase(LAS unsigned char* lds, const Gemm g, const Sched& S, const Epi& E) {
    const int tid = threadIdx.x, wid = __builtin_amdgcn_readfirstlane(tid >> 6), lane = tid & 63, wr = wid >> 2, wc = wid & 3, fr = lane & 15, fq = lane >> 4;
    const int K = g.K, nt = K / BK;
    unsigned voffA[2], voffB[2];
#pragma unroll
    for (int i = 0; i < 2; ++i) { int R, C; stage_rc(tid * 16 + i * 8192, R, C); const int Rb = Epi::PERM ? ((R & ~31) + perm32(R & 31)) : R;
        voffA[i] = (unsigned)(R * g.lda + C) * 2u; voffB[i] = (unsigned)(Rb * g.ldb + C) * 2u; }
    const size_t kstep = (size_t)(BK * 2);
    const size_t hstepA = (size_t)HALF * g.lda * 2, hstepB = (size_t)HALF * g.ldb * 2;
    const size_t tstepA = 2 * hstepA, tstepB = 2 * hstepB;
    const unsigned ldsw = (unsigned)wid * 1024u;
    const int aoff = lds_byte(wr * 64 + fr, fq * 8), boff = lds_byte(wc * 32 + fr, fq * 8);
#define PG8_SA(b, h) (((b) * 2 + (h)) * HTB)
#define PG8_SB(b, h) ((4 + (b) * 2 + (h)) * HTB)
#define PG8_STAGE(bufoff, gbase, voff) do { _Pragma("unroll") for (int _i = 0; _i < 2; ++_i) \
        __builtin_amdgcn_global_load_lds((const unsigned*)((const char*)(gbase) + (voff)[_i]), (LAS unsigned*)(lds + (bufoff) + ldsw + _i * 8192), 16, 0, 0); } while (0)
#define PG8_LDA(dst, b, h) do { _Pragma("unroll") for (int m = 0; m < 4; ++m) _Pragma("unroll") for (int k = 0; k < 2; ++k) dst[m][k] = *(const LAS bf16x8*)(lds + PG8_SA(b, h) + aoff + m * 2048 + k * 1024); } while (0)
#define PG8_LDB(dst, b, h) do { _Pragma("unroll") for (int n = 0; n < 2; ++n) _Pragma("unroll") for (int k = 0; k < 2; ++k) dst[n][k] = *(const LAS bf16x8*)(lds + PG8_SB(b, h) + boff + n * 2048 + k * 1024); } while (0)
#define PG8_MMA(ai, bj, At, Bt) do { __builtin_amdgcn_s_setprio(1); _Pragma("unroll") for (int m = 0; m < 4; ++m) _Pragma("unroll") for (int n = 0; n < 2; ++n) _Pragma("unroll") for (int k = 0; k < 2; ++k) \
        acc[ai][bj][m][n] = __builtin_amdgcn_mfma_f32_16x16x32_bf16(Bt[n][k], At[m][k], acc[ai][bj][m][n], 0, 0, 0); __builtin_amdgcn_s_setprio(0); } while (0)
#define PG8_WAIT_V(n) asm volatile("s_waitcnt vmcnt(" #n ")" ::: "memory")
#define PG8_WAIT_L(n) asm volatile("s_waitcnt lgkmcnt(" #n ")" ::: "memory")
#define PG8_BAR __builtin_amdgcn_s_barrier()
#define PG8_SCHED __builtin_amdgcn_sched_barrier(0)
    Unit cur, nxt; int ui = 0;
    if (!S.next(0, cur)) return;
    f32x4 acc[2][2][4][2];
#pragma unroll
    for (int a = 0; a < 2; ++a)
#pragma unroll
        for (int b = 0; b < 2; ++b)
#pragma unroll
            for (int m = 0; m < 4; ++m)
#pragma unroll
                for (int n = 0; n < 2; ++n) acc[a][b][m][n] = (f32x4){0.f, 0.f, 0.f, 0.f};
    bf16x8 At[4][2], B0[2][2], B1[2][2];
    const char* cA = (const char*)g.A + (size_t)cur.pm * tstepA; const char* cB = (const char*)g.Bt + (size_t)cur.pn * tstepB;
    PG8_STAGE(PG8_SB(0, 0), cB, voffB); PG8_STAGE(PG8_SB(0, 1), cB + hstepB, voffB); PG8_STAGE(PG8_SA(0, 0), cA, voffA); PG8_STAGE(PG8_SA(0, 1), cA + hstepA, voffA);
    if (wr == 1) PG8_BAR;
    PG8_WAIT_V(2); PG8_BAR;
    PG8_STAGE(PG8_SB(1, 0), cB + kstep, voffB); PG8_STAGE(PG8_SA(1, 0), cA + kstep, voffA); PG8_STAGE(PG8_SB(1, 1), cB + hstepB + kstep, voffB);
    PG8_WAIT_V(6); PG8_BAR;
    for (;;) {
        const bool has_next = S.next(ui + 1, nxt);
        const char* nA = has_next ? (const char*)g.A + (size_t)nxt.pm * tstepA : cA; const char* nB = has_next ? (const char*)g.Bt + (size_t)nxt.pn * tstepB : cB;
        for (int t = 0; t < nt; t += 2) {
            const bool last = (t == nt - 2);
            const char* a1 = cA + (size_t)(t + 1) * kstep;
            const char* a2 = last ? nA : cA + (size_t)(t + 2) * kstep; const char* b2 = last ? nB : cB + (size_t)(t + 2) * kstep;
            const char* a3 = a2 + kstep; const char* b3 = b2 + kstep;
            PG8_LDB(B0, 0, 0); PG8_LDB(B1, 0, 1); PG8_SCHED; PG8_LDA(At, 0, 0); PG8_STAGE(PG8_SA(1, 1), a1 + hstepA, voffA);
            PG8_WAIT_V(8); PG8_WAIT_L(0); PG8_BAR; PG8_MMA(0, 0, At, B0); PG8_MMA(0, 1, At, B1); PG8_BAR; PG8_SCHED;
            PG8_LDA(At, 0, 1); PG8_STAGE(PG8_SB(0, 0), b2, voffB); PG8_STAGE(PG8_SB(0, 1), b2 + hstepB, voffB); PG8_STAGE(PG8_SA(0, 0), a2, voffA);
            PG8_WAIT_V(8); PG8_WAIT_L(0); PG8_BAR; PG8_MMA(1, 0, At, B0); PG8_MMA(1, 1, At, B1); PG8_BAR; PG8_SCHED;
            PG8_LDB(B0, 1, 0); PG8_LDB(B1, 1, 1); PG8_SCHED; PG8_LDA(At, 1, 0); PG8_STAGE(PG8_SA(0, 1), a2 + hstepA, voffA);
            PG8_WAIT_V(8); PG8_WAIT_L(0); PG8_BAR; PG8_MMA(0, 0, At, B0); PG8_MMA(0, 1, At, B1); PG8_BAR; PG8_SCHED;
            PG8_LDA(At, 1, 1); PG8_STAGE(PG8_SB(1, 0), b3, voffB); PG8_STAGE(PG8_SB(1, 1), b3 + hstepB, voffB); PG8_STAGE(PG8_SA(1, 0), a3, voffA);
            PG8_WAIT_V(8); PG8_WAIT_L(0); PG8_BAR; PG8_MMA(1, 0, At, B0); PG8_MMA(1, 1, At, B1); PG8_BAR; PG8_SCHED;
        }
        if constexpr (ALIGN_EPI) { if (wr == 0) PG8_BAR; }
        E(acc, cur, wr, wc, fr, fq);
        if (!has_next) break;
#pragma unroll
        for (int a = 0; a < 2; ++a)
#pragma unroll
            for (int b = 0; b < 2; ++b)
#pragma unroll
                for (int m = 0; m < 4; ++m)
#pragma unroll
                    for (int n = 0; n < 2; ++n) acc[a][b][m][n] = (f32x4){0.f, 0.f, 0.f, 0.f};
        cur = nxt; cA = nA; cB = nB; ++ui;
        if constexpr (ALIGN_EPI) { if (wr == 1) PG8_BAR; }
    }
    PG8_WAIT_V(0);
    if constexpr (!ALIGN_EPI) { if (wr == 0) PG8_BAR; }
    PG8_BAR;
#undef PG8_SA
#undef PG8_SB
#undef PG8_STAGE
#undef PG8_LDA
#undef PG8_LDB
#undef PG8_MMA
#undef PG8_WAIT_V
#undef PG8_WAIT_L
#undef PG8_BAR
#undef PG8_SCHED
}

struct EpiBf16 {
    static constexpr bool PERM = true;
    bf16_t* O; int ldc, pad;
    __device__ __forceinline__ void operator()(const f32x4 (&acc)[2][2][4][2], const Unit& u, int wr, int wc, int fr, int fq) const {
        const int row0 = u.pm * BM + wr * 64 + fr, col0 = u.pn * BM + wc * 32 + 8 * fq;
#pragma unroll
        for (int ai = 0; ai < 2; ++ai)
#pragma unroll
            for (int m = 0; m < 4; ++m) { bf16_t* rowp = O + (size_t)(row0 + ai * HALF + m * 16) * ldc + col0;
#pragma unroll
                for (int bj = 0; bj < 2; ++bj) { const f32x4 v0 = acc[ai][bj][m][0], v1 = acc[ai][bj][m][1];
                    u32x4 w; w.x = cvt_pk_bf16(v0[0], v0[1]); w.y = cvt_pk_bf16(v0[2], v0[3]); w.z = cvt_pk_bf16(v1[0], v1[1]); w.w = cvt_pk_bf16(v1[2], v1[3]);
                    *(u32x4*)(rowp + bj * HALF) = w; } }
    }
};
struct EpiP1 {
    static constexpr bool PERM = true;
    bf16_t* O; const float* rstd; float* dtf;
    __device__ __forceinline__ void operator()(const f32x4 (&acc)[2][2][4][2], const Unit& u, int wr, int wc, int fr, int fq) const {
        const int row0 = u.pm * BM + wr * 64 + fr, col0 = u.pn * BM + wc * 32 + 8 * fq;
        const bool isdt = (u.pn == C_DT / 256) && (wc * 32 + 8 * fq == C_DT % 256);
#pragma unroll
        for (int ai = 0; ai < 2; ++ai)
#pragma unroll
            for (int m = 0; m < 4; ++m) { const int row = row0 + ai * HALF + m * 16; const float rs = rstd[row]; bf16_t* rowp = O + (size_t)row * NP + col0;
#pragma unroll
                for (int bj = 0; bj < 2; ++bj) { const f32x4 v0 = acc[ai][bj][m][0] * rs, v1 = acc[ai][bj][m][1] * rs;
                    u32x4 w; w.x = cvt_pk_bf16(v0[0], v0[1]); w.y = cvt_pk_bf16(v0[2], v0[3]); w.z = cvt_pk_bf16(v1[0], v1[1]); w.w = cvt_pk_bf16(v1[2], v1[3]);
                    *(u32x4*)(rowp + bj * HALF) = w;
                    if (bj == 0 && isdt) { *(f32x4*)(dtf + (size_t)row * 8) = v0; *(f32x4*)(dtf + (size_t)row * 8 + 4) = v1; } } }
    }
};
struct EpiRes {
    static constexpr bool PERM = false;
    const float* base; float* out;
    __device__ __forceinline__ void operator()(const f32x4 (&acc)[2][2][4][2], const Unit& u, int wr, int wc, int fr, int fq) const {
        const int row0 = u.pm * BM + wr * 64 + fr, col0 = u.pn * BM + wc * 32 + 4 * fq;
#pragma unroll
        for (int ai = 0; ai < 2; ++ai)
#pragma unroll
            for (int m = 0; m < 4; ++m) { const size_t off = (size_t)(row0 + ai * HALF + m * 16) * DM + col0;
#pragma unroll
                for (int bj = 0; bj < 2; ++bj)
#pragma unroll
                    for (int n = 0; n < 2; ++n) { const size_t ix = off + bj * HALF + n * 16; const f32x4 b = *(const f32x4*)(base + ix); *(f32x4*)(out + ix) = b + acc[ai][bj][m][n]; } }
    }
};
struct EpiGlu {
    static constexpr bool PERM = true;
    const bf16_t* yg; const bf16_t* proj; const float* bias; bf16_t* mix;
    __device__ __forceinline__ void operator()(const f32x4 (&acc)[2][2][4][2], const Unit& u, int wr, int wc, int fr, int fq) const {
        const int row0 = u.pm * BM + wr * 64 + fr, col0 = u.pn * BM + wc * 32 + 8 * fq;
#pragma unroll
        for (int ai = 0; ai < 2; ++ai)
#pragma unroll
            for (int m = 0; m < 4; ++m) { const int row = row0 + ai * HALF + m * 16;
#pragma unroll
                for (int bj = 0; bj < 2; ++bj) { const int col = col0 + bj * HALF;
                    const u32x4 yv = *(const u32x4*)(yg + (size_t)row * 512 + col), gv = *(const u32x4*)(proj + (size_t)row * NP + C_S5G + col);
                    const f32x4 b0 = *(const f32x4*)(bias + col), b1 = *(const f32x4*)(bias + col + 4);
                    float o[8];
#pragma unroll
                    for (int j = 0; j < 8; ++j) { const unsigned yw = yv[j >> 1], gw = gv[j >> 1];
                        const float y = (j & 1) ? __uint_as_float(yw & 0xffff0000u) : __uint_as_float(yw << 16);
                        const float gt = (j & 1) ? __uint_as_float(gw & 0xffff0000u) : __uint_as_float(gw << 16);
                        const float a = (j < 4 ? acc[ai][bj][m][0][j & 3] : acc[ai][bj][m][1][j & 3]) + (j < 4 ? b0[j & 3] : b1[j & 3]);
                        o[j] = y * sigmoidf_(a) * siluf_(gt); }
                    u32x4 w; w.x = cvt_pk_bf16(o[0], o[1]); w.y = cvt_pk_bf16(o[2], o[3]); w.z = cvt_pk_bf16(o[4], o[5]); w.w = cvt_pk_bf16(o[6], o[7]);
                    *(u32x4*)(mix + (size_t)row * DM + 512 + col) = w; } }
    }
};
}

template <class Epi> __global__ void __launch_bounds__(512, 2) k_gemm(pg8::Gemm g, Epi E) {
    __shared__ __attribute__((aligned(16))) unsigned char lds[pg8::STAGE_BYTES];
    pg8::StaticOrder S; S.init(g.M, g.N, (int)gridDim.x, (int)blockIdx.x);
    pg8::gemm_phase<Epi, pg8::StaticOrder, true>((LAS unsigned char*)lds, g, S, E);
}

template <int MODE> __global__ void __launch_bounds__(256) k_wtrans(const float* src, int K, int Nsrc, bf16_t* dst, int Ndst, const float* scale) {
    __shared__ float tile[64][65];
    const int l = blockIdx.z, n0 = blockIdx.x * 64, k0 = blockIdx.y * 64, tid = threadIdx.x;
    const float* s = src + (size_t)l * K * Nsrc; bf16_t* d = dst + (size_t)l * Ndst * K; const float* sc = scale ? scale + (size_t)l * K : nullptr;
    {
        const int n = tid & 63; int sn = n0 + n; if (MODE == 1) sn = win_src_col(sn);
#pragma unroll 4
        for (int i = 0; i < 16; ++i) { const int k = i * 4 + (tid >> 6); float v = 0.f; if (sn >= 0) { v = s[(size_t)(k0 + k) * Nsrc + sn]; if (sc) v *= sc[k0 + k]; } tile[k][n] = v; }
    }
    __syncthreads();
    {
        const int k = tid & 63;
#pragma unroll 4
        for (int i = 0; i < 16; ++i) { const int n = i * 4 + (tid >> 6); d[(size_t)(n0 + n) * K + k0 + k] = (bf16_t)f2bf(tile[k][n]); }
    }
}
__global__ void __launch_bounds__(256) k_s5prep(const float* a_re, const float* a_im, const float* log_dt, const float* b_re, const float* b_im, float* abar, float* bbar) {
    const int i = blockIdx.x * blockDim.x + threadIdx.x; if (i >= DEPTH * 32 * 64) return;
    const int lg = i / 64;
    const double are = a_re[i], aim = a_im[i], delta = exp((double)log_dt[lg]);
    const double mag = exp(are * delta), abr = mag * cos(aim * delta), abi = mag * sin(aim * delta), den = are * are + aim * aim;
    const double cr = ((abr - 1.0) * are + abi * aim) / den, ci = (abi * are - (abr - 1.0) * aim) / den;
    abar[2 * i] = (float)abr; abar[2 * i + 1] = (float)abi;
#pragma unroll
    for (int j = 0; j < 16; ++j) { const double br = b_re[(size_t)i * 16 + j], bi = b_im[(size_t)i * 16 + j];
        bbar[(size_t)i * 32 + j] = (float)(cr * br - ci * bi); bbar[(size_t)i * 32 + 16 + j] = (float)(cr * bi + ci * br); }
}
__global__ void __launch_bounds__(256) k_rowprep(const float* h, bf16_t* hb, float* rstd) {
    const int lane = threadIdx.x & 63, gw = (blockIdx.x * blockDim.x + threadIdx.x) >> 6, ngw = (gridDim.x * blockDim.x) >> 6;
    for (int row = gw; row < TOK; row += ngw) {
        const f32x4* xr = (const f32x4*)(h + (size_t)row * DM) + lane; f32x4 v[8]; float s = 0.f;
#pragma unroll
        for (int j = 0; j < 8; ++j) { v[j] = xr[64 * j]; s += (v[j].x * v[j].x + v[j].y * v[j].y) + (v[j].z * v[j].z + v[j].w * v[j].w); }
        s = wave_sum(s);
        if (lane == 0) rstd[row] = 1.0f / sqrtf(s * (1.0f / DM) + EPS);
        u32x2* o = (u32x2*)(hb + (size_t)row * DM) + lane;
#pragma unroll
        for (int j = 0; j < 8; ++j) { u32x2 w; w.x = pk2(v[j].x, v[j].y); w.y = pk2(v[j].z, v[j].w); o[64 * j] = w; }
    }
}

struct LayerP {
    const float *conv_w, *conv_b, *dt_bias, *a_log, *ssd_d, *ssd_norm_w;
    const float *s5_c_re, *s5_c_im, *s5_d, *abar, *bbar;
    const float *gla_w2, *gla_gb, *gla_norm_w;
    const float *qh_w, *kh_w;
    const int* pos;
    const bf16_t* proj; const float* dtf;
    float *xbcc, *dtv, *ys, *hs, *eg, *og;
    bf16_t *yg, *mix, *qraw, *kvraw, *qf, *kf, *vf;
};
__global__ void __launch_bounds__(256) k_conv(LayerP P) {
    const size_t n = (size_t)TOK * 768, stride = (size_t)gridDim.x * blockDim.x;
    for (size_t i = (size_t)blockIdx.x * blockDim.x + threadIdx.x; i < n; i += stride) {
        const int tok = (int)(i / 768), c = (int)(i % 768), s = tok % SEQ;
        float a = P.conv_b[c];
#pragma unroll
        for (int k = 0; k < 4; ++k) { const int ss = s - 3 + k; if (ss >= 0) a += P.conv_w[k * 768 + c] * bf2f(P.proj[(size_t)(tok - 3 + k) * NP + C_XBC + c]); }
        P.xbcc[i] = siluf_(a);
        if (c < 8) P.dtv[(size_t)tok * 8 + c] = softplusf_(P.dtf[(size_t)tok * 8 + c] + P.dt_bias[c]);
    }
}
__global__ void __launch_bounds__(256) k_ssd_naive(LayerP P) {
    const int lane = threadIdx.x & 63, gw = (blockIdx.x * blockDim.x + threadIdx.x) >> 6, ngw = (gridDim.x * blockDim.x) >> 6;
    for (int w = gw; w < NB * 8 * 64; w += ngw) {
        const int b = w / 512, h = (w / 64) % 8, p = w % 64, g = h / 4;
        const float A = -expf(P.a_log[h]), Dh = P.ssd_d[h];
        float hs = 0.f;
        for (int t = 0; t < SEQ; ++t) {
            const size_t tok = (size_t)b * SEQ + t; const float* xr = P.xbcc + tok * 768;
            const float dt = P.dtv[tok * 8 + h], x = xr[h * 64 + p], Bn = xr[512 + g * 64 + lane], Cn = xr[640 + g * 64 + lane];
            hs = expf(dt * A) * hs + (x * dt) * Bn;
            const float y = wave_sum(Cn * hs);
            if (lane == 0) P.ys[tok * 512 + h * 64 + p] = y + Dh * x;
        }
    }
}
__global__ void __launch_bounds__(256) k_ssd_out(LayerP P) {
    const int lane = threadIdx.x & 63, gw = (blockIdx.x * blockDim.x + threadIdx.x) >> 6, ngw = (gridDim.x * blockDim.x) >> 6;
    for (int tok = gw; tok < TOK; tok += ngw) {
        float v[8]; float s = 0.f;
#pragma unroll
        for (int j = 0; j < 8; ++j) { const int c = lane * 8 + j; v[j] = P.ys[(size_t)tok * 512 + c] * siluf_(bf2f(P.proj[(size_t)tok * NP + C_Z + c])); s += v[j] * v[j]; }
        s = wave_sum(s); const float r = 1.0f / sqrtf(s * (1.0f / 512.f) + EPS);
#pragma unroll
        for (int j = 0; j < 8; ++j) { const int c = lane * 8 + j; P.mix[(size_t)tok * DM + c] = (bf16_t)f2bf(v[j] * r * P.ssd_norm_w[c]); }
    }
}
__global__ void __launch_bounds__(256) k_s5_scan(LayerP P) {
    const int lane = threadIdx.x & 63, gw = (blockIdx.x * blockDim.x + threadIdx.x) >> 6, ngw = (gridDim.x * blockDim.x) >> 6;
    for (int w = gw; w < NB * 32; w += ngw) {
        const int b = w / 32, g = w % 32;
        const float ar = P.abar[(g * 64 + lane) * 2], ai = P.abar[(g * 64 + lane) * 2 + 1];
        float br[16], bi[16];
#pragma unroll
        for (int j = 0; j < 16; ++j) { br[j] = P.bbar[(size_t)(g * 64 + lane) * 32 + j]; bi[j] = P.bbar[(size_t)(g * 64 + lane) * 32 + 16 + j]; }
        float hr = 0.f, hi = 0.f;
        for (int t = 0; t < SEQ; ++t) {
            const size_t tok = (size_t)b * SEQ + t; const bf16_t* up = P.proj + tok * NP + C_S5U + g * 16;
            float ur = 0.f, ui = 0.f;
#pragma unroll
            for (int j = 0; j < 16; ++j) { const float u = bf2f(up[j]); ur += br[j] * u; ui += bi[j] * u; }
            const float nr = ar * hr - ai * hi + ur, ni = ar * hi + ai * hr + ui; hr = nr; hi = ni;
            float* o = P.hs + (tok * 32 + g) * 128; o[lane] = hr; o[64 + lane] = hi;
        }
    }
}
__global__ void __launch_bounds__(256) k_s5_out(LayerP P) {
    const size_t n = (size_t)TOK * 512, stride = (size_t)gridDim.x * blockDim.x;
    for (size_t i = (size_t)blockIdx.x * blockDim.x + threadIdx.x; i < n; i += stride) {
        const size_t tok = i / 512; const int ch = (int)(i % 512), g = ch / 16, ii = ch % 16;
        const float* h = P.hs + (tok * 32 + g) * 128; const float* cr = P.s5_c_re + (size_t)(g * 16 + ii) * 64; const float* ci = P.s5_c_im + (size_t)(g * 16 + ii) * 64;
        float y = 0.f;
        for (int k = 0; k < 64; ++k) y += cr[k] * h[k] - ci[k] * h[64 + k];
        y += P.s5_d[ch] * bf2f(P.proj[tok * NP + C_S5U + ch]);
        P.yg[i] = (bf16_t)f2bf(gelu_tanh(y));
    }
}
__global__ void __launch_bounds__(256) k_gla_gate(LayerP P) {
    const size_t n = (size_t)TOK * 256, stride = (size_t)gridDim.x * blockDim.x;
    for (size_t i = (size_t)blockIdx.x * blockDim.x + threadIdx.x; i < n; i += stride) {
        const size_t tok = i / 256; const int j = (int)(i % 256);
        float x = P.gla_gb[j];
#pragma unroll
        for (int r = 0; r < 16; ++r) x += bf2f(P.proj[tok * NP + C_GLR + r]) * P.gla_w2[r * 256 + j];
        const float ls = fminf(x, 0.f) - log1pf(expf(-fabsf(x)));
        P.eg[i] = expf(ls * (1.0f / 16.0f));
    }
}
__global__ void __launch_bounds__(256) k_gla_naive(LayerP P) {
    const int lane = threadIdx.x & 63, gw = (blockIdx.x * blockDim.x + threadIdx.x) >> 6, ngw = (gridDim.x * blockDim.x) >> 6;
    for (int w = gw; w < NB * 4 * 128; w += ngw) {
        const int b = w / 512, h = (w / 128) % 4, e = w % 128;
        float S = 0.f;
        for (int t = 0; t < SEQ; ++t) {
            const size_t tok = (size_t)b * SEQ + t; const bf16_t* pr = P.proj + tok * NP;
            const float eg = P.eg[tok * 256 + h * 64 + lane], k = bf2f(pr[C_GK + h * 64 + lane]), q = bf2f(pr[C_GQ + h * 64 + lane]) * 0.125f, v = bf2f(pr[C_GV + h * 128 + e]);
            S = eg * S + k * v;
            const float o = wave_sum(q * S);
            if (lane == 0) P.og[tok * 512 + h * 128 + e] = o;
        }
    }
}
__global__ void __launch_bounds__(256) k_gla_out(LayerP P) {
    const int lane = threadIdx.x & 63, gw = (blockIdx.x * blockDim.x + threadIdx.x) >> 6, ngw = (gridDim.x * blockDim.x) >> 6;
    for (int w = gw; w < TOK * 4; w += ngw) {
        const size_t tok = w / 4; const int h = w % 4;
        const float o0 = P.og[tok * 512 + h * 128 + lane], o1 = P.og[tok * 512 + h * 128 + 64 + lane];
        const float s = wave_sum(o0 * o0 + o1 * o1), r = 1.0f / sqrtf(s * (1.0f / 128.f) + EPS);
        const float g0 = bf2f(P.proj[tok * NP + C_GG + h * 128 + lane]), g1 = bf2f(P.proj[tok * NP + C_GG + h * 128 + 64 + lane]);
        P.mix[tok * DM + 1024 + h * 128 + lane] = (bf16_t)f2bf(o0 * r * P.gla_norm_w[lane] * siluf_(g0));
        P.mix[tok * DM + 1024 + h * 128 + 64 + lane] = (bf16_t)f2bf(o1 * r * P.gla_norm_w[64 + lane] * siluf_(g1));
    }
}
__global__ void __launch_bounds__(256) k_mla_fin(LayerP P) {
    const int lane = threadIdx.x & 63, gw = (blockIdx.x * blockDim.x + threadIdx.x) >> 6, ngw = (gridDim.x * blockDim.x) >> 6;
    for (int tok = gw; tok < TOK; tok += ngw) {
        const int b = tok / SEQ, s = tok % SEQ; const bf16_t* pr = P.proj + (size_t)tok * NP;
        float sq = 0.f;
#pragma unroll
        for (int j = 0; j < 6; ++j) { const float v = bf2f(pr[C_CQ + lane + 64 * j]); sq += v * v; }
        float sk = 0.f;
#pragma unroll
        for (int j = 0; j < 2; ++j) { const float v = bf2f(pr[C_CKV + lane + 64 * j]); sk += v * v; }
        const float rq = 1.0f / sqrtf(wave_sum(sq) * (1.0f / 384.f) + EPS), rk = 1.0f / sqrtf(wave_sum(sk) * (1.0f / 128.f) + EPS);
        const int i = lane & 31;
        const float inv_freq = powf(10000.0f, -(float)i / 32.0f), ang = (float)P.pos[tok] * inv_freq, cs = cosf(ang), sn = sinf(ang);
        const float kpe = bf2f(pr[C_KPE + lane]);
        for (int h = 0; h < 4; ++h) {
            const size_t ob = ((size_t)(b * 4 + h) * SEQ + s);
            {
                float q0 = bf2f(P.qraw[(size_t)tok * 768 + h * 192 + lane]) * rq, q1 = bf2f(P.qraw[(size_t)tok * 768 + h * 192 + 64 + lane]) * rq, q2 = bf2f(P.qraw[(size_t)tok * 768 + h * 192 + 128 + lane]) * rq;
                const float r = 1.0f / sqrtf(wave_sum(q0 * q0 + q1 * q1 + q2 * q2) * (1.0f / 192.f) + EPS);
                q0 *= r * P.qh_w[lane]; q1 *= r * P.qh_w[64 + lane]; q2 *= r * P.qh_w[128 + lane];
                const float oth = __shfl_xor(q2, 32);
                const float rot = (lane < 32) ? (q2 * cs - oth * sn) : (q2 * cs + oth * sn);
                bf16_t* o = P.qf + ob * 192; o[lane] = (bf16_t)f2bf(q0); o[64 + lane] = (bf16_t)f2bf(q1); o[128 + lane] = (bf16_t)f2bf(rot);
            }
            {
                float k0 = bf2f(P.kvraw[(size_t)tok * 1024 + h * 256 + lane]) * rk, k1 = bf2f(P.kvraw[(size_t)tok * 1024 + h * 256 + 64 + lane]) * rk, k2 = kpe;
                const float r = 1.0f / sqrtf(wave_sum(k0 * k0 + k1 * k1 + k2 * k2) * (1.0f / 192.f) + EPS);
                k0 *= r * P.kh_w[lane]; k1 *= r * P.kh_w[64 + lane]; k2 *= r * P.kh_w[128 + lane];
                const float oth = __shfl_xor(k2, 32);
                const float rot = (lane < 32) ? (k2 * cs - oth * sn) : (k2 * cs + oth * sn);
                bf16_t* o = P.kf + ob * 192; o[lane] = (bf16_t)f2bf(k0); o[64 + lane] = (bf16_t)f2bf(k1); o[128 + lane] = (bf16_t)f2bf(rot);
                bf16_t* vo = P.vf + ob * 128;
                vo[lane] = (bf16_t)f2bf(bf2f(P.kvraw[(size_t)tok * 1024 + h * 256 + 128 + lane]) * rk); vo[64 + lane] = (bf16_t)f2bf(bf2f(P.kvraw[(size_t)tok * 1024 + h * 256 + 192 + lane]) * rk);
            }
        }
    }
}
__global__ void __launch_bounds__(256) k_attn_naive(LayerP P) {
    const int lane = threadIdx.x & 63, gw = (blockIdx.x * blockDim.x + threadIdx.x) >> 6, ngw = (gridDim.x * blockDim.x) >> 6;
    const float scale = 0.07216878364870322f;
    for (int w = gw; w < NB * 4 * SEQ; w += ngw) {
        const int bh = w / SEQ, s = w % SEQ; const size_t base = (size_t)bh * SEQ;
        const bf16_t* q = P.qf + (base + s) * 192;
        const float q0 = bf2f(q[lane]) * scale, q1 = bf2f(q[64 + lane]) * scale, q2 = bf2f(q[128 + lane]) * scale;
        float m = -1e30f, l = 0.f, o0 = 0.f, o1 = 0.f;
        for (int j = 0; j <= s; ++j) {
            const bf16_t* k = P.kf + (base + j) * 192; const bf16_t* v = P.vf + (base + j) * 128;
            const float sc = wave_sum(q0 * bf2f(k[lane]) + q1 * bf2f(k[64 + lane]) + q2 * bf2f(k[128 + lane]));
            const float mn = fmaxf(m, sc), corr = expf(m - mn), p = expf(sc - mn);
            l = l * corr + p; o0 = o0 * corr + p * bf2f(v[lane]); o1 = o1 * corr + p * bf2f(v[64 + lane]); m = mn;
        }
        const int b = bh / 4, h = bh % 4; const size_t tok = (size_t)b * SEQ + s;
        const float g0 = bf2f(P.proj[tok * NP + C_MG + h * 128 + lane]), g1 = bf2f(P.proj[tok * NP + C_MG + h * 128 + 64 + lane]);
        P.mix[tok * DM + 1536 + h * 128 + lane] = (bf16_t)f2bf(o0 / l * siluf_(g0));
        P.mix[tok * DM + 1536 + h * 128 + 64 + lane] = (bf16_t)f2bf(o1 / l * siluf_(g1));
    }
}

constexpr size_t MiB = 1u << 20;
constexpr size_t WS_WIN = 1 * MiB;
constexpr size_t WS_WOUT = WS_WIN + 80 * MiB;
constexpr size_t WS_WUQ = WS_WOUT + 32 * MiB;
constexpr size_t WS_WUKV = WS_WUQ + 3 * MiB;
constexpr size_t WS_WGLU = WS_WUKV + 1 * MiB;
constexpr size_t WS_ABAR = WS_WGLU + 2 * MiB;
constexpr size_t WS_BBAR = WS_ABAR + 1 * MiB;
constexpr size_t WS_HB = WS_BBAR + 2 * MiB;
constexpr size_t WS_RSTD = WS_HB + 32 * MiB;
constexpr size_t WS_PROJ = WS_RSTD + 1 * MiB;
constexpr size_t WS_DTF = WS_PROJ + 80 * MiB;
constexpr size_t WS_DTV = WS_DTF + 1 * MiB;
constexpr size_t WS_XBCC = WS_DTV + 1 * MiB;
constexpr size_t WS_YS = WS_XBCC + 24 * MiB;
constexpr size_t WS_MIX = WS_YS + 16 * MiB;
constexpr size_t WS_HS = WS_MIX + 32 * MiB;
constexpr size_t WS_YG = WS_HS + 128 * MiB;
constexpr size_t WS_EG = WS_YG + 8 * MiB;
constexpr size_t WS_OG = WS_EG + 8 * MiB;
constexpr size_t WS_QRAW = WS_OG + 16 * MiB;
constexpr size_t WS_KVRAW = WS_QRAW + 12 * MiB;
constexpr size_t WS_QF = WS_KVRAW + 16 * MiB;
constexpr size_t WS_KF = WS_QF + 12 * MiB;
constexpr size_t WS_VF = WS_KF + 12 * MiB;
constexpr size_t WS_END = WS_VF + 8 * MiB;

extern "C" void kernel_launch(void* const* d_in, const int* in_sizes, int n_in, void* d_out, int out_size, void* d_ws, size_t ws_size, hipStream_t stream) {
    if (n_in != 30 || out_size != TOK * DM || ws_size < WS_END) { fprintf(stderr, "kernel_launch: unexpected shapes (n_in %d out %d ws %zu need %zu)\n", n_in, out_size, ws_size, (size_t)WS_END); return; }
    auto F = [&](int i) { return (const float*)d_in[i]; };
    unsigned char* ws = (unsigned char*)d_ws; float* out = (float*)d_out;
    bf16_t* win = (bf16_t*)(ws + WS_WIN); bf16_t* wout = (bf16_t*)(ws + WS_WOUT); bf16_t* wuq = (bf16_t*)(ws + WS_WUQ); bf16_t* wukv = (bf16_t*)(ws + WS_WUKV); bf16_t* wglu = (bf16_t*)(ws + WS_WGLU);
    float* abar = (float*)(ws + WS_ABAR); float* bbar = (float*)(ws + WS_BBAR);
    bf16_t* hb = (bf16_t*)(ws + WS_HB); float* rstd = (float*)(ws + WS_RSTD); bf16_t* proj = (bf16_t*)(ws + WS_PROJ); float* dtf = (float*)(ws + WS_DTF);
    k_wtrans<1><<<dim3(NP / 64, DM / 64, DEPTH), 256, 0, stream>>>(F(3), DM, D_IN, win, NP, F(2));
    k_wtrans<0><<<dim3(DM / 64, DM / 64, DEPTH), 256, 0, stream>>>(F(4), DM, DM, wout, DM, nullptr);
    k_wtrans<0><<<dim3(768 / 64, 384 / 64, DEPTH), 256, 0, stream>>>(F(25), 384, 768, wuq, 768, F(24));
    k_wtrans<0><<<dim3(1024 / 64, 128 / 64, DEPTH), 256, 0, stream>>>(F(27), 128, 1024, wukv, 1024, F(26));
    k_wtrans<0><<<dim3(512 / 64, 512 / 64, DEPTH), 256, 0, stream>>>(F(19), 512, 512, wglu, 512, nullptr);
    k_s5prep<<<(DEPTH * 32 * 64 + 255) / 256, 256, 0, stream>>>(F(11), F(12), F(13), F(14), F(15), abar, bbar);
    const int G = 256, NG = 2048;
    for (int l = 0; l < DEPTH; ++l) {
        const float* hin = (l == 0) ? F(0) : out;
        LayerP P{};
        P.conv_w = F(5) + (size_t)l * 4 * 768; P.conv_b = F(6) + (size_t)l * 768; P.dt_bias = F(7) + l * 8; P.a_log = F(8) + l * 8; P.ssd_d = F(9) + l * 8; P.ssd_norm_w = F(10) + l * 512;
        P.s5_c_re = F(16) + (size_t)l * 32 * 16 * 64; P.s5_c_im = F(17) + (size_t)l * 32 * 16 * 64; P.s5_d = F(18) + l * 512; P.abar = abar + (size_t)l * 32 * 64 * 2; P.bbar = bbar + (size_t)l * 32 * 64 * 32;
        P.gla_w2 = F(21) + (size_t)l * 16 * 256; P.gla_gb = F(22) + l * 256; P.gla_norm_w = F(23) + l * 128;
        P.qh_w = F(28) + l * 192; P.kh_w = F(29) + l * 192; P.pos = (const int*)d_in[1];
        P.proj = proj; P.dtf = dtf;
        P.xbcc = (float*)(ws + WS_XBCC); P.dtv = (float*)(ws + WS_DTV); P.ys = (float*)(ws + WS_YS); P.hs = (float*)(ws + WS_HS); P.eg = (float*)(ws + WS_EG); P.og = (float*)(ws + WS_OG);
        P.yg = (bf16_t*)(ws + WS_YG); P.mix = (bf16_t*)(ws + WS_MIX); P.qraw = (bf16_t*)(ws + WS_QRAW); P.kvraw = (bf16_t*)(ws + WS_KVRAW);
        P.qf = (bf16_t*)(ws + WS_QF); P.kf = (bf16_t*)(ws + WS_KF); P.vf = (bf16_t*)(ws + WS_VF);
        k_rowprep<<<NG, 256, 0, stream>>>(hin, hb, rstd);
        { pg8::Gemm g{}; g.A = hb; g.Bt = win + (size_t)l * NP * DM; g.M = TOK; g.N = NP; g.K = DM; g.lda = DM; g.ldb = DM;
          pg8::EpiP1 E{}; E.O = proj; E.rstd = rstd; E.dtf = dtf; k_gemm<pg8::EpiP1><<<G, 512, 0, stream>>>(g, E); }
        k_conv<<<NG, 256, 0, stream>>>(P);
        k_ssd_naive<<<512, 256, 0, stream>>>(P);
        k_ssd_out<<<NG, 256, 0, stream>>>(P);
        k_s5_scan<<<32, 256, 0, stream>>>(P);
        k_s5_out<<<NG, 256, 0, stream>>>(P);
        { pg8::Gemm g{}; g.A = P.yg; g.Bt = wglu + (size_t)l * 512 * 512; g.M = TOK; g.N = 512; g.K = 512; g.lda = 512; g.ldb = 512;
          pg8::EpiGlu E{}; E.yg = P.yg; E.proj = proj; E.bias = F(20) + l * 512; E.mix = P.mix; k_gemm<pg8::EpiGlu><<<G, 512, 0, stream>>>(g, E); }
        k_gla_gate<<<NG, 256, 0, stream>>>(P);
        k_gla_naive<<<512, 256, 0, stream>>>(P);
        k_gla_out<<<NG, 256, 0, stream>>>(P);
        { pg8::Gemm g{}; g.A = proj + C_CQ; g.Bt = wuq + (size_t)l * 768 * 384; g.M = TOK; g.N = 768; g.K = 384; g.lda = NP; g.ldb = 384;
          pg8::EpiBf16 E{}; E.O = P.qraw; E.ldc = 768; k_gemm<pg8::EpiBf16><<<G, 512, 0, stream>>>(g, E); }
        { pg8::Gemm g{}; g.A = proj + C_CKV; g.Bt = wukv + (size_t)l * 1024 * 128; g.M = TOK; g.N = 1024; g.K = 128; g.lda = NP; g.ldb = 128;
          pg8::EpiBf16 E{}; E.O = P.kvraw; E.ldc = 1024; k_gemm<pg8::EpiBf16><<<G, 512, 0, stream>>>(g, E); }
        k_mla_fin<<<NG, 256, 0, stream>>>(P);
        k_attn_naive<<<NG * 2, 256, 0, stream>>>(P);
        { pg8::Gemm g{}; g.A = P.mix; g.Bt = wout + (size_t)l * DM * DM; g.M = TOK; g.N = DM; g.K = DM; g.lda = DM; g.ldb = DM;
          pg8::EpiRes E{}; E.base = hin; E.out = out; k_gemm<pg8::EpiRes><<<G, 512, 0, stream>>>(g, E); }
    }
}
```

```cpp
#include <hip/hip_runtime.h>
#include <cstdio>
#include <cstdint>

#define LAS __attribute__((address_space(3)))
typedef unsigned short bf16_t;
typedef short bf16x8 __attribute__((ext_vector_type(8)));
typedef float f32x4 __attribute__((ext_vector_type(4)));
typedef unsigned u32x4 __attribute__((ext_vector_type(4)));
typedef unsigned u32x2 __attribute__((ext_vector_type(2)));

constexpr int DM = 2048, NB = 4, SEQ = 2048, DEPTH = 4, TOK = NB * SEQ;
constexpr int D_IN = 4952, NP = 5120;
constexpr float EPS = 1e-6f;
constexpr int C_Z = 0, C_XBC = 512, C_S5U = 1280, C_S5G = 1792, C_GQ = 2304, C_GK = 2560, C_GV = 2816, C_GG = 3328,
              C_CQ = 3840, C_CKV = 4224, C_KPE = 4352, C_DT = 4416, C_GLR = 4424, C_PAD = 4440, C_MG = 4608;
__host__ __device__ __forceinline__ int win_src_col(int n) {
    if (n < 1280) return n;
    if (n < C_GQ) return n + 8;
    if (n < C_CQ) return n + 8;
    if (n < C_KPE) return n + 24;
    if (n < C_DT) return n + 24;
    if (n < C_GLR) return n - C_DT + 1280;
    if (n < C_PAD) return n - C_GLR + 3848;
    if (n < C_MG) return -1;
    return n - C_MG + 4440;
}

__device__ __forceinline__ int lane_id() { int l; asm volatile("v_mbcnt_lo_u32_b32 %0, -1, 0\n\tv_mbcnt_hi_u32_b32 %0, -1, %0" : "=v"(l)); return l; }
__device__ __forceinline__ float bf2f(bf16_t v) { return __uint_as_float(((unsigned)v) << 16); }
__device__ __forceinline__ unsigned f2bf(float f) { unsigned u = __float_as_uint(f); return (u + 0x7fffu + ((u >> 16) & 1u)) >> 16; }
__device__ __forceinline__ unsigned pk2(float lo, float hi) { return f2bf(lo) | (f2bf(hi) << 16); }
__device__ __forceinline__ float wave_sum(float v) {
#pragma unroll
    for (int o = 1; o < 64; o <<= 1) v += __shfl_xor(v, o);
    return v;
}
__device__ __forceinline__ float sigmoidf_(float x) { return 1.0f / (1.0f + expf(-x)); }
__device__ __forceinline__ float siluf_(float x) { return x * sigmoidf_(x); }
__device__ __forceinline__ float softplusf_(float x) { return x > 20.f ? x : log1pf(expf(x)); }
__device__ __forceinline__ float gelu_tanh(float x) { const float c = 0.7978845608028654f; return 0.5f * x * (1.0f + tanhf(c * (x + 0.044715f * x * x * x))); }

namespace pg8 {
constexpr int BM = 256, BK = 64, HALF = 128, HTB = HALF * BK * 2, STAGE_BYTES = 8 * HTB, NXCD = 8, WGM = 8;
__host__ __device__ __forceinline__ int lds_byte(int r, int c) { const int st = (r >> 4) * 2 + (c >> 5), rr = r & 15, cc = c & 31, ob = rr * 64 + cc * 2; return st * 1024 + (ob ^ (((ob >> 9) & 1) << 5)); }
__host__ __device__ __forceinline__ void stage_rc(int b, int& R, int& C) { const int st = b / 1024, sb = b % 1024, swz = sb ^ (((sb >> 9) & 1) << 5); R = (st >> 1) * 16 + swz / 64; C = (st & 1) * 32 + (swz % 64) / 2; }
__host__ __device__ __forceinline__ int perm32(int rho) { const int n = rho >> 4, i = rho & 15; return 8 * (i >> 2) + 4 * n + (i & 3); }
struct Unit { int pm, pn; };
struct Gemm { const bf16_t* A; const bf16_t* Bt; int M, N, K, lda, ldb, pad; };
struct StaticOrder {
    int nM, nN, nwg, G, c;
    __host__ __device__ void init(int M, int N, int G_, int c_) { nM = M / BM; nN = N / BM; nwg = nM * nN; G = G_; c = c_; }
    __host__ __device__ bool next(int i, Unit& u) const {
        const long L = (long)i * G + c; if (L >= nwg) return false;
        int wgid = (int)L; { const int q = nwg / NXCD, r = nwg % NXCD, xcd = wgid % NXCD, off = wgid / NXCD; wgid = (xcd < r ? xcd * (q + 1) : r * (q + 1) + (xcd - r) * q) + off; }
        const int nig = WGM * nN, gid = wgid / nig, fm = gid * WGM, gsz = (nM - fm) < WGM ? (nM - fm) : WGM;
        u.pm = fm + ((wgid % nig) % gsz); u.pn = (wgid % nig) / gsz; return true;
    }
};
__device__ __forceinline__ unsigned cvt_pk_bf16(float lo, float hi) { unsigned r; asm volatile("v_cvt_pk_bf16_f32 %0, %1, %2" : "=v"(r) : "v"(lo), "v"(hi)); return r; }

template <class Epi, class Sched, bool ALIGN_EPI>
__device__ __forceinline__ void gemm_phase(LAS unsigned char* lds, const Gemm g, const Sched& S, const Epi& E, int wid_in) {
    int lane = lane_id(), wid = wid_in; asm volatile("" : "+v"(lane), "+s"(wid));
    const int tid = wid * 64 + lane, wr = wid >> 2, wc = wid & 3, fr = lane & 15, fq = lane >> 4;
    const int K = g.K, nt = K / BK;
    unsigned voffA[2], voffB[2];
#pragma unroll
    for (int i = 0; i < 2; ++i) { int R, C; stage_rc(tid * 16 + i * 8192, R, C); const int Rb = Epi::PERM ? ((R & ~31) + perm32(R & 31)) : R;
        voffA[i] = (unsigned)(R * g.lda + C) * 2u; voffB[i] = (unsigned)(Rb * g.ldb + C) * 2u; }
    const size_t kstep = (size_t)(BK * 2);
    const size_t hstepA = (size_t)HALF * g.lda * 2, hstepB = (size_t)HALF * g.ldb * 2;
    const size_t tstepA = 2 * hstepA, tstepB = 2 * hstepB;
    const unsigned ldsw = (unsigned)wid * 1024u;
    const int aoff = lds_byte(wr * 64 + fr, fq * 8), boff = lds_byte(wc * 32 + fr, fq * 8);
#define PG8_SA(b, h) (((b) * 2 + (h)) * HTB)
#define PG8_SB(b, h) ((4 + (b) * 2 + (h)) * HTB)
#define PG8_STAGE(bufoff, gbase, voff) do { _Pragma("unroll") for (int _i = 0; _i < 2; ++_i) \
        __builtin_amdgcn_global_load_lds((const unsigned*)((const char*)(gbase) + (voff)[_i]), (LAS unsigned*)(lds + (bufoff) + ldsw + _i * 8192), 16, 0, 0); } while (0)
#define PG8_LDA(dst, b, h) do { _Pragma("unroll") for (int m = 0; m < 4; ++m) _Pragma("unroll") for (int k = 0; k < 2; ++k) dst[m][k] = *(const LAS bf16x8*)(lds + PG8_SA(b, h) + aoff + m * 2048 + k * 1024); } while (0)
#define PG8_LDB(dst, b, h) do { _Pragma("unroll") for (int n = 0; n < 2; ++n) _Pragma("unroll") for (int k = 0; k < 2; ++k) dst[n][k] = *(const LAS bf16x8*)(lds + PG8_SB(b, h) + boff + n * 2048 + k * 1024); } while (0)
#define PG8_MMA(ai, bj, At, Bt) do { __builtin_amdgcn_s_setprio(1); _Pragma("unroll") for (int m = 0; m < 4; ++m) _Pragma("unroll") for (int n = 0; n < 2; ++n) _Pragma("unroll") for (int k = 0; k < 2; ++k) \
        acc[ai][bj][m][n] = __builtin_amdgcn_mfma_f32_16x16x32_bf16(Bt[n][k], At[m][k], acc[ai][bj][m][n], 0, 0, 0); __builtin_amdgcn_s_setprio(0); } while (0)
#define PG8_WAIT_V(n) asm volatile("s_waitcnt vmcnt(" #n ")" ::: "memory")
#define PG8_WAIT_L(n) asm volatile("s_waitcnt lgkmcnt(" #n ")" ::: "memory")
#define PG8_BAR __builtin_amdgcn_s_barrier()
#define PG8_SCHED __builtin_amdgcn_sched_barrier(0)
    Unit cur, nxt; int ui = 0;
    if (!S.next(0, cur)) return;
    f32x4 acc[2][2][4][2];
#pragma unroll
    for (int a = 0; a < 2; ++a)
#pragma unroll
        for (int b = 0; b < 2; ++b)
#pragma unroll
            for (int m = 0; m < 4; ++m)
#pragma unroll
                for (int n = 0; n < 2; ++n) acc[a][b][m][n] = (f32x4){0.f, 0.f, 0.f, 0.f};
    bf16x8 At[4][2], B0[2][2], B1[2][2];
    const char* cA = (const char*)g.A + (size_t)cur.pm * tstepA; const char* cB = (const char*)g.Bt + (size_t)cur.pn * tstepB;
    PG8_STAGE(PG8_SB(0, 0), cB, voffB); PG8_STAGE(PG8_SB(0, 1), cB + hstepB, voffB); PG8_STAGE(PG8_SA(0, 0), cA, voffA); PG8_STAGE(PG8_SA(0, 1), cA + hstepA, voffA);
    if (wr == 1) PG8_BAR;
    PG8_WAIT_V(2); PG8_BAR;
    PG8_STAGE(PG8_SB(1, 0), cB + kstep, voffB); PG8_STAGE(PG8_SA(1, 0), cA + kstep, voffA); PG8_STAGE(PG8_SB(1, 1), cB + hstepB + kstep, voffB);
    PG8_WAIT_V(6); PG8_BAR;
    for (;;) {
        const bool has_next = S.next(ui + 1, nxt);
        const char* nA = has_next ? (const char*)g.A + (size_t)nxt.pm * tstepA : cA; const char* nB = has_next ? (const char*)g.Bt + (size_t)nxt.pn * tstepB : cB;
        for (int t = 0; t < nt; t += 2) {
            const bool last = (t == nt - 2);
            const char* a1 = cA + (size_t)(t + 1) * kstep;
            const char* a2 = last ? nA : cA + (size_t)(t + 2) * kstep; const char* b2 = last ? nB : cB + (size_t)(t + 2) * kstep;
            const char* a3 = a2 + kstep; const char* b3 = b2 + kstep;
            PG8_LDB(B0, 0, 0); PG8_LDB(B1, 0, 1); PG8_SCHED; PG8_LDA(At, 0, 0); PG8_STAGE(PG8_SA(1, 1), a1 + hstepA, voffA);
            PG8_WAIT_V(8); PG8_WAIT_L(0); PG8_BAR; PG8_MMA(0, 0, At, B0); PG8_MMA(0, 1, At, B1); PG8_BAR; PG8_SCHED;
            PG8_LDA(At, 0, 1); PG8_STAGE(PG8_SB(0, 0), b2, voffB); PG8_STAGE(PG8_SB(0, 1), b2 + hstepB, voffB); PG8_STAGE(PG8_SA(0, 0), a2, voffA);
            PG8_WAIT_V(8); PG8_WAIT_L(0); PG8_BAR; PG8_MMA(1, 0, At, B0); PG8_MMA(1, 1, At, B1); PG8_BAR; PG8_SCHED;
            PG8_LDB(B0, 1, 0); PG8_LDB(B1, 1, 1); PG8_SCHED; PG8_LDA(At, 1, 0); PG8_STAGE(PG8_SA(0, 1), a2 + hstepA, voffA);
            PG8_WAIT_V(8); PG8_WAIT_L(0); PG8_BAR; PG8_MMA(0, 0, At, B0); PG8_MMA(0, 1, At, B1); PG8_BAR; PG8_SCHED;
            PG8_LDA(At, 1, 1); PG8_STAGE(PG8_SB(1, 0), b3, voffB); PG8_STAGE(PG8_SB(1, 1), b3 + hstepB, voffB); PG8_STAGE(PG8_SA(1, 0), a3, voffA);
            PG8_WAIT_V(8); PG8_WAIT_L(0); PG8_BAR; PG8_MMA(1, 0, At, B0); PG8_MMA(1, 1, At, B1); PG8_BAR; PG8_SCHED;
        }
        if constexpr (ALIGN_EPI) { if (wr == 0) PG8_BAR; }
        E(acc, cur, wr, wc, fr, fq);
        if (!has_next) break;
#pragma unroll
        for (int a = 0; a < 2; ++a)
#pragma unroll
            for (int b = 0; b < 2; ++b)
#pragma unroll
                for (int m = 0; m < 4; ++m)
#pragma unroll
                    for (int n = 0; n < 2; ++n) acc[a][b][m][n] = (f32x4){0.f, 0.f, 0.f, 0.f};
        cur = nxt; cA = nA; cB = nB; ++ui;
        if constexpr (ALIGN_EPI) { if (wr == 1) PG8_BAR; }
    }
    PG8_WAIT_V(0);
    if constexpr (!ALIGN_EPI) { if (wr == 0) PG8_BAR; }
    PG8_BAR;
#undef PG8_SA
#undef PG8_SB
#undef PG8_STAGE
#undef PG8_LDA
#undef PG8_LDB
#undef PG8_MMA
#undef PG8_WAIT_V
#undef PG8_WAIT_L
#undef PG8_BAR
#undef PG8_SCHED
}

struct EpiBf16 {
    static constexpr bool PERM = true;
    bf16_t* O; int ldc, pad;
    __device__ __forceinline__ void operator()(const f32x4 (&acc)[2][2][4][2], const Unit& u, int wr, int wc, int fr, int fq) const {
        const int row0 = u.pm * BM + wr * 64 + fr, col0 = u.pn * BM + wc * 32 + 8 * fq;
#pragma unroll
        for (int ai = 0; ai < 2; ++ai)
#pragma unroll
            for (int m = 0; m < 4; ++m) { bf16_t* rowp = O + (size_t)(row0 + ai * HALF + m * 16) * ldc + col0;
#pragma unroll
                for (int bj = 0; bj < 2; ++bj) { const f32x4 v0 = acc[ai][bj][m][0], v1 = acc[ai][bj][m][1];
                    u32x4 w; w.x = cvt_pk_bf16(v0[0], v0[1]); w.y = cvt_pk_bf16(v0[2], v0[3]); w.z = cvt_pk_bf16(v1[0], v1[1]); w.w = cvt_pk_bf16(v1[2], v1[3]);
                    *(u32x4*)(rowp + bj * HALF) = w; } }
    }
};
struct EpiP1 {
    static constexpr bool PERM = true;
    bf16_t* O; const float* rstd; float* dtf;
    __device__ __forceinline__ void operator()(const f32x4 (&acc)[2][2][4][2], const Unit& u, int wr, int wc, int fr, int fq) const {
        const int row0 = u.pm * BM + wr * 64 + fr, col0 = u.pn * BM + wc * 32 + 8 * fq;
        const bool isdt = (u.pn == C_DT / 256) && (wc * 32 + 8 * fq == C_DT % 256);
#pragma unroll
        for (int ai = 0; ai < 2; ++ai)
#pragma unroll
            for (int m = 0; m < 4; ++m) { const int row = row0 + ai * HALF + m * 16; const float rs = rstd[row]; bf16_t* rowp = O + (size_t)row * NP + col0;
#pragma unroll
                for (int bj = 0; bj < 2; ++bj) { const f32x4 v0 = acc[ai][bj][m][0] * rs, v1 = acc[ai][bj][m][1] * rs;
                    u32x4 w; w.x = cvt_pk_bf16(v0[0], v0[1]); w.y = cvt_pk_bf16(v0[2], v0[3]); w.z = cvt_pk_bf16(v1[0], v1[1]); w.w = cvt_pk_bf16(v1[2], v1[3]);
                    *(u32x4*)(rowp + bj * HALF) = w;
                    if (bj == 0 && isdt) { *(f32x4*)(dtf + (size_t)row * 8) = v0; *(f32x4*)(dtf + (size_t)row * 8 + 4) = v1; } } }
    }
};
struct EpiRes {
    static constexpr bool PERM = false;
    const float* base; float* out;
    __device__ __forceinline__ void operator()(const f32x4 (&acc)[2][2][4][2], const Unit& u, int wr, int wc, int fr, int fq) const {
        const int row0 = u.pm * BM + wr * 64 + fr, col0 = u.pn * BM + wc * 32 + 4 * fq;
#pragma unroll
        for (int ai = 0; ai < 2; ++ai)
#pragma unroll
            for (int m = 0; m < 4; ++m) { const size_t off = (size_t)(row0 + ai * HALF + m * 16) * DM + col0;
#pragma unroll
                for (int bj = 0; bj < 2; ++bj)
#pragma unroll
                    for (int n = 0; n < 2; ++n) { const size_t ix = off + bj * HALF + n * 16; const f32x4 b = *(const f32x4*)(base + ix); *(f32x4*)(out + ix) = b + acc[ai][bj][m][n]; } }
    }
};
struct EpiGlu {
    static constexpr bool PERM = true;
    const bf16_t* yg; const bf16_t* proj; const float* bias; bf16_t* mix;
    __device__ __forceinline__ void operator()(const f32x4 (&acc)[2][2][4][2], const Unit& u, int wr, int wc, int fr, int fq) const {
        const int row0 = u.pm * BM + wr * 64 + fr, col0 = u.pn * BM + wc * 32 + 8 * fq;
#pragma unroll
        for (int ai = 0; ai < 2; ++ai)
#pragma unroll
            for (int m = 0; m < 4; ++m) { const int row = row0 + ai * HALF + m * 16;
#pragma unroll
                for (int bj = 0; bj < 2; ++bj) { const int col = col0 + bj * HALF;
                    const u32x4 yv = *(const u32x4*)(yg + (size_t)row * 512 + col), gv = *(const u32x4*)(proj + (size_t)row * NP + C_S5G + col);
                    const f32x4 b0 = *(const f32x4*)(bias + col), b1 = *(const f32x4*)(bias + col + 4);
                    float o[8];
#pragma unroll
                    for (int j = 0; j < 8; ++j) { const unsigned yw = yv[j >> 1], gw = gv[j >> 1];
                        const float y = (j & 1) ? __uint_as_float(yw & 0xffff0000u) : __uint_as_float(yw << 16);
                        const float gt = (j & 1) ? __uint_as_float(gw & 0xffff0000u) : __uint_as_float(gw << 16);
                        const float a = (j < 4 ? acc[ai][bj][m][0][j & 3] : acc[ai][bj][m][1][j & 3]) + (j < 4 ? b0[j & 3] : b1[j & 3]);
                        o[j] = y * sigmoidf_(a) * siluf_(gt); }
                    u32x4 w; w.x = cvt_pk_bf16(o[0], o[1]); w.y = cvt_pk_bf16(o[2], o[3]); w.z = cvt_pk_bf16(o[4], o[5]); w.w = cvt_pk_bf16(o[6], o[7]);
                    *(u32x4*)(mix + (size_t)row * DM + 512 + col) = w; } }
    }
};
}


__device__ __forceinline__ void wtrans_read(const float* s, int Nsrc, const float* sc, int mode, int n0, int k0, LAS float* tile, int t256) {
    const int n = t256 & 63; int sn = n0 + n; if (mode == 1) sn = win_src_col(sn);
#pragma unroll 4
    for (int i = 0; i < 16; ++i) { const int k = i * 4 + (t256 >> 6); float v = 0.f; if (sn >= 0) { v = s[(size_t)(k0 + k) * Nsrc + sn]; if (sc) v *= sc[k0 + k]; } tile[k * 65 + n] = v; }
}
__device__ __forceinline__ void wtrans_write(bf16_t* d, int K, int n0, int k0, const LAS float* tile, int t256) {
    const int k = t256 & 63;
#pragma unroll 4
    for (int i = 0; i < 16; ++i) { const int n = i * 4 + (t256 >> 6); d[(size_t)(n0 + n) * K + k0 + k] = (bf16_t)f2bf(tile[k * 65 + n]); }
}
__device__ __forceinline__ void s5prep_item(int i, const float* a_re, const float* a_im, const float* log_dt, const float* b_re, const float* b_im, float* abar, float* bbar) {
    const int lg = i / 64;
    const double are = a_re[i], aim = a_im[i], delta = exp((double)log_dt[lg]);
    const double mag = exp(are * delta), abr = mag * cos(aim * delta), abi = mag * sin(aim * delta), den = are * are + aim * aim;
    const double cr = ((abr - 1.0) * are + abi * aim) / den, ci = (abi * are - (abr - 1.0) * aim) / den;
    abar[2 * i] = (float)abr; abar[2 * i + 1] = (float)abi;
#pragma unroll
    for (int j = 0; j < 16; ++j) { const double br = b_re[(size_t)i * 16 + j], bi = b_im[(size_t)i * 16 + j];
        bbar[(size_t)i * 32 + j] = (float)(cr * br - ci * bi); bbar[(size_t)i * 32 + 16 + j] = (float)(cr * bi + ci * br); }
}
__device__ __forceinline__ void k_rowprep(const float* h, bf16_t* hb, float* rstd, int lane, int gw, int ngw) {
    for (int row = gw; row < TOK; row += ngw) {
        const f32x4* xr = (const f32x4*)(h + (size_t)row * DM) + lane; f32x4 v[8]; float s = 0.f;
#pragma unroll
        for (int j = 0; j < 8; ++j) { v[j] = xr[64 * j]; s += (v[j].x * v[j].x + v[j].y * v[j].y) + (v[j].z * v[j].z + v[j].w * v[j].w); }
        s = wave_sum(s);
        if (lane == 0) rstd[row] = 1.0f / sqrtf(s * (1.0f / DM) + EPS);
        u32x2* o = (u32x2*)(hb + (size_t)row * DM) + lane;
#pragma unroll
        for (int j = 0; j < 8; ++j) { u32x2 w; w.x = pk2(v[j].x, v[j].y); w.y = pk2(v[j].z, v[j].w); o[64 * j] = w; }
    }
}

struct LayerP {
    const float *conv_w, *conv_b, *dt_bias, *a_log, *ssd_d, *ssd_norm_w;
    const float *s5_c_re, *s5_c_im, *s5_d, *abar, *bbar;
    const float *gla_w2, *gla_gb, *gla_norm_w;
    const float *qh_w, *kh_w;
    const int* pos;
    const bf16_t* proj; const float* dtf;
    float *xbcc, *dtv, *ys, *hs, *eg, *og;
    bf16_t *yg, *mix, *qraw, *kvraw, *qf, *kf, *vf;
};
__device__ __forceinline__ void k_conv(const LayerP& P, size_t gtid, size_t stride) {
    const size_t n = (size_t)TOK * 768;
    for (size_t i = gtid; i < n; i += stride) {
        const int tok = (int)(i / 768), c = (int)(i % 768), s = tok % SEQ;
        float a = P.conv_b[c];
#pragma unroll
        for (int k = 0; k < 4; ++k) { const int ss = s - 3 + k; if (ss >= 0) a += P.conv_w[k * 768 + c] * bf2f(P.proj[(size_t)(tok - 3 + k) * NP + C_XBC + c]); }
        P.xbcc[i] = siluf_(a);
        if (c < 8) P.dtv[(size_t)tok * 8 + c] = softplusf_(P.dtf[(size_t)tok * 8 + c] + P.dt_bias[c]);
    }
}
__device__ __forceinline__ void k_ssd_naive(const LayerP& P, int lane, int gw, int ngw) {
    for (int w = gw; w < NB * 8 * 64; w += ngw) {
        const int b = w / 512, h = (w / 64) % 8, p = w % 64, g = h / 4;
        const float A = -expf(P.a_log[h]), Dh = P.ssd_d[h];
        float hs = 0.f;
        for (int t = 0; t < SEQ; ++t) {
            const size_t tok = (size_t)b * SEQ + t; const float* xr = P.xbcc + tok * 768;
            const float dt = P.dtv[tok * 8 + h], x = xr[h * 64 + p], Bn = xr[512 + g * 64 + lane], Cn = xr[640 + g * 64 + lane];
            hs = expf(dt * A) * hs + (x * dt) * Bn;
            const float y = wave_sum(Cn * hs);
            if (lane == 0) P.ys[tok * 512 + h * 64 + p] = y + Dh * x;
        }
    }
}
__device__ __forceinline__ void k_ssd_out(const LayerP& P, int lane, int gw, int ngw) {
    for (int tok = gw; tok < TOK; tok += ngw) {
        float v[8]; float s = 0.f;
#pragma unroll
        for (int j = 0; j < 8; ++j) { const int c = lane * 8 + j; v[j] = P.ys[(size_t)tok * 512 + c] * siluf_(bf2f(P.proj[(size_t)tok * NP + C_Z + c])); s += v[j] * v[j]; }
        s = wave_sum(s); const float r = 1.0f / sqrtf(s * (1.0f / 512.f) + EPS);
#pragma unroll
        for (int j = 0; j < 8; ++j) { const int c = lane * 8 + j; P.mix[(size_t)tok * DM + c] = (bf16_t)f2bf(v[j] * r * P.ssd_norm_w[c]); }
    }
}
__device__ __forceinline__ void k_s5_scan(const LayerP& P, int lane, int gw, int ngw) {
    for (int w = gw; w < NB * 32; w += ngw) {
        const int b = w / 32, g = w % 32;
        const float ar = P.abar[(g * 64 + lane) * 2], ai = P.abar[(g * 64 + lane) * 2 + 1];
        float br[16], bi[16];
#pragma unroll
        for (int j = 0; j < 16; ++j) { br[j] = P.bbar[(size_t)(g * 64 + lane) * 32 + j]; bi[j] = P.bbar[(size_t)(g * 64 + lane) * 32 + 16 + j]; }
        float hr = 0.f, hi = 0.f;
        for (int t = 0; t < SEQ; ++t) {
            const size_t tok = (size_t)b * SEQ + t; const bf16_t* up = P.proj + tok * NP + C_S5U + g * 16;
            float ur = 0.f, ui = 0.f;
#pragma unroll
            for (int j = 0; j < 16; ++j) { const float u = bf2f(up[j]); ur += br[j] * u; ui += bi[j] * u; }
            const float nr = ar * hr - ai * hi + ur, ni = ar * hi + ai * hr + ui; hr = nr; hi = ni;
            float* o = P.hs + (tok * 32 + g) * 128; o[lane] = hr; o[64 + lane] = hi;
        }
    }
}
__device__ __forceinline__ void k_s5_out(const LayerP& P, size_t gtid, size_t stride) {
    const size_t n = (size_t)TOK * 512;
    for (size_t i = gtid; i < n; i += stride) {
        const size_t tok = i / 512; const int ch = (int)(i % 512), g = ch / 16, ii = ch % 16;
        const float* h = P.hs + (tok * 32 + g) * 128; const float* cr = P.s5_c_re + (size_t)(g * 16 + ii) * 64; const float* ci = P.s5_c_im + (size_t)(g * 16 + ii) * 64;
        float y = 0.f;
        for (int k = 0; k < 64; ++k) y += cr[k] * h[k] - ci[k] * h[64 + k];
        y += P.s5_d[ch] * bf2f(P.proj[tok * NP + C_S5U + ch]);
        P.yg[i] = (bf16_t)f2bf(gelu_tanh(y));
    }
}
__device__ __forceinline__ void k_gla_gate(const LayerP& P, size_t gtid, size_t stride) {
    const size_t n = (size_t)TOK * 256;
    for (size_t i = gtid; i < n; i += stride) {
        const size_t tok = i / 256; const int j = (int)(i % 256);
        float x = P.gla_gb[j];
#pragma unroll
        for (int r = 0; r < 16; ++r) x += bf2f(P.proj[tok * NP + C_GLR + r]) * P.gla_w2[r * 256 + j];
        const float ls = fminf(x, 0.f) - log1pf(expf(-fabsf(x)));
        P.eg[i] = expf(ls * (1.0f / 16.0f));
    }
}
__device__ __forceinline__ void k_gla_naive(const LayerP& P, int lane, int gw, int ngw) {
    for (int w = gw; w < NB * 4 * 128; w += ngw) {
        const int b = w / 512, h = (w / 128) % 4, e = w % 128;
        float S = 0.f;
        for (int t = 0; t < SEQ; ++t) {
            const size_t tok = (size_t)b * SEQ + t; const bf16_t* pr = P.proj + tok * NP;
            const float eg = P.eg[tok * 256 + h * 64 + lane], k = bf2f(pr[C_GK + h * 64 + lane]), q = bf2f(pr[C_GQ + h * 64 + lane]) * 0.125f, v = bf2f(pr[C_GV + h * 128 + e]);
            S = eg * S + k * v;
            const float o = wave_sum(q * S);
            if (lane == 0) P.og[tok * 512 + h * 128 + e] = o;
        }
    }
}
__device__ __forceinline__ void k_gla_out(const LayerP& P, int lane, int gw, int ngw) {
    for (int w = gw; w < TOK * 4; w += ngw) {
        const size_t tok = w / 4; const int h = w % 4;
        const float o0 = P.og[tok * 512 + h * 128 + lane], o1 = P.og[tok * 512 + h * 128 + 64 + lane];
        const float s = wave_sum(o0 * o0 + o1 * o1), r = 1.0f / sqrtf(s * (1.0f / 128.f) + EPS);
        const float g0 = bf2f(P.proj[tok * NP + C_GG + h * 128 + lane]), g1 = bf2f(P.proj[tok * NP + C_GG + h * 128 + 64 + lane]);
        P.mix[tok * DM + 1024 + h * 128 + lane] = (bf16_t)f2bf(o0 * r * P.gla_norm_w[lane] * siluf_(g0));
        P.mix[tok * DM + 1024 + h * 128 + 64 + lane] = (bf16_t)f2bf(o1 * r * P.gla_norm_w[64 + lane] * siluf_(g1));
    }
}
__device__ __forceinline__ void k_mla_fin(const LayerP& P, int lane, int gw, int ngw) {
    for (int tok = gw; tok < TOK; tok += ngw) {
        const int b = tok / SEQ, s = tok % SEQ; const bf16_t* pr = P.proj + (size_t)tok * NP;
        float sq = 0.f;
#pragma unroll
        for (int j = 0; j < 6; ++j) { const float v = bf2f(pr[C_CQ + lane + 64 * j]); sq += v * v; }
        float sk = 0.f;
#pragma unroll
        for (int j = 0; j < 2; ++j) { const float v = bf2f(pr[C_CKV + lane + 64 * j]); sk += v * v; }
        const float rq = 1.0f / sqrtf(wave_sum(sq) * (1.0f / 384.f) + EPS), rk = 1.0f / sqrtf(wave_sum(sk) * (1.0f / 128.f) + EPS);
        const int i = lane & 31;
        const float inv_freq = powf(10000.0f, -(float)i / 32.0f), ang = (float)P.pos[tok] * inv_freq, cs = cosf(ang), sn = sinf(ang);
        const float kpe = bf2f(pr[C_KPE + lane]);
        for (int h = 0; h < 4; ++h) {
            const size_t ob = ((size_t)(b * 4 + h) * SEQ + s);
            {
                float q0 = bf2f(P.qraw[(size_t)tok * 768 + h * 192 + lane]) * rq, q1 = bf2f(P.qraw[(size_t)tok * 768 + h * 192 + 64 + lane]) * rq, q2 = bf2f(P.qraw[(size_t)tok * 768 + h * 192 + 128 + lane]) * rq;
                const float r = 1.0f / sqrtf(wave_sum(q0 * q0 + q1 * q1 + q2 * q2) * (1.0f / 192.f) + EPS);
                q0 *= r * P.qh_w[lane]; q1 *= r * P.qh_w[64 + lane]; q2 *= r * P.qh_w[128 + lane];
                const float oth = __shfl_xor(q2, 32);
                const float rot = (lane < 32) ? (q2 * cs - oth * sn) : (q2 * cs + oth * sn);
                bf16_t* o = P.qf + ob * 192; o[lane] = (bf16_t)f2bf(q0); o[64 + lane] = (bf16_t)f2bf(q1); o[128 + lane] = (bf16_t)f2bf(rot);
            }
            {
                float k0 = bf2f(P.kvraw[(size_t)tok * 1024 + h * 256 + lane]) * rk, k1 = bf2f(P.kvraw[(size_t)tok * 1024 + h * 256 + 64 + lane]) * rk, k2 = kpe;
                const float r = 1.0f / sqrtf(wave_sum(k0 * k0 + k1 * k1 + k2 * k2) * (1.0f / 192.f) + EPS);
                k0 *= r * P.kh_w[lane]; k1 *= r * P.kh_w[64 + lane]; k2 *= r * P.kh_w[128 + lane];
                const float oth = __shfl_xor(k2, 32);
                const float rot = (lane < 32) ? (k2 * cs - oth * sn) : (k2 * cs + oth * sn);
                bf16_t* o = P.kf + ob * 192; o[lane] = (bf16_t)f2bf(k0); o[64 + lane] = (bf16_t)f2bf(k1); o[128 + lane] = (bf16_t)f2bf(rot);
                bf16_t* vo = P.vf + ob * 128;
                vo[lane] = (bf16_t)f2bf(bf2f(P.kvraw[(size_t)tok * 1024 + h * 256 + 128 + lane]) * rk); vo[64 + lane] = (bf16_t)f2bf(bf2f(P.kvraw[(size_t)tok * 1024 + h * 256 + 192 + lane]) * rk);
            }
        }
    }
}
__device__ __forceinline__ void k_attn_naive(const LayerP& P, int lane, int gw, int ngw) {
    const float scale = 0.07216878364870322f;
    for (int w = gw; w < NB * 4 * SEQ; w += ngw) {
        const int bh = w / SEQ, s = (bh & 1) ? (SEQ - 1 - w % SEQ) : (w % SEQ); const size_t base = (size_t)bh * SEQ;
        const bf16_t* q = P.qf + (base + s) * 192;
        const float q0 = bf2f(q[lane]) * scale, q1 = bf2f(q[64 + lane]) * scale, q2 = bf2f(q[128 + lane]) * scale;
        float m = -1e30f, l = 0.f, o0 = 0.f, o1 = 0.f;
        for (int j = 0; j <= s; ++j) {
            const bf16_t* k = P.kf + (base + j) * 192; const bf16_t* v = P.vf + (base + j) * 128;
            const float sc = wave_sum(q0 * bf2f(k[lane]) + q1 * bf2f(k[64 + lane]) + q2 * bf2f(k[128 + lane]));
            const float mn = fmaxf(m, sc), corr = expf(m - mn), p = expf(sc - mn);
            l = l * corr + p; o0 = o0 * corr + p * bf2f(v[lane]); o1 = o1 * corr + p * bf2f(v[64 + lane]); m = mn;
        }
        const int b = bh / 4, h = bh % 4; const size_t tok = (size_t)b * SEQ + s;
        const float g0 = bf2f(P.proj[tok * NP + C_MG + h * 128 + lane]), g1 = bf2f(P.proj[tok * NP + C_MG + h * 128 + 64 + lane]);
        P.mix[tok * DM + 1536 + h * 128 + lane] = (bf16_t)f2bf(o0 / l * siluf_(g0));
        P.mix[tok * DM + 1536 + h * 128 + 64 + lane] = (bf16_t)f2bf(o1 / l * siluf_(g1));
    }
}


#define XB_TMO      128
#define XB_XCNT(j)  (256  + 64 * (j))
#define XB_XSUB(j)  (1280 + 64 * (j))
#define XB_XGEN(j)  (2304 + 64 * (j))
#define XB_TOP      3328
#define XB_TOPGEN   3392
#define XCD_BAR_WORDS 3456
#define XB_SPIN_CAP (1u << 18)
__device__ __forceinline__ unsigned xb_ld(unsigned* p)              { return __hip_atomic_load(p, __ATOMIC_RELAXED, __HIP_MEMORY_SCOPE_AGENT); }
__device__ __forceinline__ unsigned xb_add(unsigned* p, unsigned v) { return __hip_atomic_fetch_add(p, v, __ATOMIC_RELAXED, __HIP_MEMORY_SCOPE_AGENT); }
__device__ __forceinline__ unsigned xb_xcc_id() { return (unsigned)__builtin_amdgcn_s_getreg((3 << 11) | 20) & 0xFu; }
#define XB_SPIN(cond, bar) do { unsigned _sp = 0; while (cond) { __builtin_amdgcn_s_sleep(1); \
    if ((++_sp & 255u) == 0u) { if (xb_ld(&(bar)[XB_TMO])) break; if (_sp > XB_SPIN_CAP) { atomicAdd(&(bar)[XB_TMO], 1u); break; } } } } while (0)
struct XcdBarrier { unsigned* bar; unsigned x; volatile LAS unsigned* st; };
__device__ __forceinline__ XcdBarrier xcd_barrier_post(unsigned* bar, volatile LAS unsigned* st, bool leader) {
    XcdBarrier b; b.bar = bar; b.x = xb_xcc_id(); b.st = st;
    if (leader) (void)xb_add(&bar[XB_XCNT(b.x)], 1u);
    return b;
}
__device__ __forceinline__ void xcd_barrier_complete(unsigned* bar, unsigned x, unsigned& nloc, unsigned& nx) {
    const unsigned G = gridDim.x * gridDim.y * gridDim.z;
    unsigned sum, cnt, mine, sp = 0u;
    for (;;) {
        sum = 0u; cnt = 0u; mine = 0u;
#pragma unroll
        for (unsigned j = 0; j < 16; ++j) { const unsigned c = xb_ld(&bar[XB_XCNT(j)]); sum += c; cnt += (c > 0u) ? 1u : 0u; mine = (j == x) ? c : mine; }
        if (sum == G) break;
        __builtin_amdgcn_s_sleep(1);
        if ((++sp & 255u) == 0u) { if (xb_ld(&bar[XB_TMO])) break; if (sp > XB_SPIN_CAP) { atomicAdd(&bar[XB_TMO], 1u); break; } }
    }
    nloc = mine > 0u ? mine : 1u; nx = cnt > 0u ? cnt : 1u;
}
__device__ __forceinline__ void xcd_barrier(const XcdBarrier& b, bool leader) {
    asm volatile("s_waitcnt vmcnt(0)" ::: "memory");
    __syncthreads();
    if (leader) {
        unsigned* bar = b.bar;
        __builtin_amdgcn_s_waitcnt(0);
        unsigned nloc = b.st[0], nx = b.st[1];
        if (nloc == 0u) { xcd_barrier_complete(bar, b.x, nloc, nx); b.st[0] = nloc; b.st[1] = nx; }
        const unsigned old = xb_add(&bar[XB_XSUB(b.x)], 1u);
        const unsigned gen = old / nloc;
        if (old + 1u == (gen + 1u) * nloc) {
            __builtin_amdgcn_fence(__ATOMIC_RELEASE, "agent");
            asm volatile("s_waitcnt vmcnt(0)" ::: "memory");
            const unsigned og = xb_add(&bar[XB_TOP], 1u);
            const unsigned tg = og / nx;
            if (og + 1u == (tg + 1u) * nx) xb_add(&bar[XB_TOPGEN], 1u);
            else XB_SPIN(xb_ld(&bar[XB_TOPGEN]) == tg, bar);
            __builtin_amdgcn_fence(__ATOMIC_ACQUIRE, "agent");
            xb_add(&bar[XB_XGEN(b.x)], 1u);
            asm volatile("s_waitcnt vmcnt(0)" ::: "memory");
        } else {
            XB_SPIN(xb_ld(&bar[XB_XGEN(b.x)]) == gen, bar);
            __builtin_amdgcn_fence(__ATOMIC_ACQUIRE, "agent");
            asm volatile("s_waitcnt vmcnt(0)" ::: "memory");
        }
    }
    __syncthreads();
}

constexpr size_t MiB = 1u << 20;
constexpr size_t WS_CTL = 0, CTL_ZERO_BYTES = 65536;
constexpr size_t WS_WIN = 1 * MiB;
constexpr size_t WS_WOUT = WS_WIN + 80 * MiB;
constexpr size_t WS_WUQ = WS_WOUT + 32 * MiB;
constexpr size_t WS_WUKV = WS_WUQ + 3 * MiB;
constexpr size_t WS_WGLU = WS_WUKV + 1 * MiB;
constexpr size_t WS_ABAR = WS_WGLU + 2 * MiB;
constexpr size_t WS_BBAR = WS_ABAR + 1 * MiB;
constexpr size_t WS_HB = WS_BBAR + 2 * MiB;
constexpr size_t WS_RSTD = WS_HB + 32 * MiB;
constexpr size_t WS_PROJ = WS_RSTD + 1 * MiB;
constexpr size_t WS_DTF = WS_PROJ + 80 * MiB;
constexpr size_t WS_DTV = WS_DTF + 1 * MiB;
constexpr size_t WS_XBCC = WS_DTV + 1 * MiB;
constexpr size_t WS_YS = WS_XBCC + 24 * MiB;
constexpr size_t WS_MIX = WS_YS + 16 * MiB;
constexpr size_t WS_HS = WS_MIX + 32 * MiB;
constexpr size_t WS_YG = WS_HS + 128 * MiB;
constexpr size_t WS_EG = WS_YG + 8 * MiB;
constexpr size_t WS_OG = WS_EG + 8 * MiB;
constexpr size_t WS_QRAW = WS_OG + 16 * MiB;
constexpr size_t WS_KVRAW = WS_QRAW + 12 * MiB;
constexpr size_t WS_QF = WS_KVRAW + 16 * MiB;
constexpr size_t WS_KF = WS_QF + 12 * MiB;
constexpr size_t WS_VF = WS_KF + 12 * MiB;
constexpr size_t WS_END = WS_VF + 8 * MiB;
constexpr int CW_BAR = 1024;

__device__ __forceinline__ void* uptr_(unsigned long long v) {
    const unsigned lo = __builtin_amdgcn_readfirstlane((unsigned)v), hi = __builtin_amdgcn_readfirstlane((unsigned)(v >> 32));
    return (void*)(((unsigned long long)hi << 32) | lo);
}
struct MegaArgs { const float* in[30]; float* out; unsigned char* ws; };
constexpr int LDS_TAB = pg8::STAGE_BYTES + 64, LDS_TOTAL = LDS_TAB + 256;

__global__ void __launch_bounds__(512, 2) mega_fwd(MegaArgs a) {
    __shared__ __attribute__((aligned(16))) unsigned char lds_raw[LDS_TOTAL];
    LAS unsigned char* lds = (LAS unsigned char*)lds_raw;
    const int wave_s = __builtin_amdgcn_readfirstlane((int)threadIdx.x >> 6);
    const int G = (int)gridDim.x, ngw = G * 8; const size_t gth = (size_t)G * 512;
#define IDS() int lane_ = lane_id(), wave_ = wave_s, bid_ = blockIdx.x; asm volatile("" : "+v"(lane_), "+s"(wave_), "+s"(bid_)); const int lane = lane_, wave = wave_, tid_ = wave_ * 64 + lane_, gw = bid_ * 8 + wave; (void)tid_; const size_t gtid = (size_t)bid_ * 512 + tid_; (void)lane; (void)gw; (void)gtid;
    volatile LAS unsigned* st = (volatile LAS unsigned*)(lds + pg8::STAGE_BYTES);
    { const int tid = wave_s * 64 + lane_id(); if (tid < 16) st[tid] = 0u; }
    __syncthreads();
    LAS unsigned long long* tab = (LAS unsigned long long*)(lds + LDS_TAB);
    { const int tid = wave_s * 64 + lane_id();
      if (tid < 30) tab[tid] = (unsigned long long)a.in[tid];
      if (tid == 30) tab[30] = (unsigned long long)a.out;
      if (tid == 31) tab[31] = (unsigned long long)a.ws; }
    __syncthreads();
#define TABP(i) ((const float*)uptr_(tab[i]))
#define WSP() ((unsigned char*)uptr_(tab[31]))
#define OUTP() ((float*)uptr_(tab[30]))
    (void)xcd_barrier_post((unsigned*)(WSP() + WS_CTL) + CW_BAR, st, wave_s == 0 && lane_id() == 0);
#define GRID_BAR() do { XcdBarrier b2_; b2_.bar = (unsigned*)(WSP() + WS_CTL) + CW_BAR; b2_.x = xb_xcc_id(); b2_.st = st; int w_ = wave_s; asm volatile("" : "+s"(w_)); xcd_barrier(b2_, (w_ * 64 + lane_id()) == 0); } while (0)
#define FIN(i) TABP(i)
    {
        unsigned char* ws = WSP();
        bf16_t* win = (bf16_t*)(ws + WS_WIN); bf16_t* wout = (bf16_t*)(ws + WS_WOUT); bf16_t* wuq = (bf16_t*)(ws + WS_WUQ); bf16_t* wukv = (bf16_t*)(ws + WS_WUKV); bf16_t* wglu = (bf16_t*)(ws + WS_WGLU);
        float* abar = (float*)(ws + WS_ABAR); float* bbar = (float*)(ws + WS_BBAR);
        constexpr int T0 = 80 * 32 * 4, T1 = 32 * 32 * 4, T2 = 12 * 6 * 4, T3 = 16 * 2 * 4, T4 = 8 * 8 * 4, TT = T0 + T1 + T2 + T3 + T4;
        IDS(); const int half = tid_ >> 8, t256 = tid_ & 255;
        LAS float* tile = (LAS float*)(lds + half * 16640);
        for (int it = (int)blockIdx.x; it * 2 < TT; it += G) {
            int r = it * 2 + half; const bool valid = r < TT;
            const float* s = nullptr; const float* sc = nullptr; bf16_t* d = nullptr; int K = 0, Nsrc = 0, Ndst = 0, mode = 0, tn = 1, tpl = 1;
            if (r < T0) { s = FIN(3); sc = FIN(2); d = win; K = DM; Nsrc = D_IN; Ndst = NP; mode = 1; tn = 80; tpl = 80 * 32; }
            else if ((r -= T0) < T1) { s = FIN(4); d = wout; K = DM; Nsrc = DM; Ndst = DM; tn = 32; tpl = 32 * 32; }
            else if ((r -= T1) < T2) { s = FIN(25); sc = FIN(24); d = wuq; K = 384; Nsrc = 768; Ndst = 768; tn = 12; tpl = 72; }
            else if ((r -= T2) < T3) { s = FIN(27); sc = FIN(26); d = wukv; K = 128; Nsrc = 1024; Ndst = 1024; tn = 16; tpl = 32; }
            else { r -= T3; s = FIN(19); d = wglu; K = 512; Nsrc = 512; Ndst = 512; tn = 8; tpl = 64; }
            const int l = r / tpl, r2 = r % tpl, n0 = (r2 % tn) * 64, k0 = (r2 / tn) * 64;
            if (valid) wtrans_read(s + (size_t)l * K * Nsrc, Nsrc, sc ? sc + (size_t)l * K : nullptr, mode, n0, k0, tile, t256);
            __syncthreads();
            if (valid) wtrans_write(d + (size_t)l * Ndst * K, K, n0, k0, tile, t256);
            __syncthreads();
        }
        if (gtid < (size_t)(DEPTH * 32 * 64)) s5prep_item((int)gtid, FIN(11), FIN(12), FIN(13), FIN(14), FIN(15), abar, bbar);
    }

#define MAKE_P() LayerP P; { unsigned char* ws = WSP(); \
        P.conv_w = FIN(5) + (size_t)l * 4 * 768; P.conv_b = FIN(6) + (size_t)l * 768; P.dt_bias = FIN(7) + l * 8; P.a_log = FIN(8) + l * 8; P.ssd_d = FIN(9) + l * 8; P.ssd_norm_w = FIN(10) + l * 512; \
        P.s5_c_re = FIN(16) + (size_t)l * 32 * 16 * 64; P.s5_c_im = FIN(17) + (size_t)l * 32 * 16 * 64; P.s5_d = FIN(18) + l * 512; P.abar = (float*)(ws + WS_ABAR) + (size_t)l * 32 * 64 * 2; P.bbar = (float*)(ws + WS_BBAR) + (size_t)l * 32 * 64 * 32; \
        P.gla_w2 = FIN(21) + (size_t)l * 16 * 256; P.gla_gb = FIN(22) + l * 256; P.gla_norm_w = FIN(23) + l * 128; \
        P.qh_w = FIN(28) + l * 192; P.kh_w = FIN(29) + l * 192; P.pos = (const int*)FIN(1); \
        P.proj = (bf16_t*)(ws + WS_PROJ); P.dtf = (float*)(ws + WS_DTF); \
        P.xbcc = (float*)(ws + WS_XBCC); P.dtv = (float*)(ws + WS_DTV); P.ys = (float*)(ws + WS_YS); P.hs = (float*)(ws + WS_HS); P.eg = (float*)(ws + WS_EG); P.og = (float*)(ws + WS_OG); \
        P.yg = (bf16_t*)(ws + WS_YG); P.mix = (bf16_t*)(ws + WS_MIX); P.qraw = (bf16_t*)(ws + WS_QRAW); P.kvraw = (bf16_t*)(ws + WS_KVRAW); \
        P.qf = (bf16_t*)(ws + WS_QF); P.kf = (bf16_t*)(ws + WS_KF); P.vf = (bf16_t*)(ws + WS_VF); }
#define RUN_GEMM(EPI, gA, gBt, gN, gK, glda, gldb, ESET) do { pg8::Gemm g; g.A = (gA); g.Bt = (gBt); g.M = TOK; g.N = (gN); g.K = (gK); g.lda = (glda); g.ldb = (gldb); g.pad = 0; \
        pg8::EPI E; ESET; int bid_ = blockIdx.x; asm volatile("" : "+s"(bid_)); pg8::StaticOrder S; S.init(g.M, g.N, G, bid_); pg8::gemm_phase<pg8::EPI, pg8::StaticOrder, true>(lds, g, S, E, wave_s); } while (0)

#pragma clang loop unroll(disable)
    for (int l = 0; l < DEPTH; ++l) {
        { IDS(); unsigned char* ws = WSP(); const float* hin = (l == 0) ? FIN(0) : (const float*)OUTP();
          k_rowprep(hin, (bf16_t*)(ws + WS_HB), (float*)(ws + WS_RSTD), lane, gw, ngw); }
        GRID_BAR();
        { unsigned char* ws = WSP();
          RUN_GEMM(EpiP1, (const bf16_t*)(ws + WS_HB), (const bf16_t*)(ws + WS_WIN) + (size_t)l * NP * DM, NP, DM, DM, DM,
                   (E.O = (bf16_t*)(ws + WS_PROJ), E.rstd = (const float*)(ws + WS_RSTD), E.dtf = (float*)(ws + WS_DTF))); }
        GRID_BAR();
        { IDS(); MAKE_P(); k_conv(P, gtid, gth); k_s5_scan(P, lane, gw, ngw); k_gla_gate(P, gtid, gth); }
        { unsigned char* ws = WSP();
          RUN_GEMM(EpiBf16, (const bf16_t*)(ws + WS_PROJ) + C_CQ, (const bf16_t*)(ws + WS_WUQ) + (size_t)l * 768 * 384, 768, 384, NP, 384, (E.O = (bf16_t*)(ws + WS_QRAW), E.ldc = 768, E.pad = 0)); }
        { unsigned char* ws = WSP();
          RUN_GEMM(EpiBf16, (const bf16_t*)(ws + WS_PROJ) + C_CKV, (const bf16_t*)(ws + WS_WUKV) + (size_t)l * 1024 * 128, 1024, 128, NP, 128, (E.O = (bf16_t*)(ws + WS_KVRAW), E.ldc = 1024, E.pad = 0)); }
        GRID_BAR();
        { IDS(); MAKE_P(); k_ssd_naive(P, lane, gw, ngw); k_s5_out(P, gtid, gth); k_gla_naive(P, lane, gw, ngw); k_mla_fin(P, lane, gw, ngw); }
        GRID_BAR();
        { IDS(); MAKE_P(); k_ssd_out(P, lane, gw, ngw); k_gla_out(P, lane, gw, ngw); k_attn_naive(P, lane, gw, ngw); }
        { unsigned char* ws = WSP();
          RUN_GEMM(EpiGlu, (const bf16_t*)(ws + WS_YG), (const bf16_t*)(ws + WS_WGLU) + (size_t)l * 512 * 512, 512, 512, 512, 512,
                   (E.yg = (const bf16_t*)(ws + WS_YG), E.proj = (const bf16_t*)(ws + WS_PROJ), E.bias = FIN(20) + l * 512, E.mix = (bf16_t*)(ws + WS_MIX))); }
        GRID_BAR();
        { unsigned char* ws = WSP(); const float* hin = (l == 0) ? FIN(0) : (const float*)OUTP();
          RUN_GEMM(EpiRes, (const bf16_t*)(ws + WS_MIX), (const bf16_t*)(ws + WS_WOUT) + (size_t)l * DM * DM, DM, DM, DM, DM, (E.base = hin, E.out = OUTP())); }
        if (l + 1 < DEPTH) GRID_BAR();
    }
}

extern "C" void kernel_launch(void* const* d_in, const int* in_sizes, int n_in, void* d_out, int out_size, void* d_ws, size_t ws_size, hipStream_t stream) {
    static int grid = 0;
    if (grid == 0) {
        if (n_in != 30 || out_size != TOK * DM || ws_size < WS_END) { fprintf(stderr, "kernel_launch: unexpected shapes (n_in %d out %d ws %zu need %zu)\n", n_in, out_size, ws_size, (size_t)WS_END); grid = -1; return; }
        int dev = 0, cus = 0;
        if (hipGetDevice(&dev) != hipSuccess || hipDeviceGetAttribute(&cus, hipDeviceAttributeMultiprocessorCount, dev) != hipSuccess || cus <= 0) { fprintf(stderr, "kernel_launch: device query failed\n"); grid = -1; return; }
        grid = cus;
    }
    if (grid < 0) return;
    (void)hipMemsetAsync((char*)d_ws + WS_CTL, 0, CTL_ZERO_BYTES, stream);
    MegaArgs a{};
    for (int i = 0; i < 30; ++i) a.in[i] = (const float*)d_in[i];
    a.out = (float*)d_out; a.ws = (unsigned char*)d_ws;
    hipLaunchKernelGGL(mega_fwd, dim3(grid), dim3(512), 0, stream, a);
}
```

```cpp
#include <hip/hip_runtime.h>
#include <cstdio>
#include <cstdint>

#define LAS __attribute__((address_space(3)))
typedef unsigned short bf16_t;
typedef short bf16x8 __attribute__((ext_vector_type(8)));
typedef float f32x4 __attribute__((ext_vector_type(4)));
typedef unsigned u32x4 __attribute__((ext_vector_type(4)));
typedef unsigned u32x2 __attribute__((ext_vector_type(2)));

constexpr int DM = 2048, NB = 4, SEQ = 2048, DEPTH = 4, TOK = NB * SEQ;
constexpr int D_IN = 4952, NP = 5120;
constexpr float EPS = 1e-6f;
constexpr int C_Z = 0, C_XBC = 512, C_S5U = 1280, C_S5G = 1792, C_GQ = 2304, C_GK = 2560, C_GV = 2816, C_GG = 3328,
              C_CQ = 3840, C_CKV = 4224, C_KPE = 4352, C_DT = 4416, C_GLR = 4424, C_PAD = 4440, C_MG = 4608;
__host__ __device__ __forceinline__ int win_src_col(int n) {
    if (n < 1280) return n;
    if (n < C_GQ) return n + 8;
    if (n < C_CQ) return n + 8;
    if (n < C_KPE) return n + 24;
    if (n < C_DT) return n + 24;
    if (n < C_GLR) return n - C_DT + 1280;
    if (n < C_PAD) return n - C_GLR + 3848;
    if (n < C_MG) return -1;
    return n - C_MG + 4440;
}

__device__ __forceinline__ int lane_id() { int l; asm volatile("v_mbcnt_lo_u32_b32 %0, -1, 0\n\tv_mbcnt_hi_u32_b32 %0, -1, %0" : "=v"(l)); return l; }
__device__ __forceinline__ float bf2f(bf16_t v) { return __uint_as_float(((unsigned)v) << 16); }
__device__ __forceinline__ unsigned f2bf(float f) { unsigned u = __float_as_uint(f); return (u + 0x7fffu + ((u >> 16) & 1u)) >> 16; }
__device__ __forceinline__ unsigned pk2(float lo, float hi) { return f2bf(lo) | (f2bf(hi) << 16); }
template <int X> __device__ __forceinline__ float swz_xor(float v) { return __int_as_float(__builtin_amdgcn_ds_swizzle(__float_as_int(v), (X << 10) | 0x1f)); }
__device__ __forceinline__ float xor32_other(float v, int lane) {
    auto r = __builtin_amdgcn_permlane32_swap(__float_as_uint(v), __float_as_uint(v), false, false);
    return __uint_as_float(lane < 32 ? r[1] : r[0]); }
__device__ __forceinline__ float wave_sum(float v) {
    v += swz_xor<1>(v); v += swz_xor<2>(v); v += swz_xor<4>(v); v += swz_xor<8>(v); v += swz_xor<16>(v);
    auto r = __builtin_amdgcn_permlane32_swap(__float_as_uint(v), __float_as_uint(v), false, false);
    return __uint_as_float(r[0]) + __uint_as_float(r[1]);
}
__device__ __forceinline__ float sigmoidf_(float x) { return 1.0f / (1.0f + expf(-x)); }
__device__ __forceinline__ float siluf_(float x) { return x * sigmoidf_(x); }
__device__ __forceinline__ float softplusf_(float x) { return x > 20.f ? x : log1pf(expf(x)); }
__device__ __forceinline__ float gelu_tanh(float x) { const float c = 0.7978845608028654f; return 0.5f * x * (1.0f + tanhf(c * (x + 0.044715f * x * x * x))); }

namespace pg8 {
constexpr int BM = 256, BK = 64, HALF = 128, HTB = HALF * BK * 2, STAGE_BYTES = 8 * HTB, NXCD = 8, WGM = 8;
__host__ __device__ __forceinline__ int lds_byte(int r, int c) { const int st = (r >> 4) * 2 + (c >> 5), rr = r & 15, cc = c & 31, ob = rr * 64 + cc * 2; return st * 1024 + (ob ^ (((ob >> 9) & 1) << 5)); }
__host__ __device__ __forceinline__ void stage_rc(int b, int& R, int& C) { const int st = b / 1024, sb = b % 1024, swz = sb ^ (((sb >> 9) & 1) << 5); R = (st >> 1) * 16 + swz / 64; C = (st & 1) * 32 + (swz % 64) / 2; }
__host__ __device__ __forceinline__ int perm32(int rho) { const int n = rho >> 4, i = rho & 15; return 8 * (i >> 2) + 4 * n + (i & 3); }
struct Unit { int pm, pn; };
struct Gemm { const bf16_t* A; const bf16_t* Bt; int M, N, K, lda, ldb, pad; };
struct StaticOrder {
    int nM, nN, nwg, G, c;
    __host__ __device__ void init(int M, int N, int G_, int c_) { nM = M / BM; nN = N / BM; nwg = nM * nN; G = G_; c = c_; }
    __host__ __device__ bool next(int i, Unit& u) const {
        const long L = (long)i * G + c; if (L >= nwg) return false;
        int wgid = (int)L; { const int q = nwg / NXCD, r = nwg % NXCD, xcd = wgid % NXCD, off = wgid / NXCD; wgid = (xcd < r ? xcd * (q + 1) : r * (q + 1) + (xcd - r) * q) + off; }
        const int nig = WGM * nN, gid = wgid / nig, fm = gid * WGM, gsz = (nM - fm) < WGM ? (nM - fm) : WGM;
        u.pm = fm + ((wgid % nig) % gsz); u.pn = (wgid % nig) / gsz; return true;
    }
};
__device__ __forceinline__ unsigned cvt_pk_bf16(float lo, float hi) { unsigned r; asm volatile("v_cvt_pk_bf16_f32 %0, %1, %2" : "=v"(r) : "v"(lo), "v"(hi)); return r; }

template <class Epi, class Sched, bool ALIGN_EPI>
__device__ __forceinline__ void gemm_phase(LAS unsigned char* lds, const Gemm g, const Sched& S, const Epi& E, int wid_in) {
    int lane = lane_id(), wid0 = wid_in; asm volatile("" : "+v"(lane), "+s"(wid0)); const int wid = __builtin_amdgcn_readfirstlane(wid0);
    const int tid = wid * 64 + lane, wr = wid >> 2, wc = wid & 3, fr = lane & 15, fq = lane >> 4;
    const int K = g.K, nt = K / BK;
    unsigned voffA[2], voffB[2];
#pragma unroll
    for (int i = 0; i < 2; ++i) { int R, C; stage_rc(tid * 16 + i * 8192, R, C); const int Rb = Epi::PERM ? ((R & ~31) + perm32(R & 31)) : R;
        voffA[i] = (unsigned)(R * g.lda + C) * 2u; voffB[i] = (unsigned)(Rb * g.ldb + C) * 2u; }
    const size_t kstep = (size_t)(BK * 2);
    const size_t hstepA = (size_t)HALF * g.lda * 2, hstepB = (size_t)HALF * g.ldb * 2;
    const size_t tstepA = 2 * hstepA, tstepB = 2 * hstepB;
    const unsigned ldsw = (unsigned)wid * 1024u;
    const int aoff = lds_byte(wr * 64 + fr, fq * 8), boff = lds_byte(wc * 32 + fr, fq * 8);
#define PG8_SA(b, h) (((b) * 2 + (h)) * HTB)
#define PG8_SB(b, h) ((4 + (b) * 2 + (h)) * HTB)
#define PG8_STAGE(bufoff, gbase, voff) do { _Pragma("unroll") for (int _i = 0; _i < 2; ++_i) \
        __builtin_amdgcn_global_load_lds((const unsigned*)((const char*)(gbase) + (voff)[_i]), (LAS unsigned*)(lds + (bufoff) + ldsw + _i * 8192), 16, 0, 0); } while (0)
#define PG8_LDA(dst, b, h) do { _Pragma("unroll") for (int m = 0; m < 4; ++m) _Pragma("unroll") for (int k = 0; k < 2; ++k) dst[m][k] = *(const LAS bf16x8*)(lds + PG8_SA(b, h) + aoff + m * 2048 + k * 1024); } while (0)
#define PG8_LDB(dst, b, h) do { _Pragma("unroll") for (int n = 0; n < 2; ++n) _Pragma("unroll") for (int k = 0; k < 2; ++k) dst[n][k] = *(const LAS bf16x8*)(lds + PG8_SB(b, h) + boff + n * 2048 + k * 1024); } while (0)
#define PG8_MMA(ai, bj, At, Bt) do { __builtin_amdgcn_s_setprio(1); _Pragma("unroll") for (int m = 0; m < 4; ++m) _Pragma("unroll") for (int n = 0; n < 2; ++n) _Pragma("unroll") for (int k = 0; k < 2; ++k) \
        acc[ai][bj][m][n] = __builtin_amdgcn_mfma_f32_16x16x32_bf16(Bt[n][k], At[m][k], acc[ai][bj][m][n], 0, 0, 0); __builtin_amdgcn_s_setprio(0); } while (0)
#define PG8_WAIT_V(n) asm volatile("s_waitcnt vmcnt(" #n ")" ::: "memory")
#define PG8_WAIT_L(n) asm volatile("s_waitcnt lgkmcnt(" #n ")" ::: "memory")
#define PG8_BAR __builtin_amdgcn_s_barrier()
#define PG8_SCHED __builtin_amdgcn_sched_barrier(0)
    Unit cur, nxt; int ui = 0;
    if (!S.next(0, cur)) return;
    f32x4 acc[2][2][4][2];
#pragma unroll
    for (int a = 0; a < 2; ++a)
#pragma unroll
        for (int b = 0; b < 2; ++b)
#pragma unroll
            for (int m = 0; m < 4; ++m)
#pragma unroll
                for (int n = 0; n < 2; ++n) acc[a][b][m][n] = (f32x4){0.f, 0.f, 0.f, 0.f};
    bf16x8 At[4][2], B0[2][2], B1[2][2];
    const char* cA = (const char*)g.A + (size_t)cur.pm * tstepA; const char* cB = (const char*)g.Bt + (size_t)cur.pn * tstepB;
    PG8_STAGE(PG8_SB(0, 0), cB, voffB); PG8_STAGE(PG8_SB(0, 1), cB + hstepB, voffB); PG8_STAGE(PG8_SA(0, 0), cA, voffA); PG8_STAGE(PG8_SA(0, 1), cA + hstepA, voffA);
    if (wr == 1) PG8_BAR;
    PG8_WAIT_V(2); PG8_BAR;
    PG8_STAGE(PG8_SB(1, 0), cB + kstep, voffB); PG8_STAGE(PG8_SA(1, 0), cA + kstep, voffA); PG8_STAGE(PG8_SB(1, 1), cB + hstepB + kstep, voffB);
    PG8_WAIT_V(6); PG8_BAR;
    for (;;) {
        const bool has_next = S.next(ui + 1, nxt);
        const char* nA = has_next ? (const char*)g.A + (size_t)nxt.pm * tstepA : cA; const char* nB = has_next ? (const char*)g.Bt + (size_t)nxt.pn * tstepB : cB;
        for (int t = 0; t < nt; t += 2) {
            const bool last = (t == nt - 2);
            const char* a1 = cA + (size_t)(t + 1) * kstep;
            const char* a2 = last ? nA : cA + (size_t)(t + 2) * kstep; const char* b2 = last ? nB : cB + (size_t)(t + 2) * kstep;
            const char* a3 = a2 + kstep; const char* b3 = b2 + kstep;
            PG8_LDB(B0, 0, 0); PG8_LDB(B1, 0, 1); PG8_SCHED; PG8_LDA(At, 0, 0); PG8_STAGE(PG8_SA(1, 1), a1 + hstepA, voffA);
            PG8_WAIT_V(8); PG8_WAIT_L(0); PG8_BAR; PG8_MMA(0, 0, At, B0); PG8_MMA(0, 1, At, B1); PG8_BAR; PG8_SCHED;
            PG8_LDA(At, 0, 1); PG8_STAGE(PG8_SB(0, 0), b2, voffB); PG8_STAGE(PG8_SB(0, 1), b2 + hstepB, voffB); PG8_STAGE(PG8_SA(0, 0), a2, voffA);
            PG8_WAIT_V(8); PG8_WAIT_L(0); PG8_BAR; PG8_MMA(1, 0, At, B0); PG8_MMA(1, 1, At, B1); PG8_BAR; PG8_SCHED;
            PG8_LDB(B0, 1, 0); PG8_LDB(B1, 1, 1); PG8_SCHED; PG8_LDA(At, 1, 0); PG8_STAGE(PG8_SA(0, 1), a2 + hstepA, voffA);
            PG8_WAIT_V(8); PG8_WAIT_L(0); PG8_BAR; PG8_MMA(0, 0, At, B0); PG8_MMA(0, 1, At, B1); PG8_BAR; PG8_SCHED;
            PG8_LDA(At, 1, 1); PG8_STAGE(PG8_SB(1, 0), b3, voffB); PG8_STAGE(PG8_SB(1, 1), b3 + hstepB, voffB); PG8_STAGE(PG8_SA(1, 0), a3, voffA);
            PG8_WAIT_V(8); PG8_WAIT_L(0); PG8_BAR; PG8_MMA(1, 0, At, B0); PG8_MMA(1, 1, At, B1); PG8_BAR; PG8_SCHED;
        }
        if constexpr (ALIGN_EPI) { if (wr == 0) PG8_BAR; }
        E(acc, cur, wr, wc, fr, fq);
        if (!has_next) break;
#pragma unroll
        for (int a = 0; a < 2; ++a)
#pragma unroll
            for (int b = 0; b < 2; ++b)
#pragma unroll
                for (int m = 0; m < 4; ++m)
#pragma unroll
                    for (int n = 0; n < 2; ++n) acc[a][b][m][n] = (f32x4){0.f, 0.f, 0.f, 0.f};
        cur = nxt; cA = nA; cB = nB; ++ui;
        if constexpr (ALIGN_EPI) { if (wr == 1) PG8_BAR; }
    }
    PG8_WAIT_V(0);
    if constexpr (!ALIGN_EPI) { if (wr == 0) PG8_BAR; }
    PG8_BAR;
#undef PG8_SA
#undef PG8_SB
#undef PG8_STAGE
#undef PG8_LDA
#undef PG8_LDB
#undef PG8_MMA
#undef PG8_WAIT_V
#undef PG8_WAIT_L
#undef PG8_BAR
#undef PG8_SCHED
}

struct EpiBf16 {
    static constexpr bool PERM = true;
    bf16_t* O; int ldc, pad;
    __device__ __forceinline__ void operator()(const f32x4 (&acc)[2][2][4][2], const Unit& u, int wr_, int wc_, int fr_, int fq_) const {
        const int ln_ = lane_id(), fr = ln_ & 15, fq = ln_ >> 4; (void)fr_; (void)fq_; const int wr = wr_, wc = wc_;
        const int row0 = u.pm * BM + wr * 64 + fr, col0 = u.pn * BM + wc * 32 + 8 * fq;
#pragma unroll
        for (int ai = 0; ai < 2; ++ai)
#pragma unroll
            for (int m = 0; m < 4; ++m) { bf16_t* rowp = O + (size_t)(row0 + ai * HALF + m * 16) * ldc + col0;
#pragma unroll
                for (int bj = 0; bj < 2; ++bj) { const f32x4 v0 = acc[ai][bj][m][0], v1 = acc[ai][bj][m][1];
                    u32x4 w; w.x = cvt_pk_bf16(v0[0], v0[1]); w.y = cvt_pk_bf16(v0[2], v0[3]); w.z = cvt_pk_bf16(v1[0], v1[1]); w.w = cvt_pk_bf16(v1[2], v1[3]);
                    *(u32x4*)(rowp + bj * HALF) = w; } }
    }
};
struct EpiP1 {
    static constexpr bool PERM = true;
    bf16_t* O; const float* rstd; float* dtf;
    __device__ __forceinline__ void operator()(const f32x4 (&acc)[2][2][4][2], const Unit& u, int wr_, int wc_, int fr_, int fq_) const {
        const int ln_ = lane_id(), fr = ln_ & 15, fq = ln_ >> 4; (void)fr_; (void)fq_; const int wr = wr_, wc = wc_;
        const int row0 = u.pm * BM + wr * 64 + fr, col0 = u.pn * BM + wc * 32 + 8 * fq;
        const bool isdt = (u.pn == C_DT / 256) && (wc * 32 + 8 * fq == C_DT % 256);
#pragma unroll
        for (int ai = 0; ai < 2; ++ai)
#pragma unroll
            for (int m = 0; m < 4; ++m) { const int row = row0 + ai * HALF + m * 16; const float rs = rstd[row]; bf16_t* rowp = O + (size_t)row * NP + col0;
#pragma unroll
                for (int bj = 0; bj < 2; ++bj) { const f32x4 v0 = acc[ai][bj][m][0] * rs, v1 = acc[ai][bj][m][1] * rs;
                    u32x4 w; w.x = cvt_pk_bf16(v0[0], v0[1]); w.y = cvt_pk_bf16(v0[2], v0[3]); w.z = cvt_pk_bf16(v1[0], v1[1]); w.w = cvt_pk_bf16(v1[2], v1[3]);
                    *(u32x4*)(rowp + bj * HALF) = w;
                    if (bj == 0 && isdt) { *(f32x4*)(dtf + (size_t)row * 8) = v0; *(f32x4*)(dtf + (size_t)row * 8 + 4) = v1; } } }
    }
};
struct EpiRes {
    static constexpr bool PERM = false;
    const float* base; float* out;
    __device__ __forceinline__ void operator()(const f32x4 (&acc)[2][2][4][2], const Unit& u, int wr_, int wc_, int fr_, int fq_) const {
        const int ln_ = lane_id(), fr = ln_ & 15, fq = ln_ >> 4; (void)fr_; (void)fq_; const int wr = wr_, wc = wc_;
        const int row0 = u.pm * BM + wr * 64 + fr, col0 = u.pn * BM + wc * 32 + 4 * fq;
#pragma unroll
        for (int ai = 0; ai < 2; ++ai)
#pragma unroll
            for (int m = 0; m < 4; ++m) { const size_t off = (size_t)(row0 + ai * HALF + m * 16) * DM + col0;
#pragma unroll
                for (int bj = 0; bj < 2; ++bj)
#pragma unroll
                    for (int n = 0; n < 2; ++n) { const size_t ix = off + bj * HALF + n * 16; const f32x4 b = *(const f32x4*)(base + ix); *(f32x4*)(out + ix) = b + acc[ai][bj][m][n]; } }
    }
};
struct EpiGlu {
    static constexpr bool PERM = true;
    const bf16_t* yg; const bf16_t* proj; const float* bias; bf16_t* mix;
    __device__ __forceinline__ void operator()(const f32x4 (&acc)[2][2][4][2], const Unit& u, int wr_, int wc_, int fr_, int fq_) const {
        const int ln_ = lane_id(), fr = ln_ & 15, fq = ln_ >> 4; (void)fr_; (void)fq_; const int wr = wr_, wc = wc_;
        const int row0 = u.pm * BM + wr * 64 + fr, col0 = u.pn * BM + wc * 32 + 8 * fq;
#pragma unroll
        for (int ai = 0; ai < 2; ++ai)
#pragma unroll
            for (int m = 0; m < 4; ++m) { const int row = row0 + ai * HALF + m * 16;
#pragma unroll
                for (int bj = 0; bj < 2; ++bj) { const int col = col0 + bj * HALF;
                    const u32x4 yv = *(const u32x4*)(yg + (size_t)row * 512 + col), gv = *(const u32x4*)(proj + (size_t)row * NP + C_S5G + col);
                    const f32x4 b0 = *(const f32x4*)(bias + col), b1 = *(const f32x4*)(bias + col + 4);
                    float o[8];
#pragma unroll
                    for (int j = 0; j < 8; ++j) { const unsigned yw = yv[j >> 1], gw = gv[j >> 1];
                        const float y = (j & 1) ? __uint_as_float(yw & 0xffff0000u) : __uint_as_float(yw << 16);
                        const float gt = (j & 1) ? __uint_as_float(gw & 0xffff0000u) : __uint_as_float(gw << 16);
                        const float a = (j < 4 ? acc[ai][bj][m][0][j & 3] : acc[ai][bj][m][1][j & 3]) + (j < 4 ? b0[j & 3] : b1[j & 3]);
                        o[j] = y * sigmoidf_(a) * siluf_(gt); }
                    u32x4 w; w.x = cvt_pk_bf16(o[0], o[1]); w.y = cvt_pk_bf16(o[2], o[3]); w.z = cvt_pk_bf16(o[4], o[5]); w.w = cvt_pk_bf16(o[6], o[7]);
                    *(u32x4*)(mix + (size_t)row * DM + 512 + col) = w; } }
    }
};
}


__device__ __forceinline__ void wtrans_read(const float* s, int Nsrc, const float* sc, int mode, int n0, int k0, LAS float* tile, int t256) {
    const int n = t256 & 63; int sn = n0 + n; if (mode == 1) sn = win_src_col(sn);
#pragma unroll 4
    for (int i = 0; i < 16; ++i) { const int k = i * 4 + (t256 >> 6); float v = 0.f; if (sn >= 0) { v = s[(size_t)(k0 + k) * Nsrc + sn]; if (sc) v *= sc[k0 + k]; } tile[k * 65 + n] = v; }
}
__device__ __forceinline__ void wtrans_write(bf16_t* d, int K, int n0, int k0, const LAS float* tile, int t256) {
    const int k = t256 & 63;
#pragma unroll 4
    for (int i = 0; i < 16; ++i) { const int n = i * 4 + (t256 >> 6); d[(size_t)(n0 + n) * K + k0 + k] = (bf16_t)f2bf(tile[k * 65 + n]); }
}
__device__ __forceinline__ void s5prep_item(int i, const float* a_re, const float* a_im, const float* log_dt, const float* b_re, const float* b_im, float* abar, float* bbar) {
    const int lg = i / 64;
    const double are = a_re[i], aim = a_im[i], delta = exp((double)log_dt[lg]);
    const double mag = exp(are * delta), abr = mag * cos(aim * delta), abi = mag * sin(aim * delta), den = are * are + aim * aim;
    const double cr = ((abr - 1.0) * are + abi * aim) / den, ci = (abi * are - (abr - 1.0) * aim) / den;
    abar[2 * i] = (float)abr; abar[2 * i + 1] = (float)abi;
#pragma unroll
    for (int j = 0; j < 16; ++j) { const double br = b_re[(size_t)i * 16 + j], bi = b_im[(size_t)i * 16 + j];
        bbar[(size_t)i * 32 + j] = (float)(cr * br - ci * bi); bbar[(size_t)i * 32 + 16 + j] = (float)(cr * bi + ci * br); }
}
__device__ __forceinline__ void k_rowprep(const float* h, bf16_t* hb, float* rstd, int lane, int gw, int ngw) {
    for (int row = gw; row < TOK; row += ngw) {
        const f32x4* xr = (const f32x4*)(h + (size_t)row * DM) + lane; f32x4 v[8]; float s = 0.f;
#pragma unroll
        for (int j = 0; j < 8; ++j) { v[j] = xr[64 * j]; s += (v[j].x * v[j].x + v[j].y * v[j].y) + (v[j].z * v[j].z + v[j].w * v[j].w); }
        s = wave_sum(s);
        if (lane == 0) rstd[row] = 1.0f / sqrtf(s * (1.0f / DM) + EPS);
        u32x2* o = (u32x2*)(hb + (size_t)row * DM) + lane;
#pragma unroll
        for (int j = 0; j < 8; ++j) { u32x2 w; w.x = pk2(v[j].x, v[j].y); w.y = pk2(v[j].z, v[j].w); o[64 * j] = w; }
    }
}

struct LayerP {
    const float *conv_w, *conv_b, *dt_bias, *a_log, *ssd_d, *ssd_norm_w;
    const float *s5_c_re, *s5_c_im, *s5_d, *abar, *bbar;
    const float *gla_w2, *gla_gb, *gla_norm_w;
    const float *qh_w, *kh_w;
    const int* pos;
    const bf16_t* proj; const float* dtf;
    float *xbcc, *dtv, *ys, *hs, *eg, *og;
    bf16_t *yg, *mix, *qraw, *kvraw, *qf, *kf, *vf, *vt;
};
__device__ __forceinline__ void k_conv(const LayerP& P, size_t gtid, size_t stride) {
    const size_t n = (size_t)TOK * 768;
    for (size_t i = gtid; i < n; i += stride) {
        const int tok = (int)(i / 768), c = (int)(i % 768), s = tok % SEQ;
        float a = P.conv_b[c];
#pragma unroll
        for (int k = 0; k < 4; ++k) { const int ss = s - 3 + k; if (ss >= 0) a += P.conv_w[k * 768 + c] * bf2f(P.proj[(size_t)(tok - 3 + k) * NP + C_XBC + c]); }
        P.xbcc[i] = siluf_(a);
        if (c < 8) P.dtv[(size_t)tok * 8 + c] = softplusf_(P.dtf[(size_t)tok * 8 + c] + P.dt_bias[c]);
    }
}
__device__ __forceinline__ void k_ssd_naive(const LayerP& P, int lane, int gw, int ngw) {
    for (int w = gw; w < NB * 8 * 64; w += ngw) {
        const int b = w / 512, h = (w / 64) % 8, p = w % 64, g = h / 4;
        const float A = -expf(P.a_log[h]), Dh = P.ssd_d[h];
        float hs = 0.f;
        for (int t = 0; t < SEQ; ++t) {
            const size_t tok = (size_t)b * SEQ + t; const float* xr = P.xbcc + tok * 768;
            const float dt = P.dtv[tok * 8 + h], x = xr[h * 64 + p], Bn = xr[512 + g * 64 + lane], Cn = xr[640 + g * 64 + lane];
            hs = expf(dt * A) * hs + (x * dt) * Bn;
            const float y = wave_sum(Cn * hs);
            if (lane == 0) P.ys[tok * 512 + h * 64 + p] = y + Dh * x;
        }
    }
}
__device__ __forceinline__ void k_ssd_out(const LayerP& P, int lane, int gw, int ngw) {
    for (int tok = gw; tok < TOK; tok += ngw) {
        float v[8]; float s = 0.f;
#pragma unroll
        for (int j = 0; j < 8; ++j) { const int c = lane * 8 + j; v[j] = P.ys[(size_t)tok * 512 + c] * siluf_(bf2f(P.proj[(size_t)tok * NP + C_Z + c])); s += v[j] * v[j]; }
        s = wave_sum(s); const float r = 1.0f / sqrtf(s * (1.0f / 512.f) + EPS);
#pragma unroll
        for (int j = 0; j < 8; ++j) { const int c = lane * 8 + j; P.mix[(size_t)tok * DM + c] = (bf16_t)f2bf(v[j] * r * P.ssd_norm_w[c]); }
    }
}
__device__ __forceinline__ void k_s5_scan(const LayerP& P, int lane, int gw, int ngw) {
    for (int w = gw; w < NB * 32; w += ngw) {
        const int b = w / 32, g = w % 32;
        const float ar = P.abar[(g * 64 + lane) * 2], ai = P.abar[(g * 64 + lane) * 2 + 1];
        float br[16], bi[16];
#pragma unroll
        for (int j = 0; j < 16; ++j) { br[j] = P.bbar[(size_t)(g * 64 + lane) * 32 + j]; bi[j] = P.bbar[(size_t)(g * 64 + lane) * 32 + 16 + j]; }
        float hr = 0.f, hi = 0.f;
        for (int t = 0; t < SEQ; ++t) {
            const size_t tok = (size_t)b * SEQ + t; const bf16_t* up = P.proj + tok * NP + C_S5U + g * 16;
            float ur = 0.f, ui = 0.f;
#pragma unroll
            for (int j = 0; j < 16; ++j) { const float u = bf2f(up[j]); ur += br[j] * u; ui += bi[j] * u; }
            const float nr = ar * hr - ai * hi + ur, ni = ar * hi + ai * hr + ui; hr = nr; hi = ni;
            float* o = P.hs + (tok * 32 + g) * 128; o[lane] = hr; o[64 + lane] = hi;
        }
    }
}
__device__ __forceinline__ void k_s5_out(const LayerP& P, size_t gtid, size_t stride) {
    const size_t n = (size_t)TOK * 512;
    for (size_t i = gtid; i < n; i += stride) {
        const size_t tok = i / 512; const int ch = (int)(i % 512), g = ch / 16, ii = ch % 16;
        const float* h = P.hs + (tok * 32 + g) * 128; const float* cr = P.s5_c_re + (size_t)(g * 16 + ii) * 64; const float* ci = P.s5_c_im + (size_t)(g * 16 + ii) * 64;
        float y = 0.f;
        for (int k = 0; k < 64; ++k) y += cr[k] * h[k] - ci[k] * h[64 + k];
        y += P.s5_d[ch] * bf2f(P.proj[tok * NP + C_S5U + ch]);
        P.yg[i] = (bf16_t)f2bf(gelu_tanh(y));
    }
}
__device__ __forceinline__ void k_gla_gate(const LayerP& P, size_t gtid, size_t stride) {
    const size_t n = (size_t)TOK * 256;
    for (size_t i = gtid; i < n; i += stride) {
        const size_t tok = i / 256; const int j = (int)(i % 256);
        float x = P.gla_gb[j];
#pragma unroll
        for (int r = 0; r < 16; ++r) x += bf2f(P.proj[tok * NP + C_GLR + r]) * P.gla_w2[r * 256 + j];
        const float ls = fminf(x, 0.f) - log1pf(expf(-fabsf(x)));
        P.eg[i] = expf(ls * (1.0f / 16.0f));
    }
}
__device__ __forceinline__ void k_gla_naive(const LayerP& P, int lane, int gw, int ngw) {
    for (int w = gw; w < NB * 4 * 128; w += ngw) {
        const int b = w / 512, h = (w / 128) % 4, e = w % 128;
        float S = 0.f;
        for (int t = 0; t < SEQ; ++t) {
            const size_t tok = (size_t)b * SEQ + t; const bf16_t* pr = P.proj + tok * NP;
            const float eg = P.eg[tok * 256 + h * 64 + lane], k = bf2f(pr[C_GK + h * 64 + lane]), q = bf2f(pr[C_GQ + h * 64 + lane]) * 0.125f, v = bf2f(pr[C_GV + h * 128 + e]);
            S = eg * S + k * v;
            const float o = wave_sum(q * S);
            if (lane == 0) P.og[tok * 512 + h * 128 + e] = o;
        }
    }
}
__device__ __forceinline__ void k_gla_out(const LayerP& P, int lane, int gw, int ngw) {
    for (int w = gw; w < TOK * 4; w += ngw) {
        const size_t tok = w / 4; const int h = w % 4;
        const float o0 = P.og[tok * 512 + h * 128 + lane], o1 = P.og[tok * 512 + h * 128 + 64 + lane];
        const float s = wave_sum(o0 * o0 + o1 * o1), r = 1.0f / sqrtf(s * (1.0f / 128.f) + EPS);
        const float g0 = bf2f(P.proj[tok * NP + C_GG + h * 128 + lane]), g1 = bf2f(P.proj[tok * NP + C_GG + h * 128 + 64 + lane]);
        P.mix[tok * DM + 1024 + h * 128 + lane] = (bf16_t)f2bf(o0 * r * P.gla_norm_w[lane] * siluf_(g0));
        P.mix[tok * DM + 1024 + h * 128 + 64 + lane] = (bf16_t)f2bf(o1 * r * P.gla_norm_w[64 + lane] * siluf_(g1));
    }
}
__device__ __forceinline__ void k_mla_fin(const LayerP& P, int lane, int gw, int ngw) {
    for (int tok = gw; tok < TOK; tok += ngw) {
        const int b = tok / SEQ, s = tok % SEQ; const bf16_t* pr = P.proj + (size_t)tok * NP;
        float sq = 0.f;
#pragma unroll
        for (int j = 0; j < 6; ++j) { const float v = bf2f(pr[C_CQ + lane + 64 * j]); sq += v * v; }
        float sk = 0.f;
#pragma unroll
        for (int j = 0; j < 2; ++j) { const float v = bf2f(pr[C_CKV + lane + 64 * j]); sk += v * v; }
        const float rq = 1.0f / sqrtf(wave_sum(sq) * (1.0f / 384.f) + EPS), rk = 1.0f / sqrtf(wave_sum(sk) * (1.0f / 128.f) + EPS);
        const int i = lane & 31;
        const float inv_freq = powf(10000.0f, -(float)i / 32.0f), ang = (float)P.pos[tok] * inv_freq, cs = cosf(ang), sn = sinf(ang);
        const float kpe = bf2f(pr[C_KPE + lane]);
        for (int h = 0; h < 4; ++h) {
            const size_t ob = ((size_t)(b * 4 + h) * SEQ + s);
            {
                float q0 = bf2f(P.qraw[(size_t)tok * 768 + h * 192 + lane]) * rq, q1 = bf2f(P.qraw[(size_t)tok * 768 + h * 192 + 64 + lane]) * rq, q2 = bf2f(P.qraw[(size_t)tok * 768 + h * 192 + 128 + lane]) * rq;
                const float r = 1.0f / sqrtf(wave_sum(q0 * q0 + q1 * q1 + q2 * q2) * (1.0f / 192.f) + EPS);
                q0 *= r * P.qh_w[lane]; q1 *= r * P.qh_w[64 + lane]; q2 *= r * P.qh_w[128 + lane];
                const float oth = xor32_other(q2, lane);
                const float rot = (lane < 32) ? (q2 * cs - oth * sn) : (q2 * cs + oth * sn);
                bf16_t* o = P.qf + ob * 192; o[lane] = (bf16_t)f2bf(q0); o[64 + lane] = (bf16_t)f2bf(q1); o[128 + lane] = (bf16_t)f2bf(rot);
            }
            {
                float k0 = bf2f(P.kvraw[(size_t)tok * 1024 + h * 256 + lane]) * rk, k1 = bf2f(P.kvraw[(size_t)tok * 1024 + h * 256 + 64 + lane]) * rk, k2 = kpe;
                const float r = 1.0f / sqrtf(wave_sum(k0 * k0 + k1 * k1 + k2 * k2) * (1.0f / 192.f) + EPS);
                k0 *= r * P.kh_w[lane]; k1 *= r * P.kh_w[64 + lane]; k2 *= r * P.kh_w[128 + lane];
                const float oth = xor32_other(k2, lane);
                const float rot = (lane < 32) ? (k2 * cs - oth * sn) : (k2 * cs + oth * sn);
                bf16_t* o = P.kf + ob * 192; o[lane] = (bf16_t)f2bf(k0); o[64 + lane] = (bf16_t)f2bf(k1); o[128 + lane] = (bf16_t)f2bf(rot);
                bf16_t* vo = P.vt + (size_t)(b * 4 + h) * 128 * SEQ + s;
                vo[(size_t)lane * SEQ] = (bf16_t)f2bf(bf2f(P.kvraw[(size_t)tok * 1024 + h * 256 + 128 + lane]) * rk); vo[(size_t)(64 + lane) * SEQ] = (bf16_t)f2bf(bf2f(P.kvraw[(size_t)tok * 1024 + h * 256 + 192 + lane]) * rk);
            }
        }
    }
}

constexpr int AT_KP = 200, AT_VP = 72, AT_PP = 72;
constexpr int AT_K_OFF = 0, AT_V_OFF = 64 * AT_KP * 2, AT_P_OFF = AT_V_OFF + 128 * AT_VP * 2, AT_LDS = AT_P_OFF + 8 * 16 * AT_PP * 2;
__device__ __forceinline__ float xmax16(float v) {
    v = fmaxf(v, swz_xor<1>(v)); v = fmaxf(v, swz_xor<2>(v)); v = fmaxf(v, swz_xor<4>(v)); v = fmaxf(v, swz_xor<8>(v)); return v; }
__device__ __forceinline__ float xsum16(float v) {
    v += swz_xor<1>(v); v += swz_xor<2>(v); v += swz_xor<4>(v); v += swz_xor<8>(v); return v; }
__device__ __forceinline__ void attn_unit(const LayerP& P, LAS unsigned char* lds, int unit, int wave, int lane) {
    const int bh = unit >> 4, p = unit & 15, grp = wave >> 2, wq = wave & 3, tid = wave * 64 + lane;
    const int qb = grp ? 31 - p : p, q0 = qb * 64 + wq * 16, ntiles = 32 - p;
    const int fr = lane & 15, fq = lane >> 4;
    const bf16_t* Q = P.qf + (size_t)bh * SEQ * 192; const bf16_t* K = P.kf + (size_t)bh * SEQ * 192; const bf16_t* VT = P.vt + (size_t)bh * 128 * SEQ;
    bf16x8 qa[6];
#pragma unroll
    for (int ks = 0; ks < 6; ++ks) qa[ks] = *(const bf16x8*)(Q + (size_t)(q0 + fr) * 192 + ks * 32 + fq * 8);
    f32x4 o[8];
#pragma unroll
    for (int e = 0; e < 8; ++e) o[e] = (f32x4){0.f, 0.f, 0.f, 0.f};
    float m[4], l[4];
#pragma unroll
    for (int r = 0; r < 4; ++r) { m[r] = -1e30f; l[r] = 0.f; }
    u32x4 kr[3], vr[2];
    int krow[3], kcol[3], vrow[2], vcol[2];
#pragma unroll
    for (int i = 0; i < 3; ++i) { const int c = tid + 512 * i; krow[i] = c / 24; kcol[i] = c % 24; }
#pragma unroll
    for (int i = 0; i < 2; ++i) { const int c = tid + 512 * i; vrow[i] = c >> 3; vcol[i] = c & 7; }
#pragma unroll
    for (int i = 0; i < 3; ++i) kr[i] = *(const u32x4*)(K + (size_t)krow[i] * 192 + kcol[i] * 8);
#pragma unroll
    for (int i = 0; i < 2; ++i) vr[i] = *(const u32x4*)(VT + (size_t)vrow[i] * SEQ + vcol[i] * 8);
    LAS unsigned char* Ks = lds + AT_K_OFF; LAS unsigned char* Vs = lds + AT_V_OFF; LAS unsigned char* Ps = lds + AT_P_OFF + wave * (16 * AT_PP * 2);
    const float SCL = 0.07216878364870322f * 1.4426950408889634f;
    for (int j = 0; j < ntiles; ++j) {
        __syncthreads();
#pragma unroll
        for (int i = 0; i < 3; ++i) *(LAS u32x4*)(Ks + (krow[i] * AT_KP + kcol[i] * 8) * 2) = kr[i];
#pragma unroll
        for (int i = 0; i < 2; ++i) *(LAS u32x4*)(Vs + (vrow[i] * AT_VP + vcol[i] * 8) * 2) = vr[i];
        __syncthreads();
        if (j + 1 < ntiles) {
#pragma unroll
            for (int i = 0; i < 3; ++i) kr[i] = *(const u32x4*)(K + (size_t)((j + 1) * 64 + krow[i]) * 192 + kcol[i] * 8);
#pragma unroll
            for (int i = 0; i < 2; ++i) vr[i] = *(const u32x4*)(VT + (size_t)vrow[i] * SEQ + (j + 1) * 64 + vcol[i] * 8);
        }
        if (j <= qb) {
            f32x4 s[4];
#pragma unroll
            for (int nt = 0; nt < 4; ++nt) { s[nt] = (f32x4){0.f, 0.f, 0.f, 0.f};
#pragma unroll
                for (int ks = 0; ks < 6; ++ks) { const bf16x8 kb = *(const LAS bf16x8*)(Ks + ((nt * 16 + fr) * AT_KP + ks * 32 + fq * 8) * 2);
                    s[nt] = __builtin_amdgcn_mfma_f32_16x16x32_bf16(qa[ks], kb, s[nt], 0, 0, 0); } }
            const bool diag = (j == qb);
            float alpha[4];
#pragma unroll
            for (int r = 0; r < 4; ++r) {
                const int rowl = wq * 16 + fq * 4 + r;
                float mx = -1e30f;
#pragma unroll
                for (int nt = 0; nt < 4; ++nt) { float v = s[nt][r] * SCL; if (diag && (nt * 16 + fr) > rowl) v = -1e30f; s[nt][r] = v; mx = fmaxf(mx, v); }
                mx = xmax16(mx);
                const float mn = fmaxf(m[r], mx); alpha[r] = exp2f(m[r] - mn); m[r] = mn;
                float rs = 0.f;
#pragma unroll
                for (int nt = 0; nt < 4; ++nt) { const float pv = exp2f(s[nt][r] - mn); s[nt][r] = pv; rs += pv; }
                rs = xsum16(rs); l[r] = l[r] * alpha[r] + rs;
            }
#pragma unroll
            for (int e = 0; e < 8; ++e)
#pragma unroll
                for (int r = 0; r < 4; ++r) o[e][r] *= alpha[r];
#pragma unroll
            for (int nt = 0; nt < 4; ++nt)
#pragma unroll
                for (int r = 0; r < 4; ++r) *(LAS bf16_t*)(Ps + ((fq * 4 + r) * AT_PP + nt * 16 + fr) * 2) = (bf16_t)f2bf(s[nt][r]);
            asm volatile("s_waitcnt lgkmcnt(0)" ::: "memory");
#pragma unroll
            for (int ks = 0; ks < 2; ++ks) { const bf16x8 pa = *(const LAS bf16x8*)(Ps + (fr * AT_PP + ks * 32 + fq * 8) * 2);
#pragma unroll
                for (int e = 0; e < 8; ++e) { const bf16x8 vb = *(const LAS bf16x8*)(Vs + ((e * 16 + fr) * AT_VP + ks * 32 + fq * 8) * 2);
                    o[e] = __builtin_amdgcn_mfma_f32_16x16x32_bf16(pa, vb, o[e], 0, 0, 0); } }
        }
    }
    const int b = bh >> 2, h = bh & 3;
#pragma unroll
    for (int r = 0; r < 4; ++r) { const size_t tok = (size_t)b * SEQ + q0 + fq * 4 + r; const float il = 1.0f / l[r];
#pragma unroll
        for (int e = 0; e < 8; ++e) { const int col = h * 128 + e * 16 + fr; const float g = bf2f(P.proj[tok * NP + C_MG + col]);
            P.mix[tok * DM + 1536 + col] = (bf16_t)f2bf(o[e][r] * il * siluf_(g)); } }
    __syncthreads();
}

__device__ __forceinline__ void k_attn_naive(const LayerP& P, int lane, int gw, int ngw) {
    const float scale = 0.07216878364870322f;
    for (int w = gw; w < NB * 4 * SEQ; w += ngw) {
        const int bh = w / SEQ, s = (bh & 1) ? (SEQ - 1 - w % SEQ) : (w % SEQ); const size_t base = (size_t)bh * SEQ;
        const bf16_t* q = P.qf + (base + s) * 192;
        const float q0 = bf2f(q[lane]) * scale, q1 = bf2f(q[64 + lane]) * scale, q2 = bf2f(q[128 + lane]) * scale;
        float m = -1e30f, l = 0.f, o0 = 0.f, o1 = 0.f;
        for (int j = 0; j <= s; ++j) {
            const bf16_t* k = P.kf + (base + j) * 192; const bf16_t* v = P.vf + (base + j) * 128;
            const float sc = wave_sum(q0 * bf2f(k[lane]) + q1 * bf2f(k[64 + lane]) + q2 * bf2f(k[128 + lane]));
            const float mn = fmaxf(m, sc), corr = expf(m - mn), p = expf(sc - mn);
            l = l * corr + p; o0 = o0 * corr + p * bf2f(v[lane]); o1 = o1 * corr + p * bf2f(v[64 + lane]); m = mn;
        }
        const int b = bh / 4, h = bh % 4; const size_t tok = (size_t)b * SEQ + s;
        const float g0 = bf2f(P.proj[tok * NP + C_MG + h * 128 + lane]), g1 = bf2f(P.proj[tok * NP + C_MG + h * 128 + 64 + lane]);
        P.mix[tok * DM + 1536 + h * 128 + lane] = (bf16_t)f2bf(o0 / l * siluf_(g0));
        P.mix[tok * DM + 1536 + h * 128 + 64 + lane] = (bf16_t)f2bf(o1 / l * siluf_(g1));
    }
}


#define XB_TMO      128
#define XB_XCNT(j)  (256  + 64 * (j))
#define XB_XSUB(j)  (1280 + 64 * (j))
#define XB_XGEN(j)  (2304 + 64 * (j))
#define XB_TOP      3328
#define XB_TOPGEN   3392
#define XCD_BAR_WORDS 3456
#define XB_SPIN_CAP (1u << 18)
__device__ __forceinline__ unsigned xb_ld(unsigned* p)              { return __hip_atomic_load(p, __ATOMIC_RELAXED, __HIP_MEMORY_SCOPE_AGENT); }
__device__ __forceinline__ unsigned xb_add(unsigned* p, unsigned v) { return __hip_atomic_fetch_add(p, v, __ATOMIC_RELAXED, __HIP_MEMORY_SCOPE_AGENT); }
__device__ __forceinline__ unsigned xb_xcc_id() { return (unsigned)__builtin_amdgcn_s_getreg((3 << 11) | 20) & 0xFu; }
#define XB_SPIN(cond, bar) do { unsigned _sp = 0; while (cond) { __builtin_amdgcn_s_sleep(1); \
    if ((++_sp & 255u) == 0u) { if (xb_ld(&(bar)[XB_TMO])) break; if (_sp > XB_SPIN_CAP) { atomicAdd(&(bar)[XB_TMO], 1u); break; } } } } while (0)
struct XcdBarrier { unsigned* bar; unsigned x; volatile LAS unsigned* st; };
__device__ __forceinline__ XcdBarrier xcd_barrier_post(unsigned* bar, volatile LAS unsigned* st, bool leader) {
    XcdBarrier b; b.bar = bar; b.x = xb_xcc_id(); b.st = st;
    if (leader) (void)xb_add(&bar[XB_XCNT(b.x)], 1u);
    return b;
}
__device__ __forceinline__ void xcd_barrier_complete(unsigned* bar, unsigned x, unsigned& nloc, unsigned& nx) {
    const unsigned G = gridDim.x * gridDim.y * gridDim.z;
    unsigned sum, cnt, mine, sp = 0u;
    for (;;) {
        sum = 0u; cnt = 0u; mine = 0u;
#pragma unroll
        for (unsigned j = 0; j < 16; ++j) { const unsigned c = xb_ld(&bar[XB_XCNT(j)]); sum += c; cnt += (c > 0u) ? 1u : 0u; mine = (j == x) ? c : mine; }
        if (sum == G) break;
        __builtin_amdgcn_s_sleep(1);
        if ((++sp & 255u) == 0u) { if (xb_ld(&bar[XB_TMO])) break; if (sp > XB_SPIN_CAP) { atomicAdd(&bar[XB_TMO], 1u); break; } }
    }
    nloc = mine > 0u ? mine : 1u; nx = cnt > 0u ? cnt : 1u;
}
__device__ __forceinline__ void xcd_barrier(const XcdBarrier& b, bool leader) {
    asm volatile("s_waitcnt vmcnt(0)" ::: "memory");
    __syncthreads();
    if (leader) {
        unsigned* bar = b.bar;
        __builtin_amdgcn_s_waitcnt(0);
        unsigned nloc = b.st[0], nx = b.st[1];
        if (nloc == 0u) { xcd_barrier_complete(bar, b.x, nloc, nx); b.st[0] = nloc; b.st[1] = nx; }
        const unsigned old = xb_add(&bar[XB_XSUB(b.x)], 1u);
        const unsigned gen = old / nloc;
        if (old + 1u == (gen + 1u) * nloc) {
            __builtin_amdgcn_fence(__ATOMIC_RELEASE, "agent");
            asm volatile("s_waitcnt vmcnt(0)" ::: "memory");
            const unsigned og = xb_add(&bar[XB_TOP], 1u);
            const unsigned tg = og / nx;
            if (og + 1u == (tg + 1u) * nx) xb_add(&bar[XB_TOPGEN], 1u);
            else XB_SPIN(xb_ld(&bar[XB_TOPGEN]) == tg, bar);
            __builtin_amdgcn_fence(__ATOMIC_ACQUIRE, "agent");
            xb_add(&bar[XB_XGEN(b.x)], 1u);
            asm volatile("s_waitcnt vmcnt(0)" ::: "memory");
        } else {
            XB_SPIN(xb_ld(&bar[XB_XGEN(b.x)]) == gen, bar);
            __builtin_amdgcn_fence(__ATOMIC_ACQUIRE, "agent");
            asm volatile("s_waitcnt vmcnt(0)" ::: "memory");
        }
    }
    __syncthreads();
}

constexpr size_t MiB = 1u << 20;
constexpr size_t WS_CTL = 0, CTL_ZERO_BYTES = 65536;
constexpr size_t WS_WIN = 1 * MiB;
constexpr size_t WS_WOUT = WS_WIN + 80 * MiB;
constexpr size_t WS_WUQ = WS_WOUT + 32 * MiB;
constexpr size_t WS_WUKV = WS_WUQ + 3 * MiB;
constexpr size_t WS_WGLU = WS_WUKV + 1 * MiB;
constexpr size_t WS_ABAR = WS_WGLU + 2 * MiB;
constexpr size_t WS_BBAR = WS_ABAR + 1 * MiB;
constexpr size_t WS_HB = WS_BBAR + 2 * MiB;
constexpr size_t WS_RSTD = WS_HB + 32 * MiB;
constexpr size_t WS_PROJ = WS_RSTD + 1 * MiB;
constexpr size_t WS_DTF = WS_PROJ + 80 * MiB;
constexpr size_t WS_DTV = WS_DTF + 1 * MiB;
constexpr size_t WS_XBCC = WS_DTV + 1 * MiB;
constexpr size_t WS_YS = WS_XBCC + 24 * MiB;
constexpr size_t WS_MIX = WS_YS + 16 * MiB;
constexpr size_t WS_HS = WS_MIX + 32 * MiB;
constexpr size_t WS_YG = WS_HS + 128 * MiB;
constexpr size_t WS_EG = WS_YG + 8 * MiB;
constexpr size_t WS_OG = WS_EG + 8 * MiB;
constexpr size_t WS_QRAW = WS_OG + 16 * MiB;
constexpr size_t WS_KVRAW = WS_QRAW + 12 * MiB;
constexpr size_t WS_QF = WS_KVRAW + 16 * MiB;
constexpr size_t WS_KF = WS_QF + 12 * MiB;
constexpr size_t WS_VF = WS_KF + 12 * MiB;
constexpr size_t WS_END = WS_VF + 8 * MiB;
constexpr int CW_BAR = 1024;

__device__ __forceinline__ void* uptr_(unsigned long long v) {
    const unsigned lo = __builtin_amdgcn_readfirstlane((unsigned)v), hi = __builtin_amdgcn_readfirstlane((unsigned)(v >> 32));
    return (void*)(((unsigned long long)hi << 32) | lo);
}
struct MegaArgs { const float* in[30]; float* out; unsigned char* ws; };
constexpr int LDS_TAB = pg8::STAGE_BYTES + 64, LDS_TOTAL = LDS_TAB + 256;

__global__ void __launch_bounds__(512, 2) mega_fwd(MegaArgs a) {
    __shared__ __attribute__((aligned(16))) unsigned char lds_raw[LDS_TOTAL];
    LAS unsigned char* lds = (LAS unsigned char*)lds_raw;
    const int wave_s = __builtin_amdgcn_readfirstlane((int)threadIdx.x >> 6);
    const int G = (int)gridDim.x, ngw = G * 8; const size_t gth = (size_t)G * 512;
#define IDS() int lane_ = lane_id(), wave_ = wave_s, bid_ = blockIdx.x; asm volatile("" : "+v"(lane_), "+s"(wave_), "+s"(bid_)); const int lane = lane_, wave = __builtin_amdgcn_readfirstlane(wave_), tid_ = wave * 64 + lane_, gw = __builtin_amdgcn_readfirstlane(bid_) * 8 + wave; (void)tid_; const size_t gtid = (size_t)bid_ * 512 + tid_; (void)lane; (void)gw; (void)gtid;
    volatile LAS unsigned* st = (volatile LAS unsigned*)(lds + pg8::STAGE_BYTES);
    { const int tid = wave_s * 64 + lane_id(); if (tid < 16) st[tid] = 0u; }
    __syncthreads();
    LAS unsigned long long* tab = (LAS unsigned long long*)(lds + LDS_TAB);
    { const int tid = wave_s * 64 + lane_id();
      if (tid < 30) tab[tid] = (unsigned long long)a.in[tid];
      if (tid == 30) tab[30] = (unsigned long long)a.out;
      if (tid == 31) tab[31] = (unsigned long long)a.ws; }
    __syncthreads();
#define TABP(i) ((const float*)uptr_(tab[i]))
#define WSP() ((unsigned char*)uptr_(tab[31]))
#define OUTP() ((float*)uptr_(tab[30]))
    (void)xcd_barrier_post((unsigned*)(WSP() + WS_CTL) + CW_BAR, st, wave_s == 0 && lane_id() == 0);
#define GRID_BAR() do { XcdBarrier b2_; b2_.bar = (unsigned*)(WSP() + WS_CTL) + CW_BAR; b2_.x = xb_xcc_id(); b2_.st = st; int w_ = wave_s; asm volatile("" : "+s"(w_)); xcd_barrier(b2_, (w_ * 64 + lane_id()) == 0); } while (0)
#define FIN(i) TABP(i)
    {
        unsigned char* ws = WSP();
        bf16_t* win = (bf16_t*)(ws + WS_WIN); bf16_t* wout = (bf16_t*)(ws + WS_WOUT); bf16_t* wuq = (bf16_t*)(ws + WS_WUQ); bf16_t* wukv = (bf16_t*)(ws + WS_WUKV); bf16_t* wglu = (bf16_t*)(ws + WS_WGLU);
        float* abar = (float*)(ws + WS_ABAR); float* bbar = (float*)(ws + WS_BBAR);
        constexpr int T0 = 80 * 32 * 4, T1 = 32 * 32 * 4, T2 = 12 * 6 * 4, T3 = 16 * 2 * 4, T4 = 8 * 8 * 4, TT = T0 + T1 + T2 + T3 + T4;
        IDS(); const int half = tid_ >> 8, t256 = tid_ & 255;
        LAS float* tile = (LAS float*)(lds + half * 16640);
        for (int it = (int)blockIdx.x; it * 2 < TT; it += G) {
            int r = it * 2 + half; const bool valid = r < TT;
            const float* s = nullptr; const float* sc = nullptr; bf16_t* d = nullptr; int K = 0, Nsrc = 0, Ndst = 0, mode = 0, tn = 1, tpl = 1;
            if (r < T0) { s = FIN(3); sc = FIN(2); d = win; K = DM; Nsrc = D_IN; Ndst = NP; mode = 1; tn = 80; tpl = 80 * 32; }
            else if ((r -= T0) < T1) { s = FIN(4); d = wout; K = DM; Nsrc = DM; Ndst = DM; tn = 32; tpl = 32 * 32; }
            else if ((r -= T1) < T2) { s = FIN(25); sc = FIN(24); d = wuq; K = 384; Nsrc = 768; Ndst = 768; tn = 12; tpl = 72; }
            else if ((r -= T2) < T3) { s = FIN(27); sc = FIN(26); d = wukv; K = 128; Nsrc = 1024; Ndst = 1024; tn = 16; tpl = 32; }
            else { r -= T3; s = FIN(19); d = wglu; K = 512; Nsrc = 512; Ndst = 512; tn = 8; tpl = 64; }
            const int l = r / tpl, r2 = r % tpl, n0 = (r2 % tn) * 64, k0 = (r2 / tn) * 64;
            if (valid) wtrans_read(s + (size_t)l * K * Nsrc, Nsrc, sc ? sc + (size_t)l * K : nullptr, mode, n0, k0, tile, t256);
            __syncthreads();
            if (valid) wtrans_write(d + (size_t)l * Ndst * K, K, n0, k0, tile, t256);
            __syncthreads();
        }
        if (gtid < (size_t)(DEPTH * 32 * 64)) s5prep_item((int)gtid, FIN(11), FIN(12), FIN(13), FIN(14), FIN(15), abar, bbar);
    }

#define MAKE_P() LayerP P; { unsigned char* ws = WSP(); \
        P.conv_w = FIN(5) + (size_t)l * 4 * 768; P.conv_b = FIN(6) + (size_t)l * 768; P.dt_bias = FIN(7) + l * 8; P.a_log = FIN(8) + l * 8; P.ssd_d = FIN(9) + l * 8; P.ssd_norm_w = FIN(10) + l * 512; \
        P.s5_c_re = FIN(16) + (size_t)l * 32 * 16 * 64; P.s5_c_im = FIN(17) + (size_t)l * 32 * 16 * 64; P.s5_d = FIN(18) + l * 512; P.abar = (float*)(ws + WS_ABAR) + (size_t)l * 32 * 64 * 2; P.bbar = (float*)(ws + WS_BBAR) + (size_t)l * 32 * 64 * 32; \
        P.gla_w2 = FIN(21) + (size_t)l * 16 * 256; P.gla_gb = FIN(22) + l * 256; P.gla_norm_w = FIN(23) + l * 128; \
        P.qh_w = FIN(28) + l * 192; P.kh_w = FIN(29) + l * 192; P.pos = (const int*)FIN(1); \
        P.proj = (bf16_t*)(ws + WS_PROJ); P.dtf = (float*)(ws + WS_DTF); \
        P.xbcc = (float*)(ws + WS_XBCC); P.dtv = (float*)(ws + WS_DTV); P.ys = (float*)(ws + WS_YS); P.hs = (float*)(ws + WS_HS); P.eg = (float*)(ws + WS_EG); P.og = (float*)(ws + WS_OG); \
        P.yg = (bf16_t*)(ws + WS_YG); P.mix = (bf16_t*)(ws + WS_MIX); P.qraw = (bf16_t*)(ws + WS_QRAW); P.kvraw = (bf16_t*)(ws + WS_KVRAW); \
        P.qf = (bf16_t*)(ws + WS_QF); P.kf = (bf16_t*)(ws + WS_KF); P.vf = (bf16_t*)(ws + WS_VF); P.vt = (bf16_t*)(ws + WS_VF); }
#define RUN_GEMM(EPI, gA, gBt, gN, gK, glda, gldb, ESET) do { pg8::Gemm g; g.A = (gA); g.Bt = (gBt); g.M = TOK; g.N = (gN); g.K = (gK); g.lda = (glda); g.ldb = (gldb); g.pad = 0; \
        pg8::EPI E; ESET; int bid_ = blockIdx.x; asm volatile("" : "+s"(bid_)); pg8::StaticOrder S; S.init(g.M, g.N, G, bid_); pg8::gemm_phase<pg8::EPI, pg8::StaticOrder, true>(lds, g, S, E, wave_s); } while (0)

#pragma clang loop unroll(disable)
    for (int l = 0; l < DEPTH; ++l) {
        { IDS(); unsigned char* ws = WSP(); const float* hin = (l == 0) ? FIN(0) : (const float*)OUTP();
          k_rowprep(hin, (bf16_t*)(ws + WS_HB), (float*)(ws + WS_RSTD), lane, gw, ngw); }
        GRID_BAR();
        { unsigned char* ws = WSP();
          RUN_GEMM(EpiP1, (const bf16_t*)(ws + WS_HB), (const bf16_t*)(ws + WS_WIN) + (size_t)l * NP * DM, NP, DM, DM, DM,
                   (E.O = (bf16_t*)(ws + WS_PROJ), E.rstd = (const float*)(ws + WS_RSTD), E.dtf = (float*)(ws + WS_DTF))); }
        GRID_BAR();
        { IDS(); MAKE_P(); k_conv(P, gtid, gth); k_s5_scan(P, lane, gw, ngw); k_gla_gate(P, gtid, gth); }
        { unsigned char* ws = WSP();
          RUN_GEMM(EpiBf16, (const bf16_t*)(ws + WS_PROJ) + C_CQ, (const bf16_t*)(ws + WS_WUQ) + (size_t)l * 768 * 384, 768, 384, NP, 384, (E.O = (bf16_t*)(ws + WS_QRAW), E.ldc = 768, E.pad = 0)); }
        { unsigned char* ws = WSP();
          RUN_GEMM(EpiBf16, (const bf16_t*)(ws + WS_PROJ) + C_CKV, (const bf16_t*)(ws + WS_WUKV) + (size_t)l * 1024 * 128, 1024, 128, NP, 128, (E.O = (bf16_t*)(ws + WS_KVRAW), E.ldc = 1024, E.pad = 0)); }
        GRID_BAR();
        { IDS(); MAKE_P(); k_ssd_naive(P, lane, gw, ngw); k_s5_out(P, gtid, gth); k_gla_naive(P, lane, gw, ngw); k_mla_fin(P, lane, gw, ngw); }
        GRID_BAR();
        { IDS(); MAKE_P(); k_ssd_out(P, lane, gw, ngw); k_gla_out(P, lane, gw, ngw);
          for (int u = bid_; u < 256; u += G) attn_unit(P, lds, u, wave, lane); }
        { unsigned char* ws = WSP();
          RUN_GEMM(EpiGlu, (const bf16_t*)(ws + WS_YG), (const bf16_t*)(ws + WS_WGLU) + (size_t)l * 512 * 512, 512, 512, 512, 512,
                   (E.yg = (const bf16_t*)(ws + WS_YG), E.proj = (const bf16_t*)(ws + WS_PROJ), E.bias = FIN(20) + l * 512, E.mix = (bf16_t*)(ws + WS_MIX))); }
        GRID_BAR();
        { unsigned char* ws = WSP(); const float* hin = (l == 0) ? FIN(0) : (const float*)OUTP();
          RUN_GEMM(EpiRes, (const bf16_t*)(ws + WS_MIX), (const bf16_t*)(ws + WS_WOUT) + (size_t)l * DM * DM, DM, DM, DM, DM, (E.base = hin, E.out = OUTP())); }
        if (l + 1 < DEPTH) GRID_BAR();
    }
}

extern "C" void kernel_launch(void* const* d_in, const int* in_sizes, int n_in, void* d_out, int out_size, void* d_ws, size_t ws_size, hipStream_t stream) {
    static int grid = 0;
    if (grid == 0) {
        if (n_in != 30 || out_size != TOK * DM || ws_size < WS_END) { fprintf(stderr, "kernel_launch: unexpected shapes (n_in %d out %d ws %zu need %zu)\n", n_in, out_size, ws_size, (size_t)WS_END); grid = -1; return; }
        int dev = 0, cus = 0;
        if (hipGetDevice(&dev) != hipSuccess || hipDeviceGetAttribute(&cus, hipDeviceAttributeMultiprocessorCount, dev) != hipSuccess || cus <= 0) { fprintf(stderr, "kernel_launch: device query failed\n"); grid = -1; return; }
        grid = cus;
    }
    if (grid < 0) return;
    (void)hipMemsetAsync((char*)d_ws + WS_CTL, 0, CTL_ZERO_BYTES, stream);
    MegaArgs a{};
    for (int i = 0; i < 30; ++i) a.in[i] = (const float*)d_in[i];
    a.out = (float*)d_out; a.ws = (unsigned char*)d_ws;
    hipLaunchKernelGGL(mega_fwd, dim3(grid), dim3(512), 0, stream, a);
}
```

```cpp
#include <hip/hip_runtime.h>
#include <cstdio>
#include <cstdint>

#define LAS __attribute__((address_space(3)))
typedef unsigned short bf16_t;
typedef short bf16x8 __attribute__((ext_vector_type(8)));
typedef float f32x4 __attribute__((ext_vector_type(4)));
typedef unsigned u32x4 __attribute__((ext_vector_type(4)));
typedef unsigned u32x2 __attribute__((ext_vector_type(2)));

constexpr int DM = 2048, NB = 4, SEQ = 2048, DEPTH = 4, TOK = NB * SEQ;
constexpr int D_IN = 4952, NP = 5120;
constexpr float EPS = 1e-6f;
constexpr int C_Z = 0, C_XBC = 512, C_S5U = 1280, C_S5G = 1792, C_GQ = 2304, C_GK = 2560, C_GV = 2816, C_GG = 3328,
              C_CQ = 3840, C_CKV = 4224, C_KPE = 4352, C_DT = 4416, C_GLR = 4424, C_PAD = 4440, C_MG = 4608;
__host__ __device__ __forceinline__ int win_src_col(int n) {
    if (n < 1280) return n;
    if (n < C_GQ) return n + 8;
    if (n < C_CQ) return n + 8;
    if (n < C_KPE) return n + 24;
    if (n < C_DT) return n + 24;
    if (n < C_GLR) return n - C_DT + 1280;
    if (n < C_PAD) return n - C_GLR + 3848;
    if (n < C_MG) return -1;
    return n - C_MG + 4440;
}

__device__ __forceinline__ int lane_id() { int l; asm volatile("v_mbcnt_lo_u32_b32 %0, -1, 0\n\tv_mbcnt_hi_u32_b32 %0, -1, %0" : "=v"(l)); return l; }
__device__ __forceinline__ float bf2f(bf16_t v) { return __uint_as_float(((unsigned)v) << 16); }
__device__ __forceinline__ unsigned f2bf(float f) { unsigned u = __float_as_uint(f); return (u + 0x7fffu + ((u >> 16) & 1u)) >> 16; }
__device__ __forceinline__ unsigned pk2(float lo, float hi) { return f2bf(lo) | (f2bf(hi) << 16); }
template <int X> __device__ __forceinline__ float swz_xor(float v) { return __int_as_float(__builtin_amdgcn_ds_swizzle(__float_as_int(v), (X << 10) | 0x1f)); }
__device__ __forceinline__ float xor32_other(float v, int lane) {
    auto r = __builtin_amdgcn_permlane32_swap(__float_as_uint(v), __float_as_uint(v), false, false);
    return __uint_as_float(lane < 32 ? r[1] : r[0]); }
__device__ __forceinline__ float wave_sum(float v) {
    v += swz_xor<1>(v); v += swz_xor<2>(v); v += swz_xor<4>(v); v += swz_xor<8>(v); v += swz_xor<16>(v);
    auto r = __builtin_amdgcn_permlane32_swap(__float_as_uint(v), __float_as_uint(v), false, false);
    return __uint_as_float(r[0]) + __uint_as_float(r[1]);
}
__device__ __forceinline__ float xmax16(float v) {
    v = fmaxf(v, swz_xor<1>(v)); v = fmaxf(v, swz_xor<2>(v)); v = fmaxf(v, swz_xor<4>(v)); v = fmaxf(v, swz_xor<8>(v)); return v; }
__device__ __forceinline__ float xsum16(float v) {
    v += swz_xor<1>(v); v += swz_xor<2>(v); v += swz_xor<4>(v); v += swz_xor<8>(v); return v; }
__device__ __forceinline__ float sigmoidf_(float x) { return 1.0f / (1.0f + expf(-x)); }
__device__ __forceinline__ float siluf_(float x) { return x * sigmoidf_(x); }
__device__ __forceinline__ float softplusf_(float x) { return x > 20.f ? x : log1pf(expf(x)); }
__device__ __forceinline__ float gelu_tanh(float x) { const float c = 0.7978845608028654f; return 0.5f * x * (1.0f + tanhf(c * (x + 0.044715f * x * x * x))); }

namespace pg8 {
constexpr int BM = 256, BK = 64, HALF = 128, HTB = HALF * BK * 2, STAGE_BYTES = 8 * HTB, NXCD = 8, WGM = 8;
__host__ __device__ __forceinline__ int lds_byte(int r, int c) { const int st = (r >> 4) * 2 + (c >> 5), rr = r & 15, cc = c & 31, ob = rr * 64 + cc * 2; return st * 1024 + (ob ^ (((ob >> 9) & 1) << 5)); }
__host__ __device__ __forceinline__ void stage_rc(int b, int& R, int& C) { const int st = b / 1024, sb = b % 1024, swz = sb ^ (((sb >> 9) & 1) << 5); R = (st >> 1) * 16 + swz / 64; C = (st & 1) * 32 + (swz % 64) / 2; }
__host__ __device__ __forceinline__ int perm32(int rho) { const int n = rho >> 4, i = rho & 15; return 8 * (i >> 2) + 4 * n + (i & 3); }
struct Unit { int pm, pn; };
struct Gemm { const bf16_t* A; const bf16_t* Bt; int M, N, K, lda, ldb, pad; };
struct StaticOrder {
    int nM, nN, nwg, G, c;
    __host__ __device__ void init(int M, int N, int G_, int c_) { nM = M / BM; nN = N / BM; nwg = nM * nN; G = G_; c = c_; }
    __host__ __device__ bool next(int i, Unit& u) const {
        const long L = (long)i * G + c; if (L >= nwg) return false;
        int wgid = (int)L; { const int q = nwg / NXCD, r = nwg % NXCD, xcd = wgid % NXCD, off = wgid / NXCD; wgid = (xcd < r ? xcd * (q + 1) : r * (q + 1) + (xcd - r) * q) + off; }
        const int nig = WGM * nN, gid = wgid / nig, fm = gid * WGM, gsz = (nM - fm) < WGM ? (nM - fm) : WGM;
        u.pm = fm + ((wgid % nig) % gsz); u.pn = (wgid % nig) / gsz; return true;
    }
};
__device__ __forceinline__ unsigned cvt_pk_bf16(float lo, float hi) { unsigned r; asm volatile("v_cvt_pk_bf16_f32 %0, %1, %2" : "=v"(r) : "v"(lo), "v"(hi)); return r; }

template <class Epi, class Sched, bool ALIGN_EPI>
__device__ __forceinline__ void gemm_phase(LAS unsigned char* lds, const Gemm g, const Sched& S, const Epi& E, int wid_in) {
    int lane = lane_id(), wid0 = wid_in; asm volatile("" : "+v"(lane), "+s"(wid0)); const int wid = __builtin_amdgcn_readfirstlane(wid0);
    const int tid = wid * 64 + lane, wr = wid >> 2, wc = wid & 3, fr = lane & 15, fq = lane >> 4;
    const int K = g.K, nt = K / BK;
    unsigned voffA[2], voffB[2];
#pragma unroll
    for (int i = 0; i < 2; ++i) { int R, C; stage_rc(tid * 16 + i * 8192, R, C); const int Rb = Epi::PERM ? ((R & ~31) + perm32(R & 31)) : R;
        voffA[i] = (unsigned)(R * g.lda + C) * 2u; voffB[i] = (unsigned)(Rb * g.ldb + C) * 2u; }
    const size_t kstep = (size_t)(BK * 2);
    const size_t hstepA = (size_t)HALF * g.lda * 2, hstepB = (size_t)HALF * g.ldb * 2;
    const size_t tstepA = 2 * hstepA, tstepB = 2 * hstepB;
    const unsigned ldsw = (unsigned)wid * 1024u;
    const int aoff = lds_byte(wr * 64 + fr, fq * 8), boff = lds_byte(wc * 32 + fr, fq * 8);
#define PG8_SA(b, h) (((b) * 2 + (h)) * HTB)
#define PG8_SB(b, h) ((4 + (b) * 2 + (h)) * HTB)
#define PG8_STAGE(bufoff, gbase, voff) do { _Pragma("unroll") for (int _i = 0; _i < 2; ++_i) \
        __builtin_amdgcn_global_load_lds((const unsigned*)((const char*)(gbase) + (voff)[_i]), (LAS unsigned*)(lds + (bufoff) + ldsw + _i * 8192), 16, 0, 0); } while (0)
#define PG8_LDA(dst, b, h) do { _Pragma("unroll") for (int m = 0; m < 4; ++m) _Pragma("unroll") for (int k = 0; k < 2; ++k) dst[m][k] = *(const LAS bf16x8*)(lds + PG8_SA(b, h) + aoff + m * 2048 + k * 1024); } while (0)
#define PG8_LDB(dst, b, h) do { _Pragma("unroll") for (int n = 0; n < 2; ++n) _Pragma("unroll") for (int k = 0; k < 2; ++k) dst[n][k] = *(const LAS bf16x8*)(lds + PG8_SB(b, h) + boff + n * 2048 + k * 1024); } while (0)
#define PG8_MMA(ai, bj, At, Bt) do { __builtin_amdgcn_s_setprio(1); _Pragma("unroll") for (int m = 0; m < 4; ++m) _Pragma("unroll") for (int n = 0; n < 2; ++n) _Pragma("unroll") for (int k = 0; k < 2; ++k) \
        acc[ai][bj][m][n] = __builtin_amdgcn_mfma_f32_16x16x32_bf16(Bt[n][k], At[m][k], acc[ai][bj][m][n], 0, 0, 0); __builtin_amdgcn_s_setprio(0); } while (0)
#define PG8_WAIT_V(n) asm volatile("s_waitcnt vmcnt(" #n ")" ::: "memory")
#define PG8_WAIT_L(n) asm volatile("s_waitcnt lgkmcnt(" #n ")" ::: "memory")
#define PG8_BAR __builtin_amdgcn_s_barrier()
#define PG8_SCHED __builtin_amdgcn_sched_barrier(0)
    Unit cur, nxt; int ui = 0;
    if (!S.next(0, cur)) return;
    f32x4 acc[2][2][4][2];
#pragma unroll
    for (int a = 0; a < 2; ++a)
#pragma unroll
        for (int b = 0; b < 2; ++b)
#pragma unroll
            for (int m = 0; m < 4; ++m)
#pragma unroll
                for (int n = 0; n < 2; ++n) acc[a][b][m][n] = (f32x4){0.f, 0.f, 0.f, 0.f};
    bf16x8 At[4][2], B0[2][2], B1[2][2];
    const char* cA = (const char*)g.A + (size_t)cur.pm * tstepA; const char* cB = (const char*)g.Bt + (size_t)cur.pn * tstepB;
    PG8_STAGE(PG8_SB(0, 0), cB, voffB); PG8_STAGE(PG8_SB(0, 1), cB + hstepB, voffB); PG8_STAGE(PG8_SA(0, 0), cA, voffA); PG8_STAGE(PG8_SA(0, 1), cA + hstepA, voffA);
    if (wr == 1) PG8_BAR;
    PG8_WAIT_V(2); PG8_BAR;
    PG8_STAGE(PG8_SB(1, 0), cB + kstep, voffB); PG8_STAGE(PG8_SA(1, 0), cA + kstep, voffA); PG8_STAGE(PG8_SB(1, 1), cB + hstepB + kstep, voffB);
    PG8_WAIT_V(6); PG8_BAR;
    for (;;) {
        const bool has_next = S.next(ui + 1, nxt);
        const char* nA = has_next ? (const char*)g.A + (size_t)nxt.pm * tstepA : cA; const char* nB = has_next ? (const char*)g.Bt + (size_t)nxt.pn * tstepB : cB;
        for (int t = 0; t < nt; t += 2) {
            const bool last = (t == nt - 2);
            const char* a1 = cA + (size_t)(t + 1) * kstep;
            const char* a2 = last ? nA : cA + (size_t)(t + 2) * kstep; const char* b2 = last ? nB : cB + (size_t)(t + 2) * kstep;
            const char* a3 = a2 + kstep; const char* b3 = b2 + kstep;
            PG8_LDB(B0, 0, 0); PG8_LDB(B1, 0, 1); PG8_SCHED; PG8_LDA(At, 0, 0); PG8_STAGE(PG8_SA(1, 1), a1 + hstepA, voffA);
            PG8_WAIT_V(8); PG8_WAIT_L(0); PG8_BAR; PG8_MMA(0, 0, At, B0); PG8_MMA(0, 1, At, B1); PG8_BAR; PG8_SCHED;
            PG8_LDA(At, 0, 1); PG8_STAGE(PG8_SB(0, 0), b2, voffB); PG8_STAGE(PG8_SB(0, 1), b2 + hstepB, voffB); PG8_STAGE(PG8_SA(0, 0), a2, voffA);
            PG8_WAIT_V(8); PG8_WAIT_L(0); PG8_BAR; PG8_MMA(1, 0, At, B0); PG8_MMA(1, 1, At, B1); PG8_BAR; PG8_SCHED;
            PG8_LDB(B0, 1, 0); PG8_LDB(B1, 1, 1); PG8_SCHED; PG8_LDA(At, 1, 0); PG8_STAGE(PG8_SA(0, 1), a2 + hstepA, voffA);
            PG8_WAIT_V(8); PG8_WAIT_L(0); PG8_BAR; PG8_MMA(0, 0, At, B0); PG8_MMA(0, 1, At, B1); PG8_BAR; PG8_SCHED;
            PG8_LDA(At, 1, 1); PG8_STAGE(PG8_SB(1, 0), b3, voffB); PG8_STAGE(PG8_SB(1, 1), b3 + hstepB, voffB); PG8_STAGE(PG8_SA(1, 0), a3, voffA);
            PG8_WAIT_V(8); PG8_WAIT_L(0); PG8_BAR; PG8_MMA(1, 0, At, B0); PG8_MMA(1, 1, At, B1); PG8_BAR; PG8_SCHED;
        }
        if constexpr (ALIGN_EPI) { if (wr == 0) PG8_BAR; }
        E(acc, cur, wr, wc, fr, fq);
        if (!has_next) break;
#pragma unroll
        for (int a = 0; a < 2; ++a)
#pragma unroll
            for (int b = 0; b < 2; ++b)
#pragma unroll
                for (int m = 0; m < 4; ++m)
#pragma unroll
                    for (int n = 0; n < 2; ++n) acc[a][b][m][n] = (f32x4){0.f, 0.f, 0.f, 0.f};
        cur = nxt; cA = nA; cB = nB; ++ui;
        if constexpr (ALIGN_EPI) { if (wr == 1) PG8_BAR; }
    }
    PG8_WAIT_V(0);
    if constexpr (!ALIGN_EPI) { if (wr == 0) PG8_BAR; }
    PG8_BAR;
#undef PG8_SA
#undef PG8_SB
#undef PG8_STAGE
#undef PG8_LDA
#undef PG8_LDB
#undef PG8_MMA
#undef PG8_WAIT_V
#undef PG8_WAIT_L
#undef PG8_BAR
#undef PG8_SCHED
}

struct EpiBf16 {
    static constexpr bool PERM = true;
    bf16_t* O; int ldc, pad;
    __device__ __forceinline__ void operator()(const f32x4 (&acc)[2][2][4][2], const Unit& u, int wr_, int wc_, int fr_, int fq_) const {
        const int ln_ = lane_id(), fr = ln_ & 15, fq = ln_ >> 4; (void)fr_; (void)fq_; const int wr = wr_, wc = wc_;
        const int row0 = u.pm * BM + wr * 64 + fr, col0 = u.pn * BM + wc * 32 + 8 * fq;
#pragma unroll
        for (int ai = 0; ai < 2; ++ai)
#pragma unroll
            for (int m = 0; m < 4; ++m) { bf16_t* rowp = O + (size_t)(row0 + ai * HALF + m * 16) * ldc + col0;
#pragma unroll
                for (int bj = 0; bj < 2; ++bj) { const f32x4 v0 = acc[ai][bj][m][0], v1 = acc[ai][bj][m][1];
                    u32x4 w; w.x = cvt_pk_bf16(v0[0], v0[1]); w.y = cvt_pk_bf16(v0[2], v0[3]); w.z = cvt_pk_bf16(v1[0], v1[1]); w.w = cvt_pk_bf16(v1[2], v1[3]);
                    *(u32x4*)(rowp + bj * HALF) = w; } }
    }
};
struct EpiP1 {
    static constexpr bool PERM = true;
    bf16_t* O; const float* rstd; float* dtf;
    __device__ __forceinline__ void operator()(const f32x4 (&acc)[2][2][4][2], const Unit& u, int wr_, int wc_, int fr_, int fq_) const {
        const int ln_ = lane_id(), fr = ln_ & 15, fq = ln_ >> 4; (void)fr_; (void)fq_; const int wr = wr_, wc = wc_;
        const int row0 = u.pm * BM + wr * 64 + fr, col0 = u.pn * BM + wc * 32 + 8 * fq;
        const bool isdt = (u.pn == C_DT / 256) && (wc * 32 + 8 * fq == C_DT % 256);
#pragma unroll
        for (int ai = 0; ai < 2; ++ai)
#pragma unroll
            for (int m = 0; m < 4; ++m) { const int row = row0 + ai * HALF + m * 16; const float rs = rstd[row]; bf16_t* rowp = O + (size_t)row * NP + col0;
#pragma unroll
                for (int bj = 0; bj < 2; ++bj) { const f32x4 v0 = acc[ai][bj][m][0] * rs, v1 = acc[ai][bj][m][1] * rs;
                    u32x4 w; w.x = cvt_pk_bf16(v0[0], v0[1]); w.y = cvt_pk_bf16(v0[2], v0[3]); w.z = cvt_pk_bf16(v1[0], v1[1]); w.w = cvt_pk_bf16(v1[2], v1[3]);
                    *(u32x4*)(rowp + bj * HALF) = w;
                    if (bj == 0 && isdt) { *(f32x4*)(dtf + (size_t)row * 8) = v0; *(f32x4*)(dtf + (size_t)row * 8 + 4) = v1; } } }
    }
};
struct EpiRes {
    static constexpr bool PERM = false;
    const float* base; float* out;
    __device__ __forceinline__ void operator()(const f32x4 (&acc)[2][2][4][2], const Unit& u, int wr_, int wc_, int fr_, int fq_) const {
        const int ln_ = lane_id(), fr = ln_ & 15, fq = ln_ >> 4; (void)fr_; (void)fq_; const int wr = wr_, wc = wc_;
        const int row0 = u.pm * BM + wr * 64 + fr, col0 = u.pn * BM + wc * 32 + 4 * fq;
#pragma unroll
        for (int ai = 0; ai < 2; ++ai)
#pragma unroll
            for (int m = 0; m < 4; ++m) { const size_t off = (size_t)(row0 + ai * HALF + m * 16) * DM + col0;
#pragma unroll
                for (int bj = 0; bj < 2; ++bj)
#pragma unroll
                    for (int n = 0; n < 2; ++n) { const size_t ix = off + bj * HALF + n * 16; const f32x4 b = *(const f32x4*)(base + ix); *(f32x4*)(out + ix) = b + acc[ai][bj][m][n]; } }
    }
};
struct EpiGlu {
    static constexpr bool PERM = true;
    const bf16_t* yg; const bf16_t* proj; const float* bias; bf16_t* mix;
    __device__ __forceinline__ void operator()(const f32x4 (&acc)[2][2][4][2], const Unit& u, int wr_, int wc_, int fr_, int fq_) const {
        const int ln_ = lane_id(), fr = ln_ & 15, fq = ln_ >> 4; (void)fr_; (void)fq_; const int wr = wr_, wc = wc_;
        const int row0 = u.pm * BM + wr * 64 + fr, col0 = u.pn * BM + wc * 32 + 8 * fq;
#pragma unroll
        for (int ai = 0; ai < 2; ++ai)
#pragma unroll
            for (int m = 0; m < 4; ++m) { const int row = row0 + ai * HALF + m * 16;
#pragma unroll
                for (int bj = 0; bj < 2; ++bj) { const int col = col0 + bj * HALF;
                    const u32x4 yv = *(const u32x4*)(yg + (size_t)row * 512 + col), gv = *(const u32x4*)(proj + (size_t)row * NP + C_S5G + col);
                    const f32x4 b0 = *(const f32x4*)(bias + col), b1 = *(const f32x4*)(bias + col + 4);
                    float o[8];
#pragma unroll
                    for (int j = 0; j < 8; ++j) { const unsigned yw = yv[j >> 1], gw = gv[j >> 1];
                        const float y = (j & 1) ? __uint_as_float(yw & 0xffff0000u) : __uint_as_float(yw << 16);
                        const float gt = (j & 1) ? __uint_as_float(gw & 0xffff0000u) : __uint_as_float(gw << 16);
                        const float a = (j < 4 ? acc[ai][bj][m][0][j & 3] : acc[ai][bj][m][1][j & 3]) + (j < 4 ? b0[j & 3] : b1[j & 3]);
                        o[j] = y * sigmoidf_(a) * siluf_(gt); }
                    u32x4 w; w.x = cvt_pk_bf16(o[0], o[1]); w.y = cvt_pk_bf16(o[2], o[3]); w.z = cvt_pk_bf16(o[4], o[5]); w.w = cvt_pk_bf16(o[6], o[7]);
                    *(u32x4*)(mix + (size_t)row * DM + 512 + col) = w; } }
    }
};
}


__device__ __forceinline__ void wtrans_read(const float* s, int Nsrc, const float* sc, int mode, int n0, int k0, LAS float* tile, int t256) {
    const int n = t256 & 63; int sn = n0 + n; if (mode == 1) sn = win_src_col(sn);
#pragma unroll 4
    for (int i = 0; i < 16; ++i) { const int k = i * 4 + (t256 >> 6); float v = 0.f; if (sn >= 0) { v = s[(size_t)(k0 + k) * Nsrc + sn]; if (sc) v *= sc[k0 + k]; } tile[k * 65 + n] = v; }
}
__device__ __forceinline__ void wtrans_write(bf16_t* d, int K, int n0, int k0, const LAS float* tile, int t256) {
    const int k = t256 & 63;
#pragma unroll 4
    for (int i = 0; i < 16; ++i) { const int n = i * 4 + (t256 >> 6); d[(size_t)(n0 + n) * K + k0 + k] = (bf16_t)f2bf(tile[k * 65 + n]); }
}
__device__ __forceinline__ void s5prep_item(int i, const float* a_re, const float* a_im, const float* log_dt, const float* b_re, const float* b_im, float* abar, float* bbar, float* abar64) {
    const int lg = i / 64;
    const double are = a_re[i], aim = a_im[i], delta = exp((double)log_dt[lg]);
    const double mag = exp(are * delta), abr = mag * cos(aim * delta), abi = mag * sin(aim * delta), den = are * are + aim * aim;
    const double cr = ((abr - 1.0) * are + abi * aim) / den, ci = (abi * are - (abr - 1.0) * aim) / den;
    abar[2 * i] = (float)abr; abar[2 * i + 1] = (float)abi;
    { const double m64 = exp(64.0 * are * delta); abar64[2 * i] = (float)(m64 * cos(64.0 * aim * delta)); abar64[2 * i + 1] = (float)(m64 * sin(64.0 * aim * delta)); }
#pragma unroll
    for (int j = 0; j < 16; ++j) { const double br = b_re[(size_t)i * 16 + j], bi = b_im[(size_t)i * 16 + j];
        bbar[(size_t)i * 32 + j] = (float)(cr * br - ci * bi); bbar[(size_t)i * 32 + 16 + j] = (float)(cr * bi + ci * br); }
}
__device__ __forceinline__ void k_rowprep(const float* h, bf16_t* hb, float* rstd, int lane, int gw, int ngw) {
    for (int row = gw; row < TOK; row += ngw) {
        const f32x4* xr = (const f32x4*)(h + (size_t)row * DM) + lane; f32x4 v[8]; float s = 0.f;
#pragma unroll
        for (int j = 0; j < 8; ++j) { v[j] = xr[64 * j]; s += (v[j].x * v[j].x + v[j].y * v[j].y) + (v[j].z * v[j].z + v[j].w * v[j].w); }
        s = wave_sum(s);
        if (lane == 0) rstd[row] = 1.0f / sqrtf(s * (1.0f / DM) + EPS);
        u32x2* o = (u32x2*)(hb + (size_t)row * DM) + lane;
#pragma unroll
        for (int j = 0; j < 8; ++j) { u32x2 w; w.x = pk2(v[j].x, v[j].y); w.y = pk2(v[j].z, v[j].w); o[64 * j] = w; }
    }
}

struct LayerP {
    const float *conv_w, *conv_b, *dt_bias, *a_log, *ssd_d, *ssd_norm_w;
    const float *s5_c_re, *s5_c_im, *s5_d, *abar, *bbar;
    const float *gla_w2, *gla_gb, *gla_norm_w;
    const float *qh_w, *kh_w;
    const int* pos;
    const bf16_t* proj; const float* dtf;
    float *xbcc, *dtv, *ys, *hs, *eg, *og;
    bf16_t *yg, *mix, *qraw, *kvraw, *qf, *kf, *vf, *vt;
    bf16_t *xbcn, *xT, *hin; float *csv, *cse, *sst; unsigned* cnt_ssd;
    bf16_t *qt, *kt, *vT2, *gin; float *glb, *gst; unsigned* cnt_gla;
    const float* abar64; float *s5st, *s5in; unsigned* cnt_s5;
};
__device__ __forceinline__ void k_conv(const LayerP& P, size_t gtid, size_t stride) {
    const size_t n = (size_t)TOK * 768;
    for (size_t i = gtid; i < n; i += stride) {
        const int tok = (int)(i / 768), c = (int)(i % 768), s = tok % SEQ;
        float a = P.conv_b[c];
#pragma unroll
        for (int k = 0; k < 4; ++k) { const int ss = s - 3 + k; if (ss >= 0) a += P.conv_w[k * 768 + c] * bf2f(P.proj[(size_t)(tok - 3 + k) * NP + C_XBC + c]); }
        P.xbcc[i] = siluf_(a);
        if (c < 8) P.dtv[(size_t)tok * 8 + c] = softplusf_(P.dtf[(size_t)tok * 8 + c] + P.dt_bias[c]);
    }
}
__device__ __forceinline__ void k_ssd_naive(const LayerP& P, int lane, int gw, int ngw) {
    for (int w = gw; w < NB * 8 * 64; w += ngw) {
        const int b = w / 512, h = (w / 64) % 8, p = w % 64, g = h / 4;
        const float A = -expf(P.a_log[h]), Dh = P.ssd_d[h];
        float hs = 0.f;
        for (int t = 0; t < SEQ; ++t) {
            const size_t tok = (size_t)b * SEQ + t; const float* xr = P.xbcc + tok * 768;
            const float dt = P.dtv[tok * 8 + h], x = xr[h * 64 + p], Bn = xr[512 + g * 64 + lane], Cn = xr[640 + g * 64 + lane];
            hs = expf(dt * A) * hs + (x * dt) * Bn;
            const float y = wave_sum(Cn * hs);
            if (lane == 0) P.ys[tok * 512 + h * 64 + p] = y + Dh * x;
        }
    }
}
__device__ __forceinline__ void k_ssd_out(const LayerP& P, int lane, int gw, int ngw) {
    for (int tok = gw; tok < TOK; tok += ngw) {
        float v[8]; float s = 0.f;
#pragma unroll
        for (int j = 0; j < 8; ++j) { const int c = lane * 8 + j; v[j] = P.ys[(size_t)tok * 512 + c] * siluf_(bf2f(P.proj[(size_t)tok * NP + C_Z + c])); s += v[j] * v[j]; }
        s = wave_sum(s); const float r = 1.0f / sqrtf(s * (1.0f / 512.f) + EPS);
#pragma unroll
        for (int j = 0; j < 8; ++j) { const int c = lane * 8 + j; P.mix[(size_t)tok * DM + c] = (bf16_t)f2bf(v[j] * r * P.ssd_norm_w[c]); }
    }
}
__device__ __forceinline__ void k_s5_scan(const LayerP& P, int lane, int gw, int ngw) {
    for (int w = gw; w < NB * 32; w += ngw) {
        const int b = w / 32, g = w % 32;
        const float ar = P.abar[(g * 64 + lane) * 2], ai = P.abar[(g * 64 + lane) * 2 + 1];
        float br[16], bi[16];
#pragma unroll
        for (int j = 0; j < 16; ++j) { br[j] = P.bbar[(size_t)(g * 64 + lane) * 32 + j]; bi[j] = P.bbar[(size_t)(g * 64 + lane) * 32 + 16 + j]; }
        float hr = 0.f, hi = 0.f;
        for (int t = 0; t < SEQ; ++t) {
            const size_t tok = (size_t)b * SEQ + t; const bf16_t* up = P.proj + tok * NP + C_S5U + g * 16;
            float ur = 0.f, ui = 0.f;
#pragma unroll
            for (int j = 0; j < 16; ++j) { const float u = bf2f(up[j]); ur += br[j] * u; ui += bi[j] * u; }
            const float nr = ar * hr - ai * hi + ur, ni = ar * hi + ai * hr + ui; hr = nr; hi = ni;
            float* o = P.hs + (tok * 32 + g) * 128; o[lane] = hr; o[64 + lane] = hi;
        }
    }
}
__device__ __forceinline__ void k_s5_out(const LayerP& P, size_t gtid, size_t stride) {
    const size_t n = (size_t)TOK * 512;
    for (size_t i = gtid; i < n; i += stride) {
        const size_t tok = i / 512; const int ch = (int)(i % 512), g = ch / 16, ii = ch % 16;
        const float* h = P.hs + (tok * 32 + g) * 128; const float* cr = P.s5_c_re + (size_t)(g * 16 + ii) * 64; const float* ci = P.s5_c_im + (size_t)(g * 16 + ii) * 64;
        float y = 0.f;
        for (int k = 0; k < 64; ++k) y += cr[k] * h[k] - ci[k] * h[64 + k];
        y += P.s5_d[ch] * bf2f(P.proj[tok * NP + C_S5U + ch]);
        P.yg[i] = (bf16_t)f2bf(gelu_tanh(y));
    }
}
__device__ __forceinline__ void k_gla_gate(const LayerP& P, size_t gtid, size_t stride) {
    const size_t n = (size_t)TOK * 256;
    for (size_t i = gtid; i < n; i += stride) {
        const size_t tok = i / 256; const int j = (int)(i % 256);
        float x = P.gla_gb[j];
#pragma unroll
        for (int r = 0; r < 16; ++r) x += bf2f(P.proj[tok * NP + C_GLR + r]) * P.gla_w2[r * 256 + j];
        const float ls = fminf(x, 0.f) - log1pf(expf(-fabsf(x)));
        P.eg[i] = expf(ls * (1.0f / 16.0f));
    }
}
__device__ __forceinline__ void k_gla_naive(const LayerP& P, int lane, int gw, int ngw) {
    for (int w = gw; w < NB * 4 * 128; w += ngw) {
        const int b = w / 512, h = (w / 128) % 4, e = w % 128;
        float S = 0.f;
        for (int t = 0; t < SEQ; ++t) {
            const size_t tok = (size_t)b * SEQ + t; const bf16_t* pr = P.proj + tok * NP;
            const float eg = P.eg[tok * 256 + h * 64 + lane], k = bf2f(pr[C_GK + h * 64 + lane]), q = bf2f(pr[C_GQ + h * 64 + lane]) * 0.125f, v = bf2f(pr[C_GV + h * 128 + e]);
            S = eg * S + k * v;
            const float o = wave_sum(q * S);
            if (lane == 0) P.og[tok * 512 + h * 128 + e] = o;
        }
    }
}
__device__ __forceinline__ void k_gla_out(const LayerP& P, int lane, int gw, int ngw) {
    for (int w = gw; w < TOK * 4; w += ngw) {
        const size_t tok = w / 4; const int h = w % 4;
        const float o0 = P.og[tok * 512 + h * 128 + lane], o1 = P.og[tok * 512 + h * 128 + 64 + lane];
        const float s = wave_sum(o0 * o0 + o1 * o1), r = 1.0f / sqrtf(s * (1.0f / 128.f) + EPS);
        const float g0 = bf2f(P.proj[tok * NP + C_GG + h * 128 + lane]), g1 = bf2f(P.proj[tok * NP + C_GG + h * 128 + 64 + lane]);
        P.mix[tok * DM + 1024 + h * 128 + lane] = (bf16_t)f2bf(o0 * r * P.gla_norm_w[lane] * siluf_(g0));
        P.mix[tok * DM + 1024 + h * 128 + 64 + lane] = (bf16_t)f2bf(o1 * r * P.gla_norm_w[64 + lane] * siluf_(g1));
    }
}
__device__ __forceinline__ void k_mla_fin(const LayerP& P, int lane, int gw, int ngw) {
    for (int tok = gw; tok < TOK; tok += ngw) {
        const int b = tok / SEQ, s = tok % SEQ; const bf16_t* pr = P.proj + (size_t)tok * NP;
        float sq = 0.f;
#pragma unroll
        for (int j = 0; j < 6; ++j) { const float v = bf2f(pr[C_CQ + lane + 64 * j]); sq += v * v; }
        float sk = 0.f;
#pragma unroll
        for (int j = 0; j < 2; ++j) { const float v = bf2f(pr[C_CKV + lane + 64 * j]); sk += v * v; }
        const float rq = 1.0f / sqrtf(wave_sum(sq) * (1.0f / 384.f) + EPS), rk = 1.0f / sqrtf(wave_sum(sk) * (1.0f / 128.f) + EPS);
        const int i = lane & 31;
        const float inv_freq = powf(10000.0f, -(float)i / 32.0f), ang = (float)P.pos[tok] * inv_freq, cs = cosf(ang), sn = sinf(ang);
        const float kpe = bf2f(pr[C_KPE + lane]);
        for (int h = 0; h < 4; ++h) {
            const size_t ob = ((size_t)(b * 4 + h) * SEQ + s);
            {
                float q0 = bf2f(P.qraw[(size_t)tok * 768 + h * 192 + lane]) * rq, q1 = bf2f(P.qraw[(size_t)tok * 768 + h * 192 + 64 + lane]) * rq, q2 = bf2f(P.qraw[(size_t)tok * 768 + h * 192 + 128 + lane]) * rq;
                const float r = 1.0f / sqrtf(wave_sum(q0 * q0 + q1 * q1 + q2 * q2) * (1.0f / 192.f) + EPS);
                q0 *= r * P.qh_w[lane]; q1 *= r * P.qh_w[64 + lane]; q2 *= r * P.qh_w[128 + lane];
                const float oth = xor32_other(q2, lane);
                const float rot = (lane < 32) ? (q2 * cs - oth * sn) : (q2 * cs + oth * sn);
                bf16_t* o = P.qf + ob * 192; o[lane] = (bf16_t)f2bf(q0); o[64 + lane] = (bf16_t)f2bf(q1); o[128 + lane] = (bf16_t)f2bf(rot);
            }
            {
                float k0 = bf2f(P.kvraw[(size_t)tok * 1024 + h * 256 + lane]) * rk, k1 = bf2f(P.kvraw[(size_t)tok * 1024 + h * 256 + 64 + lane]) * rk, k2 = kpe;
                const float r = 1.0f / sqrtf(wave_sum(k0 * k0 + k1 * k1 + k2 * k2) * (1.0f / 192.f) + EPS);
                k0 *= r * P.kh_w[lane]; k1 *= r * P.kh_w[64 + lane]; k2 *= r * P.kh_w[128 + lane];
                const float oth = xor32_other(k2, lane);
                const float rot = (lane < 32) ? (k2 * cs - oth * sn) : (k2 * cs + oth * sn);
                bf16_t* o = P.kf + ob * 192; o[lane] = (bf16_t)f2bf(k0); o[64 + lane] = (bf16_t)f2bf(k1); o[128 + lane] = (bf16_t)f2bf(rot);
                bf16_t* vo = P.vt + (size_t)(b * 4 + h) * 128 * SEQ + s;
                vo[(size_t)lane * SEQ] = (bf16_t)f2bf(bf2f(P.kvraw[(size_t)tok * 1024 + h * 256 + 128 + lane]) * rk); vo[(size_t)(64 + lane) * SEQ] = (bf16_t)f2bf(bf2f(P.kvraw[(size_t)tok * 1024 + h * 256 + 192 + lane]) * rk);
            }
        }
    }
}

constexpr int SA_XT = 0, SA_BT = 8 * 64 * 72 * 2, SA_AA = SA_BT + 2 * 64 * 72 * 2, SA_WW = SA_AA + 2048, SA_FLAG = SA_WW + 2048;
__device__ __forceinline__ bf16x8 scale_frag(bf16x8 v, const float (&w)[8]) {
    bf16x8 o;
#pragma unroll
    for (int j = 0; j < 8; j += 2) { const unsigned pk = pk2(bf2f((bf16_t)v[j]) * w[j], bf2f((bf16_t)v[j + 1]) * w[j + 1]); o[j] = (short)(pk & 0xffffu); o[j + 1] = (short)(pk >> 16); }
    return o;
}
__device__ __forceinline__ void ssd_passA(const LayerP& P, LAS unsigned char* lds, int item, int wave, int lane) {
    const int b = item >> 5, c = item & 31, tid = wave * 64 + lane, s0 = c * 64; const size_t tok0 = (size_t)b * SEQ + s0;
    LAS bf16_t* XT = (LAS bf16_t*)(lds + SA_XT); LAS bf16_t* BT = (LAS bf16_t*)(lds + SA_BT); LAS float* AA = (LAS float*)(lds + SA_AA); LAS float* WW = (LAS float*)(lds + SA_WW);
    volatile LAS unsigned* FLG = (volatile LAS unsigned*)(lds + SA_FLAG);
#pragma unroll 1
    for (int k = 0; k < 3; ++k) {
        const int u = tid + 512 * k, ch = u % 768, half = u / 768, t0 = half * 32;
        const float w0 = P.conv_w[ch], w1 = P.conv_w[768 + ch], w2 = P.conv_w[1536 + ch], w3 = P.conv_w[2304 + ch], bb = P.conv_b[ch];
        const bf16_t* src = P.proj + (tok0 + t0) * NP + C_XBC + ch;
        float x0 = 0.f, x1 = 0.f, x2 = 0.f;
        if (s0 + t0 > 0) { x0 = bf2f(*(src - 3 * NP)); x1 = bf2f(*(src - 2 * NP)); x2 = bf2f(*(src - NP)); }
#pragma unroll 8
        for (int t = 0; t < 32; ++t) {
            const float x3 = bf2f(src[(size_t)t * NP]);
            const bf16_t vb = (bf16_t)f2bf(siluf_(bb + w0 * x0 + w1 * x1 + w2 * x2 + w3 * x3));
            P.xbcn[(tok0 + t0 + t) * 768 + ch] = vb;
            if (ch < 512) XT[ch * 72 + t0 + t] = vb;
            else if (ch < 640) BT[(ch - 512) * 72 + t0 + t] = vb;
            x0 = x1; x1 = x2; x2 = x3;
        }
    }
    {
        const int h = wave; const float A = -expf(P.a_log[h]);
        const float dt = softplusf_(P.dtf[(tok0 + lane) * 8 + h] + P.dt_bias[h]);
        AA[h * 64 + lane] = dt * A;
        asm volatile("s_waitcnt lgkmcnt(0)" ::: "memory");
        float cs = 0.f;
        for (int s = 0; s < 64; ++s) { const float av = AA[h * 64 + s]; cs += (s <= lane) ? av : 0.f; }
        const float cend = __int_as_float(__builtin_amdgcn_readlane(__float_as_int(cs), 63));
        P.dtv[(tok0 + lane) * 8 + h] = dt; P.csv[(tok0 + lane) * 8 + h] = cs;
        WW[h * 64 + lane] = expf(cend - cs) * dt;
        if (lane == 63) P.cse[(size_t)(b * 32 + c) * 8 + h] = cs;
    }
    __syncthreads();
#pragma unroll
    for (int k = 0; k < 8; ++k) { const int ci = tid + 512 * k, row = ci >> 3, cc = ci & 7;
        const u32x4 v = *(const LAS u32x4*)(XT + row * 72 + cc * 8);
        *(u32x4*)(P.xT + ((size_t)(b * 8 + (row >> 6)) * 64 + (row & 63)) * SEQ + s0 + cc * 8) = v; }
    {
        const int h = wave, g = h >> 2, fr = lane & 15, fq = lane >> 4;
        f32x4 acc[4][4];
#pragma unroll
        for (int i = 0; i < 4; ++i)
#pragma unroll
            for (int j = 0; j < 4; ++j) acc[i][j] = (f32x4){0.f, 0.f, 0.f, 0.f};
#pragma unroll
        for (int ks = 0; ks < 2; ++ks) {
            float wv[8];
#pragma unroll
            for (int j = 0; j < 8; ++j) wv[j] = WW[h * 64 + ks * 32 + fq * 8 + j];
            bf16x8 bfr[4];
#pragma unroll
            for (int nt = 0; nt < 4; ++nt) bfr[nt] = *(const LAS bf16x8*)(BT + (g * 64 + nt * 16 + fr) * 72 + ks * 32 + fq * 8);
#pragma unroll
            for (int pt = 0; pt < 4; ++pt) { const bf16x8 af = scale_frag(*(const LAS bf16x8*)(XT + (h * 64 + pt * 16 + fr) * 72 + ks * 32 + fq * 8), wv);
#pragma unroll
                for (int nt = 0; nt < 4; ++nt) acc[pt][nt] = __builtin_amdgcn_mfma_f32_16x16x32_bf16(af, bfr[nt], acc[pt][nt], 0, 0, 0); }
        }
        float* so = P.sst + ((size_t)(b * 32 + c) * 8 + h) * 4096;
#pragma unroll
        for (int pt = 0; pt < 4; ++pt)
#pragma unroll
            for (int nt = 0; nt < 4; ++nt)
#pragma unroll
                for (int r = 0; r < 4; ++r) so[(pt * 16 + fq * 4 + r) * 64 + nt * 16 + fr] = acc[pt][nt][r];
    }
    asm volatile("s_waitcnt vmcnt(0)" ::: "memory");
    __syncthreads();
    if (tid == 0) {
        __builtin_amdgcn_fence(__ATOMIC_RELEASE, "agent");
        asm volatile("s_waitcnt vmcnt(0)" ::: "memory");
        const unsigned old = __hip_atomic_fetch_add(P.cnt_ssd + 64 * b, 1u, __ATOMIC_RELAXED, __HIP_MEMORY_SCOPE_AGENT);
        if (old == 31u) { __builtin_amdgcn_fence(__ATOMIC_ACQUIRE, "agent"); asm volatile("s_waitcnt vmcnt(0)" ::: "memory"); }
        FLG[0] = (old == 31u) ? 1u : 0u;
    }
    __syncthreads();
    if (FLG[0] != 0u) {
        const int h = wave;
        f32x4 H[16];
#pragma unroll
        for (int k = 0; k < 16; ++k) H[k] = (f32x4){0.f, 0.f, 0.f, 0.f};
#pragma unroll 1
        for (int c2 = 0; c2 < 32; ++c2) {
            const size_t base = ((size_t)(b * 32 + c2) * 8 + h) * 4096;
            const float dec = expf(P.cse[(size_t)(b * 32 + c2) * 8 + h]);
#pragma unroll
            for (int k = 0; k < 16; ++k) {
                u32x2 w; w.x = pk2(H[k].x, H[k].y); w.y = pk2(H[k].z, H[k].w);
                *(u32x2*)(P.hin + base + k * 256 + lane * 4) = w;
                const f32x4 S = *(const f32x4*)(P.sst + base + k * 256 + lane * 4);
                H[k] = H[k] * dec + S;
            }
        }
    }
    __syncthreads();
}
constexpr int SB_M = 0, SB_RS = 8 * 64 * 72 * 2;
__device__ __forceinline__ void ssd_passB(const LayerP& P, LAS unsigned char* lds, int item, int wave, int lane) {
    const int b = item >> 5, c = item & 31, s0 = c * 64, h = wave, g = h >> 2, fr = lane & 15, fq = lane >> 4; const size_t tok0 = (size_t)b * SEQ + s0;
    LAS bf16_t* Mw = (LAS bf16_t*)(lds + SB_M) + wave * 64 * 72; LAS float* RS = (LAS float*)(lds + SB_RS);
    bf16x8 cfr[4][2], bfr[4][2];
#pragma unroll
    for (int t = 0; t < 4; ++t)
#pragma unroll
        for (int ks = 0; ks < 2; ++ks) {
            cfr[t][ks] = *(const bf16x8*)(P.xbcn + (tok0 + t * 16 + fr) * 768 + 640 + g * 64 + ks * 32 + fq * 8);
            bfr[t][ks] = *(const bf16x8*)(P.xbcn + (tok0 + t * 16 + fr) * 768 + 512 + g * 64 + ks * 32 + fq * 8); }
    float cst[4][4], css[4], dts[4];
#pragma unroll
    for (int tt = 0; tt < 4; ++tt)
#pragma unroll
        for (int r = 0; r < 4; ++r) cst[tt][r] = P.csv[(tok0 + tt * 16 + fq * 4 + r) * 8 + h];
#pragma unroll
    for (int st = 0; st < 4; ++st) { css[st] = P.csv[(tok0 + st * 16 + fr) * 8 + h]; dts[st] = P.dtv[(tok0 + st * 16 + fr) * 8 + h]; }
#pragma unroll
    for (int tt = 0; tt < 4; ++tt)
#pragma unroll
        for (int st = 0; st < 4; ++st) {
            f32x4 G = (f32x4){0.f, 0.f, 0.f, 0.f};
            if (st <= tt) {
#pragma unroll
                for (int ks = 0; ks < 2; ++ks) G = __builtin_amdgcn_mfma_f32_16x16x32_bf16(cfr[tt][ks], bfr[st][ks], G, 0, 0, 0);
            }
#pragma unroll
            for (int r = 0; r < 4; ++r) { const int t = tt * 16 + fq * 4 + r, s = st * 16 + fr;
                const float v = (st <= tt && s <= t) ? G[r] * expf(cst[tt][r] - css[st]) * dts[st] : 0.f;
                Mw[t * 72 + s] = (bf16_t)f2bf(v); }
        }
    f32x4 Y[4][4];
    {
        const bf16_t* hb = P.hin + ((size_t)(b * 32 + c) * 8 + h) * 4096;
        bf16x8 hfr[4][2];
#pragma unroll
        for (int pt = 0; pt < 4; ++pt)
#pragma unroll
            for (int ks = 0; ks < 2; ++ks) hfr[pt][ks] = *(const bf16x8*)(hb + (pt * 16 + fr) * 64 + ks * 32 + fq * 8);
#pragma unroll
        for (int tt = 0; tt < 4; ++tt)
#pragma unroll
            for (int pt = 0; pt < 4; ++pt) { f32x4 a = (f32x4){0.f, 0.f, 0.f, 0.f};
#pragma unroll
                for (int ks = 0; ks < 2; ++ks) a = __builtin_amdgcn_mfma_f32_16x16x32_bf16(cfr[tt][ks], hfr[pt][ks], a, 0, 0, 0);
#pragma unroll
                for (int r = 0; r < 4; ++r) a[r] *= expf(cst[tt][r]);
                Y[tt][pt] = a; }
    }
    {
        bf16x8 xfr[4][2];
#pragma unroll
        for (int pt = 0; pt < 4; ++pt)
#pragma unroll
            for (int ks = 0; ks < 2; ++ks) xfr[pt][ks] = *(const bf16x8*)(P.xT + ((size_t)(b * 8 + h) * 64 + pt * 16 + fr) * SEQ + s0 + ks * 32 + fq * 8);
        asm volatile("s_waitcnt lgkmcnt(0)" ::: "memory");
#pragma unroll
        for (int tt = 0; tt < 4; ++tt)
#pragma unroll
            for (int ks = 0; ks < 2; ++ks) { if (ks * 32 > tt * 16 + 15) continue;
                const bf16x8 af = *(const LAS bf16x8*)(Mw + (tt * 16 + fr) * 72 + ks * 32 + fq * 8);
#pragma unroll
                for (int pt = 0; pt < 4; ++pt) Y[tt][pt] = __builtin_amdgcn_mfma_f32_16x16x32_bf16(af, xfr[pt][ks], Y[tt][pt], 0, 0, 0); }
    }
    const float Dh = P.ssd_d[h];
    float rsq[4][4];
#pragma unroll
    for (int tt = 0; tt < 4; ++tt)
#pragma unroll
        for (int r = 0; r < 4; ++r) { const size_t tok = tok0 + tt * 16 + fq * 4 + r; float q = 0.f;
#pragma unroll
            for (int pt = 0; pt < 4; ++pt) { const int ch = h * 64 + pt * 16 + fr;
                const float x = bf2f(P.xbcn[tok * 768 + ch]), z = bf2f(P.proj[tok * NP + C_Z + ch]);
                const float v = (Y[tt][pt][r] + Dh * x) * siluf_(z); Y[tt][pt][r] = v; q += v * v; }
            rsq[tt][r] = xsum16(q); }
    if (fr == 0) {
#pragma unroll
        for (int tt = 0; tt < 4; ++tt)
#pragma unroll
            for (int r = 0; r < 4; ++r) RS[h * 64 + tt * 16 + fq * 4 + r] = rsq[tt][r];
    }
    __syncthreads();
#pragma unroll
    for (int tt = 0; tt < 4; ++tt)
#pragma unroll
        for (int r = 0; r < 4; ++r) { const int t = tt * 16 + fq * 4 + r; float tot = 0.f;
#pragma unroll
            for (int hh = 0; hh < 8; ++hh) tot += RS[hh * 64 + t];
            const float rn = 1.0f / sqrtf(tot * (1.0f / 512.f) + EPS); const size_t tok = tok0 + t;
#pragma unroll
            for (int pt = 0; pt < 4; ++pt) { const int ch = h * 64 + pt * 16 + fr; P.mix[tok * DM + ch] = (bf16_t)f2bf(Y[tt][pt][r] * rn * P.ssd_norm_w[ch]); } }
    __syncthreads();
}

constexpr int GA_KH = 0, GA_VT = 256 * 72 * 2, GA_HT = GA_VT + 512 * 72 * 2, GA_FLAG = GA_HT + 2048;
__device__ __forceinline__ float logsig16(float x) { return (fminf(x, 0.f) - log1pf(expf(-fabsf(x)))) * (1.0f / 16.0f); }
__device__ __forceinline__ void gla_passA(const LayerP& P, LAS unsigned char* lds, int item, int wave, int lane) {
    const int b = item >> 5, c = item & 31, tid = wave * 64 + lane, s0 = c * 64; const size_t tok0 = (size_t)b * SEQ + s0;
    LAS bf16_t* KH = (LAS bf16_t*)(lds + GA_KH); LAS bf16_t* VT = (LAS bf16_t*)(lds + GA_VT); LAS float* HT = (LAS float*)(lds + GA_HT);
    volatile LAS unsigned* FLG = (volatile LAS unsigned*)(lds + GA_FLAG);
    const int j = tid & 255, half = tid >> 8;
    float w2[16];
#pragma unroll
    for (int r = 0; r < 16; ++r) w2[r] = P.gla_w2[r * 256 + j];
    const float gb = P.gla_gb[j];
    float run = 0.f;
#pragma unroll 4
    for (int i = 0; i < 32; ++i) { const size_t tok = tok0 + half * 32 + i; const u32x4 g0 = *(const u32x4*)(P.proj + tok * NP + C_GLR), g1 = *(const u32x4*)(P.proj + tok * NP + C_GLR + 8);
        float x = gb;
#pragma unroll
        for (int r = 0; r < 8; ++r) { const unsigned wlo = g0[r >> 1], whi = g1[r >> 1];
            x += ((r & 1) ? __uint_as_float(wlo & 0xffff0000u) : __uint_as_float(wlo << 16)) * w2[r] + ((r & 1) ? __uint_as_float(whi & 0xffff0000u) : __uint_as_float(whi << 16)) * w2[8 + r]; }
        run += logsig16(x); }
    HT[half * 256 + j] = run;
    {
        const bf16_t* vsrc = P.proj + tok0 * NP + C_GV + tid;
#pragma unroll 8
        for (int t = 0; t < 64; ++t) VT[tid * 72 + t] = vsrc[(size_t)t * NP];
    }
    __syncthreads();
    const float off = half ? HT[j] : 0.f, blast = HT[j] + HT[256 + j];
    if (half == 0) P.glb[(size_t)(b * 32 + c) * 256 + j] = blast;
    run = off;
#pragma unroll 4
    for (int i = 0; i < 32; ++i) { const int t = half * 32 + i; const size_t tok = tok0 + t; const u32x4 g0 = *(const u32x4*)(P.proj + tok * NP + C_GLR), g1 = *(const u32x4*)(P.proj + tok * NP + C_GLR + 8);
        float x = gb;
#pragma unroll
        for (int r = 0; r < 8; ++r) { const unsigned wlo = g0[r >> 1], whi = g1[r >> 1];
            x += ((r & 1) ? __uint_as_float(wlo & 0xffff0000u) : __uint_as_float(wlo << 16)) * w2[r] + ((r & 1) ? __uint_as_float(whi & 0xffff0000u) : __uint_as_float(whi << 16)) * w2[8 + r]; }
        run += logsig16(x);
        const float q = bf2f(P.proj[tok * NP + C_GQ + j]), k = bf2f(P.proj[tok * NP + C_GK + j]);
        P.qt[tok * 256 + j] = (bf16_t)f2bf(q * 0.125f * expf(run));
        P.kt[tok * 256 + j] = (bf16_t)f2bf(k * expf(-run));
        KH[j * 72 + t] = (bf16_t)f2bf(k * expf(blast - run)); }
    __syncthreads();
#pragma unroll
    for (int k = 0; k < 8; ++k) { const int ci = tid + 512 * k, row = ci >> 3, cc = ci & 7;
        const u32x4 v = *(const LAS u32x4*)(VT + row * 72 + cc * 8);
        *(u32x4*)(P.vT2 + ((size_t)(b * 4 + (row >> 7)) * 128 + (row & 127)) * SEQ + s0 + cc * 8) = v; }
    {
        const int h = wave >> 1, eh = wave & 1, fr = lane & 15, fq = lane >> 4;
        f32x4 acc[4][4];
#pragma unroll
        for (int i = 0; i < 4; ++i)
#pragma unroll
            for (int jj = 0; jj < 4; ++jj) acc[i][jj] = (f32x4){0.f, 0.f, 0.f, 0.f};
#pragma unroll
        for (int ks = 0; ks < 2; ++ks) {
            bf16x8 kf[4];
#pragma unroll
            for (int dt = 0; dt < 4; ++dt) kf[dt] = *(const LAS bf16x8*)(KH + (h * 64 + dt * 16 + fr) * 72 + ks * 32 + fq * 8);
#pragma unroll
            for (int et = 0; et < 4; ++et) { const bf16x8 vf = *(const LAS bf16x8*)(VT + (h * 128 + eh * 64 + et * 16 + fr) * 72 + ks * 32 + fq * 8);
#pragma unroll
                for (int dt = 0; dt < 4; ++dt) acc[et][dt] = __builtin_amdgcn_mfma_f32_16x16x32_bf16(vf, kf[dt], acc[et][dt], 0, 0, 0); }
        }
        float* so = P.gst + ((size_t)(b * 32 + c) * 4 + h) * 8192 + eh * 4096;
#pragma unroll
        for (int et = 0; et < 4; ++et)
#pragma unroll
            for (int dt = 0; dt < 4; ++dt)
#pragma unroll
                for (int r = 0; r < 4; ++r) so[(et * 16 + fq * 4 + r) * 64 + dt * 16 + fr] = acc[et][dt][r];
    }
    asm volatile("s_waitcnt vmcnt(0)" ::: "memory");
    __syncthreads();
    if (tid == 0) {
        __builtin_amdgcn_fence(__ATOMIC_RELEASE, "agent");
        asm volatile("s_waitcnt vmcnt(0)" ::: "memory");
        const unsigned old = __hip_atomic_fetch_add(P.cnt_gla + 64 * b, 1u, __ATOMIC_RELAXED, __HIP_MEMORY_SCOPE_AGENT);
        if (old == 31u) { __builtin_amdgcn_fence(__ATOMIC_ACQUIRE, "agent"); asm volatile("s_waitcnt vmcnt(0)" ::: "memory"); }
        FLG[0] = (old == 31u) ? 1u : 0u;
    }
    __syncthreads();
    if (FLG[0] != 0u) {
        const int h = wave >> 1, eh = wave & 1;
        f32x4 H[16];
#pragma unroll
        for (int k = 0; k < 16; ++k) H[k] = (f32x4){0.f, 0.f, 0.f, 0.f};
#pragma unroll 1
        for (int c2 = 0; c2 < 32; ++c2) {
            const size_t base = ((size_t)(b * 32 + c2) * 4 + h) * 8192 + eh * 4096;
            const f32x4 bl = *(const f32x4*)(P.glb + (size_t)(b * 32 + c2) * 256 + h * 64 + (lane & 15) * 4);
            const f32x4 dec = (f32x4){expf(bl.x), expf(bl.y), expf(bl.z), expf(bl.w)};
#pragma unroll
            for (int k = 0; k < 16; ++k) {
                u32x2 w; w.x = pk2(H[k].x, H[k].y); w.y = pk2(H[k].z, H[k].w);
                *(u32x2*)(P.gin + base + k * 256 + lane * 4) = w;
                const f32x4 S = *(const f32x4*)(P.gst + base + k * 256 + lane * 4);
                H[k] = H[k] * dec + S;
            }
        }
    }
    __syncthreads();
}
__device__ __forceinline__ void gla_passB(const LayerP& P, LAS unsigned char* lds, int item, int wave, int lane) {
    const int b = item >> 5, c = item & 31, s0 = c * 64, h = wave >> 1, half = wave & 1, fr = lane & 15, fq = lane >> 4; const size_t tok0 = (size_t)b * SEQ + s0;
    LAS bf16_t* Pw = (LAS bf16_t*)lds + wave * 32 * 72;
    bf16x8 qfr[2][2];
#pragma unroll
    for (int tt = 0; tt < 2; ++tt)
#pragma unroll
        for (int ks = 0; ks < 2; ++ks) qfr[tt][ks] = *(const bf16x8*)(P.qt + (tok0 + (half * 2 + tt) * 16 + fr) * 256 + h * 64 + ks * 32 + fq * 8);
    {
        bf16x8 kfr[4][2];
#pragma unroll
        for (int st = 0; st < 4; ++st)
#pragma unroll
            for (int ks = 0; ks < 2; ++ks) kfr[st][ks] = *(const bf16x8*)(P.kt + (tok0 + st * 16 + fr) * 256 + h * 64 + ks * 32 + fq * 8);
#pragma unroll
        for (int tt = 0; tt < 2; ++tt)
#pragma unroll
            for (int st = 0; st < 4; ++st) { const int tg = half * 2 + tt;
                f32x4 G = (f32x4){0.f, 0.f, 0.f, 0.f};
                if (st <= tg) {
#pragma unroll
                    for (int ks = 0; ks < 2; ++ks) G = __builtin_amdgcn_mfma_f32_16x16x32_bf16(qfr[tt][ks], kfr[st][ks], G, 0, 0, 0);
                }
#pragma unroll
                for (int r = 0; r < 4; ++r) { const float v = (st < tg || (st == tg && fr <= fq * 4 + r)) ? G[r] : 0.f;
                    Pw[(tt * 16 + fq * 4 + r) * 72 + st * 16 + fr] = (bf16_t)f2bf(v); } }
    }
    f32x4 O[2][8];
    {
        const bf16_t* gb = P.gin + ((size_t)(b * 32 + c) * 4 + h) * 8192;
#pragma unroll
        for (int et = 0; et < 8; ++et) { const bf16x8 g0 = *(const bf16x8*)(gb + (et * 16 + fr) * 64 + fq * 8), g1 = *(const bf16x8*)(gb + (et * 16 + fr) * 64 + 32 + fq * 8);
#pragma unroll
            for (int tt = 0; tt < 2; ++tt) { f32x4 a = (f32x4){0.f, 0.f, 0.f, 0.f};
                a = __builtin_amdgcn_mfma_f32_16x16x32_bf16(qfr[tt][0], g0, a, 0, 0, 0); a = __builtin_amdgcn_mfma_f32_16x16x32_bf16(qfr[tt][1], g1, a, 0, 0, 0); O[tt][et] = a; } }
    }
    asm volatile("s_waitcnt lgkmcnt(0)" ::: "memory");
#pragma unroll
    for (int ks = 0; ks < 2; ++ks) { if (ks * 32 > (half * 2 + 1) * 16 + 15) continue;
        bf16x8 pf[2];
#pragma unroll
        for (int tt = 0; tt < 2; ++tt) pf[tt] = *(const LAS bf16x8*)(Pw + (tt * 16 + fr) * 72 + ks * 32 + fq * 8);
#pragma unroll
        for (int et = 0; et < 8; ++et) { const bf16x8 vf = *(const bf16x8*)(P.vT2 + ((size_t)(b * 4 + h) * 128 + et * 16 + fr) * SEQ + s0 + ks * 32 + fq * 8);
#pragma unroll
            for (int tt = 0; tt < 2; ++tt) O[tt][et] = __builtin_amdgcn_mfma_f32_16x16x32_bf16(pf[tt], vf, O[tt][et], 0, 0, 0); } }
#pragma unroll
    for (int tt = 0; tt < 2; ++tt)
#pragma unroll
        for (int r = 0; r < 4; ++r) { float q = 0.f;
#pragma unroll
            for (int et = 0; et < 8; ++et) q += O[tt][et][r] * O[tt][et][r];
            q = xsum16(q); const float rn = 1.0f / sqrtf(q * (1.0f / 128.f) + EPS);
            const size_t tok = tok0 + (half * 2 + tt) * 16 + fq * 4 + r;
#pragma unroll
            for (int et = 0; et < 8; ++et) { const int e = et * 16 + fr; const float g = bf2f(P.proj[tok * NP + C_GG + h * 128 + e]);
                P.mix[tok * DM + 1024 + h * 128 + e] = (bf16_t)f2bf(O[tt][et][r] * rn * P.gla_norm_w[e] * siluf_(g)); } }
    __syncthreads();
}

__device__ __forceinline__ void s5_step(float& hr, float& hi, float ar, float ai, const float (&br)[16], const float (&bi)[16], const unsigned (&up)[8], int t) {
    float ur = 0.f, ui = 0.f;
#pragma unroll
    for (int j = 0; j < 8; ++j) { const unsigned w = (unsigned)__builtin_amdgcn_readlane((int)up[j], t);
        const float u0 = __uint_as_float(w << 16), u1 = __uint_as_float(w & 0xffff0000u);
        ur += br[2 * j] * u0; ui += bi[2 * j] * u0; ur += br[2 * j + 1] * u1; ui += bi[2 * j + 1] * u1; }
    const float nr = ar * hr - ai * hi + ur, ni = ar * hi + ai * hr + ui; hr = nr; hi = ni;
}
constexpr int S5_FLAG = 8 * 32 * 136 * 2;
__device__ __forceinline__ void s5_passA(const LayerP& P, LAS unsigned char* lds, int item, int wave, int lane) {
    const int b = item >> 5, c = item & 31, tid = wave * 64 + lane; const size_t tok0 = (size_t)b * SEQ + c * 64;
    volatile LAS unsigned* FLG = (volatile LAS unsigned*)(lds + S5_FLAG);
#pragma unroll 1
    for (int gi = 0; gi < 4; ++gi) {
        const int g = wave * 4 + gi;
        const float ar = P.abar[(g * 64 + lane) * 2], ai = P.abar[(g * 64 + lane) * 2 + 1];
        float br[16], bi[16];
#pragma unroll
        for (int j = 0; j < 16; ++j) { br[j] = P.bbar[(size_t)(g * 64 + lane) * 32 + j]; bi[j] = P.bbar[(size_t)(g * 64 + lane) * 32 + 16 + j]; }
        unsigned up[8];
        { const u32x4 a = *(const u32x4*)(P.proj + (tok0 + lane) * NP + C_S5U + g * 16), bq = *(const u32x4*)(P.proj + (tok0 + lane) * NP + C_S5U + g * 16 + 8);
          up[0] = a.x; up[1] = a.y; up[2] = a.z; up[3] = a.w; up[4] = bq.x; up[5] = bq.y; up[6] = bq.z; up[7] = bq.w; }
        float hr = 0.f, hi = 0.f;
#pragma unroll 4
        for (int t = 0; t < 64; ++t) s5_step(hr, hi, ar, ai, br, bi, up, t);
        float* so = P.s5st + ((size_t)(b * 32 + c) * 32 + g) * 128; so[lane] = hr; so[64 + lane] = hi;
    }
    asm volatile("s_waitcnt vmcnt(0)" ::: "memory");
    __syncthreads();
    if (tid == 0) {
        __builtin_amdgcn_fence(__ATOMIC_RELEASE, "agent");
        asm volatile("s_waitcnt vmcnt(0)" ::: "memory");
        const unsigned old = __hip_atomic_fetch_add(P.cnt_s5 + 64 * b, 1u, __ATOMIC_RELAXED, __HIP_MEMORY_SCOPE_AGENT);
        if (old == 31u) { __builtin_amdgcn_fence(__ATOMIC_ACQUIRE, "agent"); asm volatile("s_waitcnt vmcnt(0)" ::: "memory"); }
        FLG[0] = (old == 31u) ? 1u : 0u;
    }
    __syncthreads();
    if (FLG[0] != 0u) {
#pragma unroll 1
        for (int k = 0; k < 4; ++k) { const int gn = tid + 512 * k, g = gn >> 6, n = gn & 63;
            const float a64r = P.abar64[gn * 2], a64i = P.abar64[gn * 2 + 1];
            float hr = 0.f, hi = 0.f;
            for (int c2 = 0; c2 < 32; ++c2) { const size_t o = ((size_t)(b * 32 + c2) * 32 + g) * 128 + n;
                P.s5in[o] = hr; P.s5in[o + 64] = hi;
                const float sr = P.s5st[o], si = P.s5st[o + 64];
                const float nr = a64r * hr - a64i * hi + sr, ni = a64r * hi + a64i * hr + si; hr = nr; hi = ni; } }
    }
    __syncthreads();
}
__device__ __forceinline__ void s5_passB(const LayerP& P, LAS unsigned char* lds, int item, int wave, int lane) {
    const int b = item >> 5, c = item & 31, fr = lane & 15, fq = lane >> 4; const size_t tok0 = (size_t)b * SEQ + c * 64;
    LAS bf16_t* Hm = (LAS bf16_t*)lds + wave * 32 * 136;
#pragma unroll 1
    for (int gi = 0; gi < 4; ++gi) {
        const int g = wave * 4 + gi;
        const float ar = P.abar[(g * 64 + lane) * 2], ai = P.abar[(g * 64 + lane) * 2 + 1];
        float br[16], bi[16];
#pragma unroll
        for (int j = 0; j < 16; ++j) { br[j] = P.bbar[(size_t)(g * 64 + lane) * 32 + j]; bi[j] = P.bbar[(size_t)(g * 64 + lane) * 32 + 16 + j]; }
        unsigned up[8];
        { const u32x4 a = *(const u32x4*)(P.proj + (tok0 + lane) * NP + C_S5U + g * 16), bq = *(const u32x4*)(P.proj + (tok0 + lane) * NP + C_S5U + g * 16 + 8);
          up[0] = a.x; up[1] = a.y; up[2] = a.z; up[3] = a.w; up[4] = bq.x; up[5] = bq.y; up[6] = bq.z; up[7] = bq.w; }
        bf16x8 cb[4];
#pragma unroll
        for (int ks = 0; ks < 4; ++ks) { const float* cp = ((ks < 2) ? P.s5_c_re : P.s5_c_im) + (size_t)(g * 16 + fr) * 64 + (ks & 1) * 32 + fq * 8; const float sg = (ks < 2) ? 1.f : -1.f;
            const f32x4 c0 = *(const f32x4*)cp, c1 = *(const f32x4*)(cp + 4);
            const unsigned p0 = pk2(sg * c0.x, sg * c0.y), p1 = pk2(sg * c0.z, sg * c0.w), p2 = pk2(sg * c1.x, sg * c1.y), p3 = pk2(sg * c1.z, sg * c1.w);
            cb[ks] = (bf16x8){(short)(p0 & 0xffff), (short)(p0 >> 16), (short)(p1 & 0xffff), (short)(p1 >> 16), (short)(p2 & 0xffff), (short)(p2 >> 16), (short)(p3 & 0xffff), (short)(p3 >> 16)}; }
        const size_t so = ((size_t)(b * 32 + c) * 32 + g) * 128;
        float hr = P.s5in[so + lane], hi = P.s5in[so + 64 + lane];
        const float dsk = P.s5_d[g * 16 + fr];
#pragma unroll 1
        for (int sub = 0; sub < 2; ++sub) {
#pragma unroll 4
            for (int tl = 0; tl < 32; ++tl) { s5_step(hr, hi, ar, ai, br, bi, up, sub * 32 + tl);
                Hm[tl * 136 + lane] = (bf16_t)f2bf(hr); Hm[tl * 136 + 64 + lane] = (bf16_t)f2bf(hi); }
            asm volatile("s_waitcnt lgkmcnt(0)" ::: "memory");
#pragma unroll
            for (int tt = 0; tt < 2; ++tt) { f32x4 acc = (f32x4){0.f, 0.f, 0.f, 0.f};
#pragma unroll
                for (int ks = 0; ks < 4; ++ks) { const bf16x8 af = *(const LAS bf16x8*)(Hm + (tt * 16 + fr) * 136 + ks * 32 + fq * 8);
                    acc = __builtin_amdgcn_mfma_f32_16x16x32_bf16(af, cb[ks], acc, 0, 0, 0); }
#pragma unroll
                for (int r = 0; r < 4; ++r) { const size_t tok = tok0 + sub * 32 + tt * 16 + fq * 4 + r;
                    const float y = acc[r] + dsk * bf2f(P.proj[tok * NP + C_S5U + g * 16 + fr]);
                    P.yg[tok * 512 + g * 16 + fr] = (bf16_t)f2bf(gelu_tanh(y)); } }
            asm volatile("s_waitcnt lgkmcnt(0)" ::: "memory");
        }
    }
    __syncthreads();
}

constexpr int AT_KP = 200, AT_VP = 72, AT_PP = 72;
constexpr int AT_K_OFF = 0, AT_V_OFF = 64 * AT_KP * 2, AT_P_OFF = AT_V_OFF + 128 * AT_VP * 2, AT_LDS = AT_P_OFF + 8 * 16 * AT_PP * 2;
__device__ __forceinline__ void attn_unit(const LayerP& P, LAS unsigned char* lds, int unit, int wave, int lane) {
    const int bh = unit >> 4, p = unit & 15, grp = wave >> 2, wq = wave & 3, tid = wave * 64 + lane;
    const int qb = grp ? 31 - p : p, q0 = qb * 64 + wq * 16, ntiles = 32 - p;
    const int fr = lane & 15, fq = lane >> 4;
    const bf16_t* Q = P.qf + (size_t)bh * SEQ * 192; const bf16_t* K = P.kf + (size_t)bh * SEQ * 192; const bf16_t* VT = P.vt + (size_t)bh * 128 * SEQ;
    bf16x8 qa[6];
#pragma unroll
    for (int ks = 0; ks < 6; ++ks) qa[ks] = *(const bf16x8*)(Q + (size_t)(q0 + fr) * 192 + ks * 32 + fq * 8);
    f32x4 o[8];
#pragma unroll
    for (int e = 0; e < 8; ++e) o[e] = (f32x4){0.f, 0.f, 0.f, 0.f};
    float m[4], l[4];
#pragma unroll
    for (int r = 0; r < 4; ++r) { m[r] = -1e30f; l[r] = 0.f; }
    u32x4 kr[3], vr[2];
    int krow[3], kcol[3], vrow[2], vcol[2];
#pragma unroll
    for (int i = 0; i < 3; ++i) { const int c = tid + 512 * i; krow[i] = c / 24; kcol[i] = c % 24; }
#pragma unroll
    for (int i = 0; i < 2; ++i) { const int c = tid + 512 * i; vrow[i] = c >> 3; vcol[i] = c & 7; }
#pragma unroll
    for (int i = 0; i < 3; ++i) kr[i] = *(const u32x4*)(K + (size_t)krow[i] * 192 + kcol[i] * 8);
#pragma unroll
    for (int i = 0; i < 2; ++i) vr[i] = *(const u32x4*)(VT + (size_t)vrow[i] * SEQ + vcol[i] * 8);
    LAS unsigned char* Ks = lds + AT_K_OFF; LAS unsigned char* Vs = lds + AT_V_OFF; LAS unsigned char* Ps = lds + AT_P_OFF + wave * (16 * AT_PP * 2);
    const float SCL = 0.07216878364870322f * 1.4426950408889634f;
    for (int j = 0; j < ntiles; ++j) {
        __syncthreads();
#pragma unroll
        for (int i = 0; i < 3; ++i) *(LAS u32x4*)(Ks + (krow[i] * AT_KP + kcol[i] * 8) * 2) = kr[i];
#pragma unroll
        for (int i = 0; i < 2; ++i) *(LAS u32x4*)(Vs + (vrow[i] * AT_VP + vcol[i] * 8) * 2) = vr[i];
        __syncthreads();
        if (j + 1 < ntiles) {
#pragma unroll
            for (int i = 0; i < 3; ++i) kr[i] = *(const u32x4*)(K + (size_t)((j + 1) * 64 + krow[i]) * 192 + kcol[i] * 8);
#pragma unroll
            for (int i = 0; i < 2; ++i) vr[i] = *(const u32x4*)(VT + (size_t)vrow[i] * SEQ + (j + 1) * 64 + vcol[i] * 8);
        }
        if (j <= qb) {
            f32x4 s[4];
#pragma unroll
            for (int nt = 0; nt < 4; ++nt) { s[nt] = (f32x4){0.f, 0.f, 0.f, 0.f};
#pragma unroll
                for (int ks = 0; ks < 6; ++ks) { const bf16x8 kb = *(const LAS bf16x8*)(Ks + ((nt * 16 + fr) * AT_KP + ks * 32 + fq * 8) * 2);
                    s[nt] = __builtin_amdgcn_mfma_f32_16x16x32_bf16(qa[ks], kb, s[nt], 0, 0, 0); } }
            const bool diag = (j == qb);
            float alpha[4];
#pragma unroll
            for (int r = 0; r < 4; ++r) {
                const int rowl = wq * 16 + fq * 4 + r;
                float mx = -1e30f;
#pragma unroll
                for (int nt = 0; nt < 4; ++nt) { float v = s[nt][r] * SCL; if (diag && (nt * 16 + fr) > rowl) v = -1e30f; s[nt][r] = v; mx = fmaxf(mx, v); }
                mx = xmax16(mx);
                const float mn = fmaxf(m[r], mx); alpha[r] = exp2f(m[r] - mn); m[r] = mn;
                float rs = 0.f;
#pragma unroll
                for (int nt = 0; nt < 4; ++nt) { const float pv = exp2f(s[nt][r] - mn); s[nt][r] = pv; rs += pv; }
                rs = xsum16(rs); l[r] = l[r] * alpha[r] + rs;
            }
#pragma unroll
            for (int e = 0; e < 8; ++e)
#pragma unroll
                for (int r = 0; r < 4; ++r) o[e][r] *= alpha[r];
#pragma unroll
            for (int nt = 0; nt < 4; ++nt)
#pragma unroll
                for (int r = 0; r < 4; ++r) *(LAS bf16_t*)(Ps + ((fq * 4 + r) * AT_PP + nt * 16 + fr) * 2) = (bf16_t)f2bf(s[nt][r]);
            asm volatile("s_waitcnt lgkmcnt(0)" ::: "memory");
#pragma unroll
            for (int ks = 0; ks < 2; ++ks) { const bf16x8 pa = *(const LAS bf16x8*)(Ps + (fr * AT_PP + ks * 32 + fq * 8) * 2);
#pragma unroll
                for (int e = 0; e < 8; ++e) { const bf16x8 vb = *(const LAS bf16x8*)(Vs + ((e * 16 + fr) * AT_VP + ks * 32 + fq * 8) * 2);
                    o[e] = __builtin_amdgcn_mfma_f32_16x16x32_bf16(pa, vb, o[e], 0, 0, 0); } }
        }
    }
    const int b = bh >> 2, h = bh & 3;
#pragma unroll
    for (int r = 0; r < 4; ++r) { const size_t tok = (size_t)b * SEQ + q0 + fq * 4 + r; const float il = 1.0f / l[r];
#pragma unroll
        for (int e = 0; e < 8; ++e) { const int col = h * 128 + e * 16 + fr; const float g = bf2f(P.proj[tok * NP + C_MG + col]);
            P.mix[tok * DM + 1536 + col] = (bf16_t)f2bf(o[e][r] * il * siluf_(g)); } }
    __syncthreads();
}

__device__ __forceinline__ void k_attn_naive(const LayerP& P, int lane, int gw, int ngw) {
    const float scale = 0.07216878364870322f;
    for (int w = gw; w < NB * 4 * SEQ; w += ngw) {
        const int bh = w / SEQ, s = (bh & 1) ? (SEQ - 1 - w % SEQ) : (w % SEQ); const size_t base = (size_t)bh * SEQ;
        const bf16_t* q = P.qf + (base + s) * 192;
        const float q0 = bf2f(q[lane]) * scale, q1 = bf2f(q[64 + lane]) * scale, q2 = bf2f(q[128 + lane]) * scale;
        float m = -1e30f, l = 0.f, o0 = 0.f, o1 = 0.f;
        for (int j = 0; j <= s; ++j) {
            const bf16_t* k = P.kf + (base + j) * 192; const bf16_t* v = P.vf + (base + j) * 128;
            const float sc = wave_sum(q0 * bf2f(k[lane]) + q1 * bf2f(k[64 + lane]) + q2 * bf2f(k[128 + lane]));
            const float mn = fmaxf(m, sc), corr = expf(m - mn), p = expf(sc - mn);
            l = l * corr + p; o0 = o0 * corr + p * bf2f(v[lane]); o1 = o1 * corr + p * bf2f(v[64 + lane]); m = mn;
        }
        const int b = bh / 4, h = bh % 4; const size_t tok = (size_t)b * SEQ + s;
        const float g0 = bf2f(P.proj[tok * NP + C_MG + h * 128 + lane]), g1 = bf2f(P.proj[tok * NP + C_MG + h * 128 + 64 + lane]);
        P.mix[tok * DM + 1536 + h * 128 + lane] = (bf16_t)f2bf(o0 / l * siluf_(g0));
        P.mix[tok * DM + 1536 + h * 128 + 64 + lane] = (bf16_t)f2bf(o1 / l * siluf_(g1));
    }
}


#define XB_TMO      128
#define XB_XCNT(j)  (256  + 64 * (j))
#define XB_XSUB(j)  (1280 + 64 * (j))
#define XB_XGEN(j)  (2304 + 64 * (j))
#define XB_TOP      3328
#define XB_TOPGEN   3392
#define XCD_BAR_WORDS 3456
#define XB_SPIN_CAP (1u << 18)
__device__ __forceinline__ unsigned xb_ld(unsigned* p)              { return __hip_atomic_load(p, __ATOMIC_RELAXED, __HIP_MEMORY_SCOPE_AGENT); }
__device__ __forceinline__ unsigned xb_add(unsigned* p, unsigned v) { return __hip_atomic_fetch_add(p, v, __ATOMIC_RELAXED, __HIP_MEMORY_SCOPE_AGENT); }
__device__ __forceinline__ unsigned xb_xcc_id() { return (unsigned)__builtin_amdgcn_s_getreg((3 << 11) | 20) & 0xFu; }
#define XB_SPIN(cond, bar) do { unsigned _sp = 0; while (cond) { __builtin_amdgcn_s_sleep(1); \
    if ((++_sp & 255u) == 0u) { if (xb_ld(&(bar)[XB_TMO])) break; if (_sp > XB_SPIN_CAP) { atomicAdd(&(bar)[XB_TMO], 1u); break; } } } } while (0)
struct XcdBarrier { unsigned* bar; unsigned x; volatile LAS unsigned* st; };
__device__ __forceinline__ XcdBarrier xcd_barrier_post(unsigned* bar, volatile LAS unsigned* st, bool leader) {
    XcdBarrier b; b.bar = bar; b.x = xb_xcc_id(); b.st = st;
    if (leader) (void)xb_add(&bar[XB_XCNT(b.x)], 1u);
    return b;
}
__device__ __forceinline__ void xcd_barrier_complete(unsigned* bar, unsigned x, unsigned& nloc, unsigned& nx) {
    const unsigned G = gridDim.x * gridDim.y * gridDim.z;
    unsigned sum, cnt, mine, sp = 0u;
    for (;;) {
        sum = 0u; cnt = 0u; mine = 0u;
#pragma unroll
        for (unsigned j = 0; j < 16; ++j) { const unsigned c = xb_ld(&bar[XB_XCNT(j)]); sum += c; cnt += (c > 0u) ? 1u : 0u; mine = (j == x) ? c : mine; }
        if (sum == G) break;
        __builtin_amdgcn_s_sleep(1);
        if ((++sp & 255u) == 0u) { if (xb_ld(&bar[XB_TMO])) break; if (sp > XB_SPIN_CAP) { atomicAdd(&bar[XB_TMO], 1u); break; } }
    }
    nloc = mine > 0u ? mine : 1u; nx = cnt > 0u ? cnt : 1u;
}
__device__ __forceinline__ void xcd_barrier(const XcdBarrier& b, bool leader) {
    asm volatile("s_waitcnt vmcnt(0)" ::: "memory");
    __syncthreads();
    if (leader) {
        unsigned* bar = b.bar;
        __builtin_amdgcn_s_waitcnt(0);
        unsigned nloc = b.st[0], nx = b.st[1];
        if (nloc == 0u) { xcd_barrier_complete(bar, b.x, nloc, nx); b.st[0] = nloc; b.st[1] = nx; }
        const unsigned old = xb_add(&bar[XB_XSUB(b.x)], 1u);
        const unsigned gen = old / nloc;
        if (old + 1u == (gen + 1u) * nloc) {
            __builtin_amdgcn_fence(__ATOMIC_RELEASE, "agent");
            asm volatile("s_waitcnt vmcnt(0)" ::: "memory");
            const unsigned og = xb_add(&bar[XB_TOP], 1u);
            const unsigned tg = og / nx;
            if (og + 1u == (tg + 1u) * nx) xb_add(&bar[XB_TOPGEN], 1u);
            else XB_SPIN(xb_ld(&bar[XB_TOPGEN]) == tg, bar);
            __builtin_amdgcn_fence(__ATOMIC_ACQUIRE, "agent");
            xb_add(&bar[XB_XGEN(b.x)], 1u);
            asm volatile("s_waitcnt vmcnt(0)" ::: "memory");
        } else {
            XB_SPIN(xb_ld(&bar[XB_XGEN(b.x)]) == gen, bar);
            __builtin_amdgcn_fence(__ATOMIC_ACQUIRE, "agent");
            asm volatile("s_waitcnt vmcnt(0)" ::: "memory");
        }
    }
    __syncthreads();
}

constexpr size_t MiB = 1u << 20;
constexpr size_t WS_CTL = 0, CTL_ZERO_BYTES = 65536;
constexpr size_t WS_WIN = 1 * MiB;
constexpr size_t WS_WOUT = WS_WIN + 80 * MiB;
constexpr size_t WS_WUQ = WS_WOUT + 32 * MiB;
constexpr size_t WS_WUKV = WS_WUQ + 3 * MiB;
constexpr size_t WS_WGLU = WS_WUKV + 1 * MiB;
constexpr size_t WS_ABAR = WS_WGLU + 2 * MiB;
constexpr size_t WS_BBAR = WS_ABAR + 1 * MiB;
constexpr size_t WS_HB = WS_BBAR + 2 * MiB;
constexpr size_t WS_RSTD = WS_HB + 32 * MiB;
constexpr size_t WS_PROJ = WS_RSTD + 1 * MiB;
constexpr size_t WS_DTF = WS_PROJ + 80 * MiB;
constexpr size_t WS_DTV = WS_DTF + 1 * MiB;
constexpr size_t WS_XBCC = WS_DTV + 1 * MiB;
constexpr size_t WS_YS = WS_XBCC + 24 * MiB;
constexpr size_t WS_MIX = WS_YS + 16 * MiB;
constexpr size_t WS_HS = WS_MIX + 32 * MiB;
constexpr size_t WS_YG = WS_HS + 128 * MiB;
constexpr size_t WS_EG = WS_YG + 8 * MiB;
constexpr size_t WS_OG = WS_EG + 8 * MiB;
constexpr size_t WS_QRAW = WS_OG + 16 * MiB;
constexpr size_t WS_KVRAW = WS_QRAW + 12 * MiB;
constexpr size_t WS_QF = WS_KVRAW + 16 * MiB;
constexpr size_t WS_KF = WS_QF + 12 * MiB;
constexpr size_t WS_VF = WS_KF + 12 * MiB;
constexpr size_t WS_SST = WS_VF + 8 * MiB;
constexpr size_t WS_HIN = WS_SST + 16 * MiB;
constexpr size_t WS_GST = WS_HIN + 8 * MiB;
constexpr size_t WS_GIN = WS_GST + 16 * MiB;
constexpr size_t WS_END = WS_GIN + 8 * MiB;
constexpr int CW_GLA = 10240, CW_S5 = 12288;
constexpr int CW_SSD = 8192;
constexpr int CW_BAR = 1024;

__device__ __forceinline__ void* uptr_(unsigned long long v) {
    const unsigned lo = __builtin_amdgcn_readfirstlane((unsigned)v), hi = __builtin_amdgcn_readfirstlane((unsigned)(v >> 32));
    return (void*)(((unsigned long long)hi << 32) | lo);
}
struct MegaArgs { const float* in[30]; float* out; unsigned char* ws; };
constexpr int LDS_TAB = pg8::STAGE_BYTES + 64, LDS_TOTAL = LDS_TAB + 256;

__global__ void __launch_bounds__(512, 2) mega_fwd(MegaArgs a) {
    __shared__ __attribute__((aligned(16))) unsigned char lds_raw[LDS_TOTAL];
    LAS unsigned char* lds = (LAS unsigned char*)lds_raw;
    const int wave_s = __builtin_amdgcn_readfirstlane((int)threadIdx.x >> 6);
    const int G = (int)gridDim.x, ngw = G * 8; const size_t gth = (size_t)G * 512;
#define IDS() int lane_ = lane_id(), wave_ = wave_s, bid_ = blockIdx.x; asm volatile("" : "+v"(lane_), "+s"(wave_), "+s"(bid_)); const int lane = lane_, wave = __builtin_amdgcn_readfirstlane(wave_), tid_ = wave * 64 + lane_, gw = __builtin_amdgcn_readfirstlane(bid_) * 8 + wave; (void)tid_; const size_t gtid = (size_t)bid_ * 512 + tid_; (void)lane; (void)gw; (void)gtid;
    volatile LAS unsigned* st = (volatile LAS unsigned*)(lds + pg8::STAGE_BYTES);
    { const int tid = wave_s * 64 + lane_id(); if (tid < 16) st[tid] = 0u; }
    __syncthreads();
    LAS unsigned long long* tab = (LAS unsigned long long*)(lds + LDS_TAB);
    { const int tid = wave_s * 64 + lane_id();
      if (tid < 30) tab[tid] = (unsigned long long)a.in[tid];
      if (tid == 30) tab[30] = (unsigned long long)a.out;
      if (tid == 31) tab[31] = (unsigned long long)a.ws; }
    __syncthreads();
#define TABP(i) ((const float*)uptr_(tab[i]))
#define WSP() ((unsigned char*)uptr_(tab[31]))
#define OUTP() ((float*)uptr_(tab[30]))
    (void)xcd_barrier_post((unsigned*)(WSP() + WS_CTL) + CW_BAR, st, wave_s == 0 && lane_id() == 0);
#define GRID_BAR() do { XcdBarrier b2_; b2_.bar = (unsigned*)(WSP() + WS_CTL) + CW_BAR; b2_.x = xb_xcc_id(); b2_.st = st; int w_ = wave_s; asm volatile("" : "+s"(w_)); xcd_barrier(b2_, (w_ * 64 + lane_id()) == 0); } while (0)
#define FIN(i) TABP(i)
    {
        unsigned char* ws = WSP();
        bf16_t* win = (bf16_t*)(ws + WS_WIN); bf16_t* wout = (bf16_t*)(ws + WS_WOUT); bf16_t* wuq = (bf16_t*)(ws + WS_WUQ); bf16_t* wukv = (bf16_t*)(ws + WS_WUKV); bf16_t* wglu = (bf16_t*)(ws + WS_WGLU);
        float* abar = (float*)(ws + WS_ABAR); float* bbar = (float*)(ws + WS_BBAR);
        constexpr int T0 = 80 * 32 * 4, T1 = 32 * 32 * 4, T2 = 12 * 6 * 4, T3 = 16 * 2 * 4, T4 = 8 * 8 * 4, TT = T0 + T1 + T2 + T3 + T4;
        IDS(); const int half = tid_ >> 8, t256 = tid_ & 255;
        LAS float* tile = (LAS float*)(lds + half * 16640);
        for (int it = (int)blockIdx.x; it * 2 < TT; it += G) {
            int r = it * 2 + half; const bool valid = r < TT;
            const float* s = nullptr; const float* sc = nullptr; bf16_t* d = nullptr; int K = 0, Nsrc = 0, Ndst = 0, mode = 0, tn = 1, tpl = 1;
            if (r < T0) { s = FIN(3); sc = FIN(2); d = win; K = DM; Nsrc = D_IN; Ndst = NP; mode = 1; tn = 80; tpl = 80 * 32; }
            else if ((r -= T0) < T1) { s = FIN(4); d = wout; K = DM; Nsrc = DM; Ndst = DM; tn = 32; tpl = 32 * 32; }
            else if ((r -= T1) < T2) { s = FIN(25); sc = FIN(24); d = wuq; K = 384; Nsrc = 768; Ndst = 768; tn = 12; tpl = 72; }
            else if ((r -= T2) < T3) { s = FIN(27); sc = FIN(26); d = wukv; K = 128; Nsrc = 1024; Ndst = 1024; tn = 16; tpl = 32; }
            else { r -= T3; s = FIN(19); d = wglu; K = 512; Nsrc = 512; Ndst = 512; tn = 8; tpl = 64; }
            const int l = r / tpl, r2 = r % tpl, n0 = (r2 % tn) * 64, k0 = (r2 / tn) * 64;
            if (valid) wtrans_read(s + (size_t)l * K * Nsrc, Nsrc, sc ? sc + (size_t)l * K : nullptr, mode, n0, k0, tile, t256);
            __syncthreads();
            if (valid) wtrans_write(d + (size_t)l * Ndst * K, K, n0, k0, tile, t256);
            __syncthreads();
        }
        if (gtid < (size_t)(DEPTH * 32 * 64)) s5prep_item((int)gtid, FIN(11), FIN(12), FIN(13), FIN(14), FIN(15), abar, bbar, (float*)(ws + WS_ABAR + 512 * 1024));
    }

#define MAKE_P() LayerP P; { unsigned char* ws = WSP(); \
        P.conv_w = FIN(5) + (size_t)l * 4 * 768; P.conv_b = FIN(6) + (size_t)l * 768; P.dt_bias = FIN(7) + l * 8; P.a_log = FIN(8) + l * 8; P.ssd_d = FIN(9) + l * 8; P.ssd_norm_w = FIN(10) + l * 512; \
        P.s5_c_re = FIN(16) + (size_t)l * 32 * 16 * 64; P.s5_c_im = FIN(17) + (size_t)l * 32 * 16 * 64; P.s5_d = FIN(18) + l * 512; P.abar = (float*)(ws + WS_ABAR) + (size_t)l * 32 * 64 * 2; P.bbar = (float*)(ws + WS_BBAR) + (size_t)l * 32 * 64 * 32; \
        P.gla_w2 = FIN(21) + (size_t)l * 16 * 256; P.gla_gb = FIN(22) + l * 256; P.gla_norm_w = FIN(23) + l * 128; \
        P.qh_w = FIN(28) + l * 192; P.kh_w = FIN(29) + l * 192; P.pos = (const int*)FIN(1); \
        P.proj = (bf16_t*)(ws + WS_PROJ); P.dtf = (float*)(ws + WS_DTF); \
        P.xbcc = (float*)(ws + WS_XBCC); P.dtv = (float*)(ws + WS_DTV); P.ys = (float*)(ws + WS_YS); P.hs = (float*)(ws + WS_HS); P.eg = (float*)(ws + WS_EG); P.og = (float*)(ws + WS_OG); \
        P.yg = (bf16_t*)(ws + WS_YG); P.mix = (bf16_t*)(ws + WS_MIX); P.qraw = (bf16_t*)(ws + WS_QRAW); P.kvraw = (bf16_t*)(ws + WS_KVRAW); \
        P.qf = (bf16_t*)(ws + WS_QF); P.kf = (bf16_t*)(ws + WS_KF); P.vf = (bf16_t*)(ws + WS_VF); P.vt = (bf16_t*)(ws + WS_VF); \
        P.xbcn = (bf16_t*)(ws + WS_XBCC); P.xT = (bf16_t*)(ws + WS_YS); P.hin = (bf16_t*)(ws + WS_HIN); P.csv = (float*)(ws + WS_DTV + 512 * 1024); P.cse = (float*)(ws + WS_DTV + 768 * 1024); P.sst = (float*)(ws + WS_SST); \
        P.cnt_ssd = (unsigned*)(ws + WS_CTL) + CW_SSD + l * 8 * 64; \
        P.qt = (bf16_t*)(ws + WS_EG); P.kt = (bf16_t*)(ws + WS_EG + 4 * MiB); P.vT2 = (bf16_t*)(ws + WS_OG); P.glb = (float*)(ws + WS_OG + 8 * MiB); P.gst = (float*)(ws + WS_GST); P.gin = (bf16_t*)(ws + WS_GIN); \
        P.cnt_gla = (unsigned*)(ws + WS_CTL) + CW_GLA + l * 8 * 64; \
        P.abar64 = (const float*)(ws + WS_ABAR + 512 * 1024) + (size_t)l * 32 * 64 * 2; P.s5st = (float*)(ws + WS_HS); P.s5in = (float*)(ws + WS_HS + 4 * MiB); P.cnt_s5 = (unsigned*)(ws + WS_CTL) + CW_S5 + l * 8 * 64; }
#define RUN_GEMM(EPI, gA, gBt, gN, gK, glda, gldb, ESET) do { pg8::Gemm g; g.A = (gA); g.Bt = (gBt); g.M = TOK; g.N = (gN); g.K = (gK); g.lda = (glda); g.ldb = (gldb); g.pad = 0; \
        pg8::EPI E; ESET; int bid_ = blockIdx.x; asm volatile("" : "+s"(bid_)); pg8::StaticOrder S; S.init(g.M, g.N, G, bid_); pg8::gemm_phase<pg8::EPI, pg8::StaticOrder, true>(lds, g, S, E, wave_s); } while (0)

#pragma clang loop unroll(disable)
    for (int l = 0; l < DEPTH; ++l) {
        { IDS(); unsigned char* ws = WSP(); const float* hin = (l == 0) ? FIN(0) : (const float*)OUTP();
          k_rowprep(hin, (bf16_t*)(ws + WS_HB), (float*)(ws + WS_RSTD), lane, gw, ngw); }
        GRID_BAR();
        { unsigned char* ws = WSP();
          RUN_GEMM(EpiP1, (const bf16_t*)(ws + WS_HB), (const bf16_t*)(ws + WS_WIN) + (size_t)l * NP * DM, NP, DM, DM, DM,
                   (E.O = (bf16_t*)(ws + WS_PROJ), E.rstd = (const float*)(ws + WS_RSTD), E.dtf = (float*)(ws + WS_DTF))); }
        GRID_BAR();
        { IDS(); MAKE_P();
          for (int it = bid_; it < 128; it += G) ssd_passA(P, lds, it, wave, lane);
          for (int it = bid_ - 128; it < 128; it += G) if (it >= 0) { gla_passA(P, lds, it, wave, lane); s5_passA(P, lds, it, wave, lane); } }
        { unsigned char* ws = WSP();
          RUN_GEMM(EpiBf16, (const bf16_t*)(ws + WS_PROJ) + C_CQ, (const bf16_t*)(ws + WS_WUQ) + (size_t)l * 768 * 384, 768, 384, NP, 384, (E.O = (bf16_t*)(ws + WS_QRAW), E.ldc = 768, E.pad = 0)); }
        { unsigned char* ws = WSP();
          RUN_GEMM(EpiBf16, (const bf16_t*)(ws + WS_PROJ) + C_CKV, (const bf16_t*)(ws + WS_WUKV) + (size_t)l * 1024 * 128, 1024, 128, NP, 128, (E.O = (bf16_t*)(ws + WS_KVRAW), E.ldc = 1024, E.pad = 0)); }
        GRID_BAR();
        { IDS(); MAKE_P(); k_mla_fin(P, lane, gw, ngw);
          for (int it = bid_; it < 128; it += G) { s5_passB(P, lds, it, wave, lane); ssd_passB(P, lds, it, wave, lane); }
          for (int it = bid_ - 128; it < 128; it += G) if (it >= 0) gla_passB(P, lds, it, wave, lane); }
        GRID_BAR();
        { IDS(); MAKE_P();
          for (int u = bid_; u < 256; u += G) attn_unit(P, lds, u, wave, lane); }
        { unsigned char* ws = WSP();
          RUN_GEMM(EpiGlu, (const bf16_t*)(ws + WS_YG), (const bf16_t*)(ws + WS_WGLU) + (size_t)l * 512 * 512, 512, 512, 512, 512,
                   (E.yg = (const bf16_t*)(ws + WS_YG), E.proj = (const bf16_t*)(ws + WS_PROJ), E.bias = FIN(20) + l * 512, E.mix = (bf16_t*)(ws + WS_MIX))); }
        GRID_BAR();
        { unsigned char* ws = WSP(); const float* hin = (l == 0) ? FIN(0) : (const float*)OUTP();
          RUN_GEMM(EpiRes, (const bf16_t*)(ws + WS_MIX), (const bf16_t*)(ws + WS_WOUT) + (size_t)l * DM * DM, DM, DM, DM, DM, (E.base = hin, E.out = OUTP())); }
        if (l + 1 < DEPTH) GRID_BAR();
    }
}

extern "C" void kernel_launch(void* const* d_in, const int* in_sizes, int n_in, void* d_out, int out_size, void* d_ws, size_t ws_size, hipStream_t stream) {
    static int grid = 0;
    if (grid == 0) {
        if (n_in != 30 || out_size != TOK * DM || ws_size < WS_END) { fprintf(stderr, "kernel_launch: unexpected shapes (n_in %d out %d ws %zu need %zu)\n", n_in, out_size, ws_size, (size_t)WS_END); grid = -1; return; }
        int dev = 0, cus = 0;
        if (hipGetDevice(&dev) != hipSuccess || hipDeviceGetAttribute(&cus, hipDeviceAttributeMultiprocessorCount, dev) != hipSuccess || cus <= 0) { fprintf(stderr, "kernel_launch: device query failed\n"); grid = -1; return; }
        grid = cus;
    }
    if (grid < 0) return;
    (void)hipMemsetAsync((char*)d_ws + WS_CTL, 0, CTL_ZERO_BYTES, stream);
    MegaArgs a{};
    for (int i = 0; i < 30; ++i) a.in[i] = (const float*)d_in[i];
    a.out = (float*)d_out; a.ws = (unsigned char*)d_ws;
    hipLaunchKernelGGL(mega_fwd, dim3(grid), dim3(512), 0, stream, a);
}
```

```cpp
#include <hip/hip_runtime.h>
#include <cstdio>
#include <cstdint>

#define LAS __attribute__((address_space(3)))
typedef unsigned short bf16_t;
typedef short bf16x8 __attribute__((ext_vector_type(8)));
typedef float f32x4 __attribute__((ext_vector_type(4)));
typedef unsigned u32x4 __attribute__((ext_vector_type(4)));
typedef unsigned u32x2 __attribute__((ext_vector_type(2)));

constexpr int DM = 2048, NB = 4, SEQ = 2048, DEPTH = 4, TOK = NB * SEQ;
constexpr int D_IN = 4952, NP = 5120;
constexpr float EPS = 1e-6f;
constexpr int C_Z = 0, C_XBC = 512, C_S5U = 1280, C_S5G = 1792, C_GQ = 2304, C_GK = 2560, C_GV = 2816, C_GG = 3328,
              C_CQ = 3840, C_CKV = 4224, C_KPE = 4352, C_DT = 4416, C_GLR = 4424, C_PAD = 4440, C_MG = 4608;
__host__ __device__ __forceinline__ int win_src_col(int n) {
    if (n < 1280) return n;
    if (n < C_GQ) return n + 8;
    if (n < C_CQ) return n + 8;
    if (n < C_KPE) return n + 24;
    if (n < C_DT) return n + 24;
    if (n < C_GLR) return n - C_DT + 1280;
    if (n < C_PAD) return n - C_GLR + 3848;
    if (n < C_MG) return -1;
    return n - C_MG + 4440;
}

__device__ __forceinline__ int lane_id() { int l; asm volatile("v_mbcnt_lo_u32_b32 %0, -1, 0\n\tv_mbcnt_hi_u32_b32 %0, -1, %0" : "=v"(l)); return l; }
__device__ __forceinline__ float bf2f(bf16_t v) { return __uint_as_float(((unsigned)v) << 16); }
__device__ __forceinline__ unsigned f2bf(float f) { unsigned u = __float_as_uint(f); return (u + 0x7fffu + ((u >> 16) & 1u)) >> 16; }
__device__ __forceinline__ unsigned pk2(float lo, float hi) { return f2bf(lo) | (f2bf(hi) << 16); }
template <int X> __device__ __forceinline__ float swz_xor(float v) { return __int_as_float(__builtin_amdgcn_ds_swizzle(__float_as_int(v), (X << 10) | 0x1f)); }
__device__ __forceinline__ float xor32_other(float v, int lane) {
    auto r = __builtin_amdgcn_permlane32_swap(__float_as_uint(v), __float_as_uint(v), false, false);
    return __uint_as_float(lane < 32 ? r[1] : r[0]); }
__device__ __forceinline__ float wave_sum(float v) {
    v += swz_xor<1>(v); v += swz_xor<2>(v); v += swz_xor<4>(v); v += swz_xor<8>(v); v += swz_xor<16>(v);
    auto r = __builtin_amdgcn_permlane32_swap(__float_as_uint(v), __float_as_uint(v), false, false);
    return __uint_as_float(r[0]) + __uint_as_float(r[1]);
}
__device__ __forceinline__ float xmax16(float v) {
    v = fmaxf(v, swz_xor<1>(v)); v = fmaxf(v, swz_xor<2>(v)); v = fmaxf(v, swz_xor<4>(v)); v = fmaxf(v, swz_xor<8>(v)); return v; }
__device__ __forceinline__ float xsum16(float v) {
    v += swz_xor<1>(v); v += swz_xor<2>(v); v += swz_xor<4>(v); v += swz_xor<8>(v); return v; }
__device__ __forceinline__ float sigmoidf_(float x) { return 1.0f / (1.0f + expf(-x)); }
__device__ __forceinline__ float siluf_(float x) { return x * sigmoidf_(x); }
__device__ __forceinline__ float softplusf_(float x) { return x > 20.f ? x : log1pf(expf(x)); }
__device__ __forceinline__ float gelu_tanh(float x) { const float c = 0.7978845608028654f; return 0.5f * x * (1.0f + tanhf(c * (x + 0.044715f * x * x * x))); }

namespace pg8 {
constexpr int BM = 256, BK = 64, HALF = 128, HTB = HALF * BK * 2, STAGE_BYTES = 8 * HTB, NXCD = 8, WGM = 8;
__host__ __device__ __forceinline__ int lds_byte(int r, int c) { const int st = (r >> 4) * 2 + (c >> 5), rr = r & 15, cc = c & 31, ob = rr * 64 + cc * 2; return st * 1024 + (ob ^ (((ob >> 9) & 1) << 5)); }
__host__ __device__ __forceinline__ void stage_rc(int b, int& R, int& C) { const int st = b / 1024, sb = b % 1024, swz = sb ^ (((sb >> 9) & 1) << 5); R = (st >> 1) * 16 + swz / 64; C = (st & 1) * 32 + (swz % 64) / 2; }
__host__ __device__ __forceinline__ int perm32(int rho) { const int n = rho >> 4, i = rho & 15; return 8 * (i >> 2) + 4 * n + (i & 3); }
struct Unit { int pm, pn; };
struct Gemm { const bf16_t* A; const bf16_t* Bt; int M, N, K, lda, ldb, pad; };
struct StaticOrder {
    int nM, nN, nwg, G, c;
    __host__ __device__ void init(int M, int N, int G_, int c_) { nM = M / BM; nN = N / BM; nwg = nM * nN; G = G_; c = c_; }
    __host__ __device__ bool next(int i, Unit& u) const {
        const long L = (long)i * G + c; if (L >= nwg) return false;
        int wgid = (int)L; { const int q = nwg / NXCD, r = nwg % NXCD, xcd = wgid % NXCD, off = wgid / NXCD; wgid = (xcd < r ? xcd * (q + 1) : r * (q + 1) + (xcd - r) * q) + off; }
        const int nig = WGM * nN, gid = wgid / nig, fm = gid * WGM, gsz = (nM - fm) < WGM ? (nM - fm) : WGM;
        u.pm = fm + ((wgid % nig) % gsz); u.pn = (wgid % nig) / gsz; return true;
    }
};
__device__ __forceinline__ void glds16_s(const void* sbase, unsigned voff, unsigned lds_dst) {
    unsigned keep;
    asm volatile("s_nop 4\n\ts_mov_b32 %0, m0\n\ts_mov_b32 m0, %2\n\ts_nop 0\n\tglobal_load_lds_dwordx4 %1, %3\n\ts_mov_b32 m0, %0" : "=&s"(keep) : "v"(voff), "s"(lds_dst), "s"(sbase) : "memory");
}
__device__ __forceinline__ unsigned cvt_pk_bf16(float lo, float hi) { unsigned r; asm volatile("v_cvt_pk_bf16_f32 %0, %1, %2" : "=v"(r) : "v"(lo), "v"(hi)); return r; }

template <class Epi, class Sched, bool ALIGN_EPI>
__device__ __forceinline__ void gemm_phase(LAS unsigned char* lds, const Gemm g, const Sched& S, const Epi& E, int wid_in) {
    int lane = lane_id(), wid0 = wid_in; asm volatile("" : "+v"(lane), "+s"(wid0)); const int wid = __builtin_amdgcn_readfirstlane(wid0);
    const int tid = wid * 64 + lane, wr = wid >> 2, wc = wid & 3, fr = lane & 15, fq = lane >> 4;
    const int K = g.K, nt = K / BK;
    unsigned voffA[2], voffB[2];
#pragma unroll
    for (int i = 0; i < 2; ++i) { int R, C; stage_rc(tid * 16 + i * 8192, R, C); const int Rb = Epi::PERM ? ((R & ~31) + perm32(R & 31)) : R;
        voffA[i] = (unsigned)(R * g.lda + C) * 2u; voffB[i] = (unsigned)(Rb * g.ldb + C) * 2u; }
    const size_t kstep = (size_t)(BK * 2);
    const size_t hstepA = (size_t)HALF * g.lda * 2, hstepB = (size_t)HALF * g.ldb * 2;
    const size_t tstepA = 2 * hstepA, tstepB = 2 * hstepB;
    const unsigned ldsw = (unsigned)wid * 1024u, ldsbase = (unsigned)(uintptr_t)lds;
    const int aoff = lds_byte(wr * 64 + fr, fq * 8), boff = lds_byte(wc * 32 + fr, fq * 8);
#define PG8_SA(b, h) (((b) * 2 + (h)) * HTB)
#define PG8_SB(b, h) ((4 + (b) * 2 + (h)) * HTB)
#define PG8_STAGE(bufoff, gbase, voff) do { _Pragma("unroll") for (int _i = 0; _i < 2; ++_i) \
        glds16_s((const void*)(gbase), (voff)[_i], (unsigned)__builtin_amdgcn_readfirstlane((int)(ldsbase + (unsigned)(bufoff) + ldsw + (unsigned)(_i * 8192)))); } while (0)
#define PG8_LDA(dst, b, h) do { _Pragma("unroll") for (int m = 0; m < 4; ++m) _Pragma("unroll") for (int k = 0; k < 2; ++k) dst[m][k] = *(const LAS bf16x8*)(lds + PG8_SA(b, h) + aoff + m * 2048 + k * 1024); } while (0)
#define PG8_LDB(dst, b, h) do { _Pragma("unroll") for (int n = 0; n < 2; ++n) _Pragma("unroll") for (int k = 0; k < 2; ++k) dst[n][k] = *(const LAS bf16x8*)(lds + PG8_SB(b, h) + boff + n * 2048 + k * 1024); } while (0)
#define PG8_MMA(ai, bj, At, Bt) do { __builtin_amdgcn_s_setprio(1); _Pragma("unroll") for (int m = 0; m < 4; ++m) _Pragma("unroll") for (int n = 0; n < 2; ++n) _Pragma("unroll") for (int k = 0; k < 2; ++k) \
        acc[ai][bj][m][n] = __builtin_amdgcn_mfma_f32_16x16x32_bf16(Bt[n][k], At[m][k], acc[ai][bj][m][n], 0, 0, 0); __builtin_amdgcn_s_setprio(0); } while (0)
#define PG8_WAIT_V(n) asm volatile("s_waitcnt vmcnt(" #n ")" ::: "memory")
#define PG8_WAIT_L(n) asm volatile("s_waitcnt lgkmcnt(" #n ")" ::: "memory")
#define PG8_BAR __builtin_amdgcn_s_barrier()
#define PG8_SCHED __builtin_amdgcn_sched_barrier(0)
    Unit cur, nxt; int ui = 0;
    if (!S.next(0, cur)) return;
    f32x4 acc[2][2][4][2];
#pragma unroll
    for (int a = 0; a < 2; ++a)
#pragma unroll
        for (int b = 0; b < 2; ++b)
#pragma unroll
            for (int m = 0; m < 4; ++m)
#pragma unroll
                for (int n = 0; n < 2; ++n) acc[a][b][m][n] = (f32x4){0.f, 0.f, 0.f, 0.f};
    bf16x8 At[4][2], B0[2][2], B1[2][2];
    const char* cA = (const char*)g.A + (size_t)cur.pm * tstepA; const char* cB = (const char*)g.Bt + (size_t)cur.pn * tstepB;
    PG8_STAGE(PG8_SB(0, 0), cB, voffB); PG8_STAGE(PG8_SB(0, 1), cB + hstepB, voffB); PG8_STAGE(PG8_SA(0, 0), cA, voffA); PG8_STAGE(PG8_SA(0, 1), cA + hstepA, voffA);
    if (wr == 1) PG8_BAR;
    PG8_WAIT_V(2); PG8_BAR;
    PG8_STAGE(PG8_SB(1, 0), cB + kstep, voffB); PG8_STAGE(PG8_SA(1, 0), cA + kstep, voffA); PG8_STAGE(PG8_SB(1, 1), cB + hstepB + kstep, voffB);
    PG8_WAIT_V(6); PG8_BAR;
    for (;;) {
        const bool has_next = S.next(ui + 1, nxt);
        const char* nA = has_next ? (const char*)g.A + (size_t)nxt.pm * tstepA : cA; const char* nB = has_next ? (const char*)g.Bt + (size_t)nxt.pn * tstepB : cB;
        for (int t = 0; t < nt; t += 2) {
            const bool last = (t == nt - 2);
            const char* a1 = cA + (size_t)(t + 1) * kstep;
            const char* a2 = last ? nA : cA + (size_t)(t + 2) * kstep; const char* b2 = last ? nB : cB + (size_t)(t + 2) * kstep;
            const char* a3 = a2 + kstep; const char* b3 = b2 + kstep;
            PG8_LDB(B0, 0, 0); PG8_LDB(B1, 0, 1); PG8_SCHED; PG8_LDA(At, 0, 0); PG8_STAGE(PG8_SA(1, 1), a1 + hstepA, voffA);
            PG8_WAIT_V(8); PG8_WAIT_L(0); PG8_BAR; PG8_MMA(0, 0, At, B0); PG8_MMA(0, 1, At, B1); PG8_BAR; PG8_SCHED;
            PG8_LDA(At, 0, 1); PG8_STAGE(PG8_SB(0, 0), b2, voffB); PG8_STAGE(PG8_SB(0, 1), b2 + hstepB, voffB); PG8_STAGE(PG8_SA(0, 0), a2, voffA);
            PG8_WAIT_V(8); PG8_WAIT_L(0); PG8_BAR; PG8_MMA(1, 0, At, B0); PG8_MMA(1, 1, At, B1); PG8_BAR; PG8_SCHED;
            PG8_LDB(B0, 1, 0); PG8_LDB(B1, 1, 1); PG8_SCHED; PG8_LDA(At, 1, 0); PG8_STAGE(PG8_SA(0, 1), a2 + hstepA, voffA);
            PG8_WAIT_V(8); PG8_WAIT_L(0); PG8_BAR; PG8_MMA(0, 0, At, B0); PG8_MMA(0, 1, At, B1); PG8_BAR; PG8_SCHED;
            PG8_LDA(At, 1, 1); PG8_STAGE(PG8_SB(1, 0), b3, voffB); PG8_STAGE(PG8_SB(1, 1), b3 + hstepB, voffB); PG8_STAGE(PG8_SA(1, 0), a3, voffA);
            PG8_WAIT_V(8); PG8_WAIT_L(0); PG8_BAR; PG8_MMA(1, 0, At, B0); PG8_MMA(1, 1, At, B1); PG8_BAR; PG8_SCHED;
        }
        if constexpr (ALIGN_EPI) { if (wr == 0) PG8_BAR; }
        E(acc, cur, wr, wc, fr, fq);
        if (!has_next) break;
#pragma unroll
        for (int a = 0; a < 2; ++a)
#pragma unroll
            for (int b = 0; b < 2; ++b)
#pragma unroll
                for (int m = 0; m < 4; ++m)
#pragma unroll
                    for (int n = 0; n < 2; ++n) acc[a][b][m][n] = (f32x4){0.f, 0.f, 0.f, 0.f};
        cur = nxt; cA = nA; cB = nB; ++ui;
        if constexpr (ALIGN_EPI) { if (wr == 1) PG8_BAR; }
    }
    PG8_WAIT_V(0);
    if constexpr (!ALIGN_EPI) { if (wr == 0) PG8_BAR; }
    PG8_BAR;
#undef PG8_SA
#undef PG8_SB
#undef PG8_STAGE
#undef PG8_LDA
#undef PG8_LDB
#undef PG8_MMA
#undef PG8_WAIT_V
#undef PG8_WAIT_L
#undef PG8_BAR
#undef PG8_SCHED
}

struct EpiBf16 {
    static constexpr bool PERM = true;
    bf16_t* O; int ldc, pad;
    __device__ __forceinline__ void operator()(const f32x4 (&acc)[2][2][4][2], const Unit& u, int wr_, int wc_, int fr_, int fq_) const {
        const int ln_ = lane_id(), fr = ln_ & 15, fq = ln_ >> 4; (void)fr_; (void)fq_; const int wr = wr_, wc = wc_;
        const int row0 = u.pm * BM + wr * 64 + fr, col0 = u.pn * BM + wc * 32 + 8 * fq;
#pragma unroll
        for (int ai = 0; ai < 2; ++ai)
#pragma unroll
            for (int m = 0; m < 4; ++m) { bf16_t* rowp = O + (size_t)(row0 + ai * HALF + m * 16) * ldc + col0;
#pragma unroll
                for (int bj = 0; bj < 2; ++bj) { const f32x4 v0 = acc[ai][bj][m][0], v1 = acc[ai][bj][m][1];
                    u32x4 w; w.x = cvt_pk_bf16(v0[0], v0[1]); w.y = cvt_pk_bf16(v0[2], v0[3]); w.z = cvt_pk_bf16(v1[0], v1[1]); w.w = cvt_pk_bf16(v1[2], v1[3]);
                    *(u32x4*)(rowp + bj * HALF) = w; } }
    }
};
struct EpiP1 {
    static constexpr bool PERM = true;
    bf16_t* O; const float* rstd; float* dtf;
    __device__ __forceinline__ void operator()(const f32x4 (&acc)[2][2][4][2], const Unit& u, int wr_, int wc_, int fr_, int fq_) const {
        const int ln_ = lane_id(), fr = ln_ & 15, fq = ln_ >> 4; (void)fr_; (void)fq_; const int wr = wr_, wc = wc_;
        const int row0 = u.pm * BM + wr * 64 + fr, col0 = u.pn * BM + wc * 32 + 8 * fq;
        const bool isdt = (u.pn == C_DT / 256) && (wc * 32 + 8 * fq == C_DT % 256);
#pragma unroll
        for (int ai = 0; ai < 2; ++ai)
#pragma unroll
            for (int m = 0; m < 4; ++m) { const int row = row0 + ai * HALF + m * 16; const float rs = rstd[row]; bf16_t* rowp = O + (size_t)row * NP + col0;
#pragma unroll
                for (int bj = 0; bj < 2; ++bj) { const f32x4 v0 = acc[ai][bj][m][0] * rs, v1 = acc[ai][bj][m][1] * rs;
                    u32x4 w; w.x = cvt_pk_bf16(v0[0], v0[1]); w.y = cvt_pk_bf16(v0[2], v0[3]); w.z = cvt_pk_bf16(v1[0], v1[1]); w.w = cvt_pk_bf16(v1[2], v1[3]);
                    *(u32x4*)(rowp + bj * HALF) = w;
                    if (bj == 0 && isdt) { *(f32x4*)(dtf + (size_t)row * 8) = v0; *(f32x4*)(dtf + (size_t)row * 8 + 4) = v1; } } }
    }
};
struct EpiRes {
    static constexpr bool PERM = false;
    const float* base; float* out;
    __device__ __forceinline__ void operator()(const f32x4 (&acc)[2][2][4][2], const Unit& u, int wr_, int wc_, int fr_, int fq_) const {
        const int ln_ = lane_id(), fr = ln_ & 15, fq = ln_ >> 4; (void)fr_; (void)fq_; const int wr = wr_, wc = wc_;
        const int row0 = u.pm * BM + wr * 64 + fr, col0 = u.pn * BM + wc * 32 + 4 * fq;
#pragma unroll
        for (int ai = 0; ai < 2; ++ai)
#pragma unroll
            for (int m = 0; m < 4; ++m) { const size_t off = (size_t)(row0 + ai * HALF + m * 16) * DM + col0;
#pragma unroll
                for (int bj = 0; bj < 2; ++bj)
#pragma unroll
                    for (int n = 0; n < 2; ++n) { const size_t ix = off + bj * HALF + n * 16; const f32x4 b = *(const f32x4*)(base + ix); *(f32x4*)(out + ix) = b + acc[ai][bj][m][n]; } }
    }
};
struct EpiGlu {
    static constexpr bool PERM = true;
    const bf16_t* yg; const bf16_t* proj; const float* bias; bf16_t* mix;
    __device__ __forceinline__ void operator()(const f32x4 (&acc)[2][2][4][2], const Unit& u, int wr_, int wc_, int fr_, int fq_) const {
        const int ln_ = lane_id(), fr = ln_ & 15, fq = ln_ >> 4; (void)fr_; (void)fq_; const int wr = wr_, wc = wc_;
        const int row0 = u.pm * BM + wr * 64 + fr, col0 = u.pn * BM + wc * 32 + 8 * fq;
#pragma unroll
        for (int ai = 0; ai < 2; ++ai)
#pragma unroll
            for (int m = 0; m < 4; ++m) { const int row = row0 + ai * HALF + m * 16;
#pragma unroll
                for (int bj = 0; bj < 2; ++bj) { const int col = col0 + bj * HALF;
                    const u32x4 yv = *(const u32x4*)(yg + (size_t)row * 512 + col), gv = *(const u32x4*)(proj + (size_t)row * NP + C_S5G + col);
                    const f32x4 b0 = *(const f32x4*)(bias + col), b1 = *(const f32x4*)(bias + col + 4);
                    float o[8];
#pragma unroll
                    for (int j = 0; j < 8; ++j) { const unsigned yw = yv[j >> 1], gw = gv[j >> 1];
                        const float y = (j & 1) ? __uint_as_float(yw & 0xffff0000u) : __uint_as_float(yw << 16);
                        const float gt = (j & 1) ? __uint_as_float(gw & 0xffff0000u) : __uint_as_float(gw << 16);
                        const float a = (j < 4 ? acc[ai][bj][m][0][j & 3] : acc[ai][bj][m][1][j & 3]) + (j < 4 ? b0[j & 3] : b1[j & 3]);
                        o[j] = y * sigmoidf_(a) * siluf_(gt); }
                    u32x4 w; w.x = cvt_pk_bf16(o[0], o[1]); w.y = cvt_pk_bf16(o[2], o[3]); w.z = cvt_pk_bf16(o[4], o[5]); w.w = cvt_pk_bf16(o[6], o[7]);
                    *(u32x4*)(mix + (size_t)row * DM + 512 + col) = w; } }
    }
};
}


__device__ __forceinline__ void wtrans_read(const float* s, int Nsrc, const float* sc, int mode, int n0, int k0, LAS float* tile, int t256) {
    const int n = t256 & 63; int sn = n0 + n; if (mode == 1) sn = win_src_col(sn);
#pragma unroll 4
    for (int i = 0; i < 16; ++i) { const int k = i * 4 + (t256 >> 6); float v = 0.f; if (sn >= 0) { v = s[(size_t)(k0 + k) * Nsrc + sn]; if (sc) v *= sc[k0 + k]; } tile[k * 65 + n] = v; }
}
__device__ __forceinline__ void wtrans_write(bf16_t* d, int K, int n0, int k0, const LAS float* tile, int t256) {
    const int k = t256 & 63;
#pragma unroll 4
    for (int i = 0; i < 16; ++i) { const int n = i * 4 + (t256 >> 6); d[(size_t)(n0 + n) * K + k0 + k] = (bf16_t)f2bf(tile[k * 65 + n]); }
}
__device__ __forceinline__ void s5prep_item(int i, const float* a_re, const float* a_im, const float* log_dt, const float* b_re, const float* b_im, float* abar, float* bbar, float* abar64) {
    const int lg = i / 64;
    const double are = a_re[i], aim = a_im[i], delta = exp((double)log_dt[lg]);
    const double mag = exp(are * delta), abr = mag * cos(aim * delta), abi = mag * sin(aim * delta), den = are * are + aim * aim;
    const double cr = ((abr - 1.0) * are + abi * aim) / den, ci = (abi * are - (abr - 1.0) * aim) / den;
    abar[2 * i] = (float)abr; abar[2 * i + 1] = (float)abi;
    { const double m64 = exp(64.0 * are * delta); abar64[2 * i] = (float)(m64 * cos(64.0 * aim * delta)); abar64[2 * i + 1] = (float)(m64 * sin(64.0 * aim * delta)); }
#pragma unroll
    for (int j = 0; j < 16; ++j) { const double br = b_re[(size_t)i * 16 + j], bi = b_im[(size_t)i * 16 + j];
        bbar[(size_t)i * 32 + j] = (float)(cr * br - ci * bi); bbar[(size_t)i * 32 + 16 + j] = (float)(cr * bi + ci * br); }
}
__device__ __forceinline__ void k_rowprep(const float* h, bf16_t* hb, float* rstd, int lane, int gw, int ngw) {
    for (int row = gw; row < TOK; row += ngw) {
        const f32x4* xr = (const f32x4*)(h + (size_t)row * DM) + lane; f32x4 v[8]; float s = 0.f;
#pragma unroll
        for (int j = 0; j < 8; ++j) { v[j] = xr[64 * j]; s += (v[j].x * v[j].x + v[j].y * v[j].y) + (v[j].z * v[j].z + v[j].w * v[j].w); }
        s = wave_sum(s);
        if (lane == 0) rstd[row] = 1.0f / sqrtf(s * (1.0f / DM) + EPS);
        u32x2* o = (u32x2*)(hb + (size_t)row * DM) + lane;
#pragma unroll
        for (int j = 0; j < 8; ++j) { u32x2 w; w.x = pk2(v[j].x, v[j].y); w.y = pk2(v[j].z, v[j].w); o[64 * j] = w; }
    }
}

struct LayerP {
    const float *conv_w, *conv_b, *dt_bias, *a_log, *ssd_d, *ssd_norm_w;
    const float *s5_c_re, *s5_c_im, *s5_d, *abar, *bbar;
    const float *gla_w2, *gla_gb, *gla_norm_w;
    const float *qh_w, *kh_w;
    const int* pos;
    const bf16_t* proj; const float* dtf;
    float *xbcc, *dtv, *ys, *hs, *eg, *og;
    bf16_t *yg, *mix, *qraw, *kvraw, *qf, *kf, *vf, *vt;
    bf16_t *xbcn, *xT, *hin; float *csv, *cse, *sst; unsigned* cnt_ssd;
    bf16_t *qt, *kt, *vT2, *gin; float *glb, *gst; unsigned* cnt_gla;
    const float* abar64; float *s5st, *s5in; unsigned* cnt_s5;
};
__device__ __forceinline__ void k_mla_fin(const LayerP& P, int lane, int gw, int ngw) {
    for (int tok = gw; tok < TOK; tok += ngw) {
        const int b = tok / SEQ, s = tok % SEQ; const bf16_t* pr = P.proj + (size_t)tok * NP;
        float sq = 0.f;
#pragma unroll
        for (int j = 0; j < 6; ++j) { const float v = bf2f(pr[C_CQ + lane + 64 * j]); sq += v * v; }
        float sk = 0.f;
#pragma unroll
        for (int j = 0; j < 2; ++j) { const float v = bf2f(pr[C_CKV + lane + 64 * j]); sk += v * v; }
        const float rq = 1.0f / sqrtf(wave_sum(sq) * (1.0f / 384.f) + EPS), rk = 1.0f / sqrtf(wave_sum(sk) * (1.0f / 128.f) + EPS);
        const int i = lane & 31;
        const float inv_freq = powf(10000.0f, -(float)i / 32.0f), ang = (float)P.pos[tok] * inv_freq, cs = cosf(ang), sn = sinf(ang);
        const float kpe = bf2f(pr[C_KPE + lane]);
        for (int h = 0; h < 4; ++h) {
            const size_t ob = ((size_t)(b * 4 + h) * SEQ + s);
            {
                float q0 = bf2f(P.qraw[(size_t)tok * 768 + h * 192 + lane]) * rq, q1 = bf2f(P.qraw[(size_t)tok * 768 + h * 192 + 64 + lane]) * rq, q2 = bf2f(P.qraw[(size_t)tok * 768 + h * 192 + 128 + lane]) * rq;
                const float r = 1.0f / sqrtf(wave_sum(q0 * q0 + q1 * q1 + q2 * q2) * (1.0f / 192.f) + EPS);
                q0 *= r * P.qh_w[lane]; q1 *= r * P.qh_w[64 + lane]; q2 *= r * P.qh_w[128 + lane];
                const float oth = xor32_other(q2, lane);
                const float rot = (lane < 32) ? (q2 * cs - oth * sn) : (q2 * cs + oth * sn);
                bf16_t* o = P.qf + ob * 192; o[lane] = (bf16_t)f2bf(q0); o[64 + lane] = (bf16_t)f2bf(q1); o[128 + lane] = (bf16_t)f2bf(rot);
            }
            {
                float k0 = bf2f(P.kvraw[(size_t)tok * 1024 + h * 256 + lane]) * rk, k1 = bf2f(P.kvraw[(size_t)tok * 1024 + h * 256 + 64 + lane]) * rk, k2 = kpe;
                const float r = 1.0f / sqrtf(wave_sum(k0 * k0 + k1 * k1 + k2 * k2) * (1.0f / 192.f) + EPS);
                k0 *= r * P.kh_w[lane]; k1 *= r * P.kh_w[64 + lane]; k2 *= r * P.kh_w[128 + lane];
                const float oth = xor32_other(k2, lane);
                const float rot = (lane < 32) ? (k2 * cs - oth * sn) : (k2 * cs + oth * sn);
                bf16_t* o = P.kf + ob * 192; o[lane] = (bf16_t)f2bf(k0); o[64 + lane] = (bf16_t)f2bf(k1); o[128 + lane] = (bf16_t)f2bf(rot);
                bf16_t* vo = P.vt + (size_t)(b * 4 + h) * 128 * SEQ + s;
                vo[(size_t)lane * SEQ] = (bf16_t)f2bf(bf2f(P.kvraw[(size_t)tok * 1024 + h * 256 + 128 + lane]) * rk); vo[(size_t)(64 + lane) * SEQ] = (bf16_t)f2bf(bf2f(P.kvraw[(size_t)tok * 1024 + h * 256 + 192 + lane]) * rk);
            }
        }
    }
}

constexpr int SA_XT = 0, SA_BT = 8 * 64 * 72 * 2, SA_AA = SA_BT + 2 * 64 * 72 * 2, SA_WW = SA_AA + 2048, SA_FLAG = SA_WW + 2048;
__device__ __forceinline__ bf16x8 scale_frag(bf16x8 v, const float (&w)[8]) {
    bf16x8 o;
#pragma unroll
    for (int j = 0; j < 8; j += 2) { const unsigned pk = pk2(bf2f((bf16_t)v[j]) * w[j], bf2f((bf16_t)v[j + 1]) * w[j + 1]); o[j] = (short)(pk & 0xffffu); o[j + 1] = (short)(pk >> 16); }
    return o;
}
__device__ __forceinline__ void ssd_passA(const LayerP& P, LAS unsigned char* lds, int item, int wave, int lane, bool arrive = true) {
    const int b = item >> 5, c = item & 31, tid = wave * 64 + lane, s0 = c * 64; const size_t tok0 = (size_t)b * SEQ + s0;
    LAS bf16_t* XT = (LAS bf16_t*)(lds + SA_XT); LAS bf16_t* BT = (LAS bf16_t*)(lds + SA_BT); LAS float* AA = (LAS float*)(lds + SA_AA); LAS float* WW = (LAS float*)(lds + SA_WW);
    volatile LAS unsigned* FLG = (volatile LAS unsigned*)(lds + SA_FLAG);
#pragma unroll 1
    for (int k = 0; k < 3; ++k) {
        const int u = tid + 512 * k, ch = u % 768, half = u / 768, t0 = half * 32;
        const float w0 = P.conv_w[ch], w1 = P.conv_w[768 + ch], w2 = P.conv_w[1536 + ch], w3 = P.conv_w[2304 + ch], bb = P.conv_b[ch];
        const bf16_t* src = P.proj + (tok0 + t0) * NP + C_XBC + ch;
        float x0 = 0.f, x1 = 0.f, x2 = 0.f;
        if (s0 + t0 > 0) { x0 = bf2f(*(src - 3 * NP)); x1 = bf2f(*(src - 2 * NP)); x2 = bf2f(*(src - NP)); }
#pragma unroll 8
        for (int t = 0; t < 32; ++t) {
            const float x3 = bf2f(src[(size_t)t * NP]);
            const bf16_t vb = (bf16_t)f2bf(siluf_(bb + w0 * x0 + w1 * x1 + w2 * x2 + w3 * x3));
            P.xbcn[(tok0 + t0 + t) * 768 + ch] = vb;
            if (ch < 512) XT[ch * 72 + t0 + t] = vb;
            else if (ch < 640) BT[(ch - 512) * 72 + t0 + t] = vb;
            x0 = x1; x1 = x2; x2 = x3;
        }
    }
    {
        const int h = wave; const float A = -expf(P.a_log[h]);
        const float dt = softplusf_(P.dtf[(tok0 + lane) * 8 + h] + P.dt_bias[h]);
        AA[h * 64 + lane] = dt * A;
        asm volatile("s_waitcnt lgkmcnt(0)" ::: "memory");
        float cs = 0.f;
        for (int s = 0; s < 64; ++s) { const float av = AA[h * 64 + s]; cs += (s <= lane) ? av : 0.f; }
        const float cend = __int_as_float(__builtin_amdgcn_readlane(__float_as_int(cs), 63));
        P.dtv[(tok0 + lane) * 8 + h] = dt; P.csv[(tok0 + lane) * 8 + h] = cs;
        WW[h * 64 + lane] = expf(cend - cs) * dt;
        if (lane == 63) P.cse[(size_t)(b * 32 + c) * 8 + h] = cs;
    }
    __syncthreads();
#pragma unroll
    for (int k = 0; k < 8; ++k) { const int ci = tid + 512 * k, row = ci >> 3, cc = ci & 7;
        const u32x4 v = *(const LAS u32x4*)(XT + row * 72 + cc * 8);
        *(u32x4*)(P.xT + ((size_t)(b * 8 + (row >> 6)) * 64 + (row & 63)) * SEQ + s0 + cc * 8) = v; }
    {
        const int h = wave, g = h >> 2, fr = lane & 15, fq = lane >> 4;
        f32x4 acc[4][4];
#pragma unroll
        for (int i = 0; i < 4; ++i)
#pragma unroll
            for (int j = 0; j < 4; ++j) acc[i][j] = (f32x4){0.f, 0.f, 0.f, 0.f};
#pragma unroll
        for (int ks = 0; ks < 2; ++ks) {
            float wv[8];
#pragma unroll
            for (int j = 0; j < 8; ++j) wv[j] = WW[h * 64 + ks * 32 + fq * 8 + j];
            bf16x8 bfr[4];
#pragma unroll
            for (int nt = 0; nt < 4; ++nt) bfr[nt] = *(const LAS bf16x8*)(BT + (g * 64 + nt * 16 + fr) * 72 + ks * 32 + fq * 8);
#pragma unroll
            for (int pt = 0; pt < 4; ++pt) { const bf16x8 af = scale_frag(*(const LAS bf16x8*)(XT + (h * 64 + pt * 16 + fr) * 72 + ks * 32 + fq * 8), wv);
#pragma unroll
                for (int nt = 0; nt < 4; ++nt) acc[pt][nt] = __builtin_amdgcn_mfma_f32_16x16x32_bf16(af, bfr[nt], acc[pt][nt], 0, 0, 0); }
        }
        float* so = P.sst + ((size_t)(b * 32 + c) * 8 + h) * 4096;
#pragma unroll
        for (int pt = 0; pt < 4; ++pt)
#pragma unroll
            for (int nt = 0; nt < 4; ++nt)
#pragma unroll
                for (int r = 0; r < 4; ++r) so[(pt * 16 + fq * 4 + r) * 64 + nt * 16 + fr] = acc[pt][nt][r];
    }
    asm volatile("s_waitcnt vmcnt(0)" ::: "memory");
    __syncthreads();
    if (!arrive) return;
    if (tid == 0) {
        __builtin_amdgcn_fence(__ATOMIC_RELEASE, "agent");
        asm volatile("s_waitcnt vmcnt(0)" ::: "memory");
        const unsigned old = __hip_atomic_fetch_add(P.cnt_ssd + 64 * b, 1u, __ATOMIC_RELAXED, __HIP_MEMORY_SCOPE_AGENT);
        if (old == 31u) { __builtin_amdgcn_fence(__ATOMIC_ACQUIRE, "agent"); asm volatile("s_waitcnt vmcnt(0)" ::: "memory"); }
        FLG[0] = (old == 31u) ? 1u : 0u;
    }
    __syncthreads();
    if (FLG[0] != 0u) {
        const int h = wave;
        f32x4 H[16];
#pragma unroll
        for (int k = 0; k < 16; ++k) H[k] = (f32x4){0.f, 0.f, 0.f, 0.f};
#pragma unroll 1
        for (int c2 = 0; c2 < 32; ++c2) {
            const size_t base = ((size_t)(b * 32 + c2) * 8 + h) * 4096;
            const float dec = expf(P.cse[(size_t)(b * 32 + c2) * 8 + h]);
#pragma unroll
            for (int k = 0; k < 16; ++k) {
                u32x2 w; w.x = pk2(H[k].x, H[k].y); w.y = pk2(H[k].z, H[k].w);
                *(u32x2*)(P.hin + base + k * 256 + lane * 4) = w;
                const f32x4 S = *(const f32x4*)(P.sst + base + k * 256 + lane * 4);
                H[k] = H[k] * dec + S;
            }
        }
    }
    __syncthreads();
}
constexpr int SB_M = 0, SB_RS = 8 * 64 * 72 * 2;
__device__ __forceinline__ void ssd_passB(const LayerP& P, LAS unsigned char* lds, int item, int wave, int lane) {
    const int b = item >> 5, c = item & 31, s0 = c * 64, h = wave, g = h >> 2, fr = lane & 15, fq = lane >> 4; const size_t tok0 = (size_t)b * SEQ + s0;
    LAS bf16_t* Mw = (LAS bf16_t*)(lds + SB_M) + wave * 64 * 72; LAS float* RS = (LAS float*)(lds + SB_RS);
    bf16x8 cfr[4][2], bfr[4][2];
#pragma unroll
    for (int t = 0; t < 4; ++t)
#pragma unroll
        for (int ks = 0; ks < 2; ++ks) {
            cfr[t][ks] = *(const bf16x8*)(P.xbcn + (tok0 + t * 16 + fr) * 768 + 640 + g * 64 + ks * 32 + fq * 8);
            bfr[t][ks] = *(const bf16x8*)(P.xbcn + (tok0 + t * 16 + fr) * 768 + 512 + g * 64 + ks * 32 + fq * 8); }
    float cst[4][4], css[4], dts[4];
#pragma unroll
    for (int tt = 0; tt < 4; ++tt)
#pragma unroll
        for (int r = 0; r < 4; ++r) cst[tt][r] = P.csv[(tok0 + tt * 16 + fq * 4 + r) * 8 + h];
#pragma unroll
    for (int st = 0; st < 4; ++st) { css[st] = P.csv[(tok0 + st * 16 + fr) * 8 + h]; dts[st] = P.dtv[(tok0 + st * 16 + fr) * 8 + h]; }
#pragma unroll
    for (int tt = 0; tt < 4; ++tt)
#pragma unroll
        for (int st = 0; st < 4; ++st) {
            f32x4 G = (f32x4){0.f, 0.f, 0.f, 0.f};
            if (st <= tt) {
#pragma unroll
                for (int ks = 0; ks < 2; ++ks) G = __builtin_amdgcn_mfma_f32_16x16x32_bf16(cfr[tt][ks], bfr[st][ks], G, 0, 0, 0);
            }
#pragma unroll
            for (int r = 0; r < 4; ++r) { const int t = tt * 16 + fq * 4 + r, s = st * 16 + fr;
                const float v = (st <= tt && s <= t) ? G[r] * expf(cst[tt][r] - css[st]) * dts[st] : 0.f;
                Mw[t * 72 + s] = (bf16_t)f2bf(v); }
        }
    f32x4 Y[4][4];
    {
        const bf16_t* hb = P.hin + ((size_t)(b * 32 + c) * 8 + h) * 4096;
        bf16x8 hfr[4][2];
#pragma unroll
        for (int pt = 0; pt < 4; ++pt)
#pragma unroll
            for (int ks = 0; ks < 2; ++ks) hfr[pt][ks] = *(const bf16x8*)(hb + (pt * 16 + fr) * 64 + ks * 32 + fq * 8);
#pragma unroll
        for (int tt = 0; tt < 4; ++tt)
#pragma unroll
            for (int pt = 0; pt < 4; ++pt) { f32x4 a = (f32x4){0.f, 0.f, 0.f, 0.f};
#pragma unroll
                for (int ks = 0; ks < 2; ++ks) a = __builtin_amdgcn_mfma_f32_16x16x32_bf16(cfr[tt][ks], hfr[pt][ks], a, 0, 0, 0);
#pragma unroll
                for (int r = 0; r < 4; ++r) a[r] *= expf(cst[tt][r]);
                Y[tt][pt] = a; }
    }
    {
        bf16x8 xfr[4][2];
#pragma unroll
        for (int pt = 0; pt < 4; ++pt)
#pragma unroll
            for (int ks = 0; ks < 2; ++ks) xfr[pt][ks] = *(const bf16x8*)(P.xT + ((size_t)(b * 8 + h) * 64 + pt * 16 + fr) * SEQ + s0 + ks * 32 + fq * 8);
        asm volatile("s_waitcnt lgkmcnt(0)" ::: "memory");
#pragma unroll
        for (int tt = 0; tt < 4; ++tt)
#pragma unroll
            for (int ks = 0; ks < 2; ++ks) { if (ks * 32 > tt * 16 + 15) continue;
                const bf16x8 af = *(const LAS bf16x8*)(Mw + (tt * 16 + fr) * 72 + ks * 32 + fq * 8);
#pragma unroll
                for (int pt = 0; pt < 4; ++pt) Y[tt][pt] = __builtin_amdgcn_mfma_f32_16x16x32_bf16(af, xfr[pt][ks], Y[tt][pt], 0, 0, 0); }
    }
    const float Dh = P.ssd_d[h];
    float rsq[4][4];
#pragma unroll
    for (int tt = 0; tt < 4; ++tt)
#pragma unroll
        for (int r = 0; r < 4; ++r) { const size_t tok = tok0 + tt * 16 + fq * 4 + r; float q = 0.f;
#pragma unroll
            for (int pt = 0; pt < 4; ++pt) { const int ch = h * 64 + pt * 16 + fr;
                const float x = bf2f(P.xbcn[tok * 768 + ch]), z = bf2f(P.proj[tok * NP + C_Z + ch]);
                const float v = (Y[tt][pt][r] + Dh * x) * siluf_(z); Y[tt][pt][r] = v; q += v * v; }
            rsq[tt][r] = xsum16(q); }
    if (fr == 0) {
#pragma unroll
        for (int tt = 0; tt < 4; ++tt)
#pragma unroll
            for (int r = 0; r < 4; ++r) RS[h * 64 + tt * 16 + fq * 4 + r] = rsq[tt][r];
    }
    __syncthreads();
#pragma unroll
    for (int tt = 0; tt < 4; ++tt)
#pragma unroll
        for (int r = 0; r < 4; ++r) { const int t = tt * 16 + fq * 4 + r; float tot = 0.f;
#pragma unroll
            for (int hh = 0; hh < 8; ++hh) tot += RS[hh * 64 + t];
            const float rn = 1.0f / sqrtf(tot * (1.0f / 512.f) + EPS); const size_t tok = tok0 + t;
#pragma unroll
            for (int pt = 0; pt < 4; ++pt) { const int ch = h * 64 + pt * 16 + fr; P.mix[tok * DM + ch] = (bf16_t)f2bf(Y[tt][pt][r] * rn * P.ssd_norm_w[ch]); } }
    __syncthreads();
}

constexpr int GA_KH = 0, GA_VT = 256 * 72 * 2, GA_HT = GA_VT + 512 * 72 * 2, GA_FLAG = GA_HT + 2048;
__device__ __forceinline__ float logsig16(float x) { return (fminf(x, 0.f) - log1pf(expf(-fabsf(x)))) * (1.0f / 16.0f); }
__device__ __forceinline__ void gla_passA(const LayerP& P, LAS unsigned char* lds, int item, int wave, int lane, bool arrive = true) {
    const int b = item >> 5, c = item & 31, tid = wave * 64 + lane, s0 = c * 64; const size_t tok0 = (size_t)b * SEQ + s0;
    LAS bf16_t* KH = (LAS bf16_t*)(lds + GA_KH); LAS bf16_t* VT = (LAS bf16_t*)(lds + GA_VT); LAS float* HT = (LAS float*)(lds + GA_HT);
    volatile LAS unsigned* FLG = (volatile LAS unsigned*)(lds + GA_FLAG);
    const int j = tid & 255, half = tid >> 8;
    float w2[16];
#pragma unroll
    for (int r = 0; r < 16; ++r) w2[r] = P.gla_w2[r * 256 + j];
    const float gb = P.gla_gb[j];
    float run = 0.f;
#pragma unroll 4
    for (int i = 0; i < 32; ++i) { const size_t tok = tok0 + half * 32 + i; const u32x4 g0 = *(const u32x4*)(P.proj + tok * NP + C_GLR), g1 = *(const u32x4*)(P.proj + tok * NP + C_GLR + 8);
        float x = gb;
#pragma unroll
        for (int r = 0; r < 8; ++r) { const unsigned wlo = g0[r >> 1], whi = g1[r >> 1];
            x += ((r & 1) ? __uint_as_float(wlo & 0xffff0000u) : __uint_as_float(wlo << 16)) * w2[r] + ((r & 1) ? __uint_as_float(whi & 0xffff0000u) : __uint_as_float(whi << 16)) * w2[8 + r]; }
        run += logsig16(x); }
    HT[half * 256 + j] = run;
    {
        const bf16_t* vsrc = P.proj + tok0 * NP + C_GV + tid;
#pragma unroll 8
        for (int t = 0; t < 64; ++t) VT[tid * 72 + t] = vsrc[(size_t)t * NP];
    }
    __syncthreads();
    const float off = half ? HT[j] : 0.f, blast = HT[j] + HT[256 + j];
    if (half == 0) P.glb[(size_t)(b * 32 + c) * 256 + j] = blast;
    run = off;
#pragma unroll 4
    for (int i = 0; i < 32; ++i) { const int t = half * 32 + i; const size_t tok = tok0 + t; const u32x4 g0 = *(const u32x4*)(P.proj + tok * NP + C_GLR), g1 = *(const u32x4*)(P.proj + tok * NP + C_GLR + 8);
        float x = gb;
#pragma unroll
        for (int r = 0; r < 8; ++r) { const unsigned wlo = g0[r >> 1], whi = g1[r >> 1];
            x += ((r & 1) ? __uint_as_float(wlo & 0xffff0000u) : __uint_as_float(wlo << 16)) * w2[r] + ((r & 1) ? __uint_as_float(whi & 0xffff0000u) : __uint_as_float(whi << 16)) * w2[8 + r]; }
        run += logsig16(x);
        const float q = bf2f(P.proj[tok * NP + C_GQ + j]), k = bf2f(P.proj[tok * NP + C_GK + j]);
        P.qt[tok * 256 + j] = (bf16_t)f2bf(q * 0.125f * expf(run));
        P.kt[tok * 256 + j] = (bf16_t)f2bf(k * expf(-run));
        KH[j * 72 + t] = (bf16_t)f2bf(k * expf(blast - run)); }
    __syncthreads();
#pragma unroll
    for (int k = 0; k < 8; ++k) { const int ci = tid + 512 * k, row = ci >> 3, cc = ci & 7;
        const u32x4 v = *(const LAS u32x4*)(VT + row * 72 + cc * 8);
        *(u32x4*)(P.vT2 + ((size_t)(b * 4 + (row >> 7)) * 128 + (row & 127)) * SEQ + s0 + cc * 8) = v; }
    {
        const int h = wave >> 1, eh = wave & 1, fr = lane & 15, fq = lane >> 4;
        f32x4 acc[4][4];
#pragma unroll
        for (int i = 0; i < 4; ++i)
#pragma unroll
            for (int jj = 0; jj < 4; ++jj) acc[i][jj] = (f32x4){0.f, 0.f, 0.f, 0.f};
#pragma unroll
        for (int ks = 0; ks < 2; ++ks) {
            bf16x8 kf[4];
#pragma unroll
            for (int dt = 0; dt < 4; ++dt) kf[dt] = *(const LAS bf16x8*)(KH + (h * 64 + dt * 16 + fr) * 72 + ks * 32 + fq * 8);
#pragma unroll
            for (int et = 0; et < 4; ++et) { const bf16x8 vf = *(const LAS bf16x8*)(VT + (h * 128 + eh * 64 + et * 16 + fr) * 72 + ks * 32 + fq * 8);
#pragma unroll
                for (int dt = 0; dt < 4; ++dt) acc[et][dt] = __builtin_amdgcn_mfma_f32_16x16x32_bf16(vf, kf[dt], acc[et][dt], 0, 0, 0); }
        }
        float* so = P.gst + ((size_t)(b * 32 + c) * 4 + h) * 8192 + eh * 4096;
#pragma unroll
        for (int et = 0; et < 4; ++et)
#pragma unroll
            for (int dt = 0; dt < 4; ++dt)
#pragma unroll
                for (int r = 0; r < 4; ++r) so[(et * 16 + fq * 4 + r) * 64 + dt * 16 + fr] = acc[et][dt][r];
    }
    asm volatile("s_waitcnt vmcnt(0)" ::: "memory");
    __syncthreads();
    if (!arrive) return;
    if (tid == 0) {
        __builtin_amdgcn_fence(__ATOMIC_RELEASE, "agent");
        asm volatile("s_waitcnt vmcnt(0)" ::: "memory");
        const unsigned old = __hip_atomic_fetch_add(P.cnt_gla + 64 * b, 1u, __ATOMIC_RELAXED, __HIP_MEMORY_SCOPE_AGENT);
        if (old == 31u) { __builtin_amdgcn_fence(__ATOMIC_ACQUIRE, "agent"); asm volatile("s_waitcnt vmcnt(0)" ::: "memory"); }
        FLG[0] = (old == 31u) ? 1u : 0u;
    }
    __syncthreads();
    if (FLG[0] != 0u) {
        const int h = wave >> 1, eh = wave & 1;
        f32x4 H[16];
#pragma unroll
        for (int k = 0; k < 16; ++k) H[k] = (f32x4){0.f, 0.f, 0.f, 0.f};
#pragma unroll 1
        for (int c2 = 0; c2 < 32; ++c2) {
            const size_t base = ((size_t)(b * 32 + c2) * 4 + h) * 8192 + eh * 4096;
            const f32x4 bl = *(const f32x4*)(P.glb + (size_t)(b * 32 + c2) * 256 + h * 64 + (lane & 15) * 4);
            const f32x4 dec = (f32x4){expf(bl.x), expf(bl.y), expf(bl.z), expf(bl.w)};
#pragma unroll
            for (int k = 0; k < 16; ++k) {
                u32x2 w; w.x = pk2(H[k].x, H[k].y); w.y = pk2(H[k].z, H[k].w);
                *(u32x2*)(P.gin + base + k * 256 + lane * 4) = w;
                const f32x4 S = *(const f32x4*)(P.gst + base + k * 256 + lane * 4);
                H[k] = H[k] * dec + S;
            }
        }
    }
    __syncthreads();
}
__device__ __forceinline__ void gla_passB(const LayerP& P, LAS unsigned char* lds, int item, int wave, int lane) {
    const int b = item >> 5, c = item & 31, s0 = c * 64, h = wave >> 1, half = wave & 1, fr = lane & 15, fq = lane >> 4; const size_t tok0 = (size_t)b * SEQ + s0;
    LAS bf16_t* Pw = (LAS bf16_t*)lds + wave * 32 * 72;
    bf16x8 qfr[2][2];
#pragma unroll
    for (int tt = 0; tt < 2; ++tt)
#pragma unroll
        for (int ks = 0; ks < 2; ++ks) qfr[tt][ks] = *(const bf16x8*)(P.qt + (tok0 + (half * 2 + tt) * 16 + fr) * 256 + h * 64 + ks * 32 + fq * 8);
    {
        bf16x8 kfr[4][2];
#pragma unroll
        for (int st = 0; st < 4; ++st)
#pragma unroll
            for (int ks = 0; ks < 2; ++ks) kfr[st][ks] = *(const bf16x8*)(P.kt + (tok0 + st * 16 + fr) * 256 + h * 64 + ks * 32 + fq * 8);
#pragma unroll
        for (int tt = 0; tt < 2; ++tt)
#pragma unroll
            for (int st = 0; st < 4; ++st) { const int tg = half * 2 + tt;
                f32x4 G = (f32x4){0.f, 0.f, 0.f, 0.f};
                if (st <= tg) {
#pragma unroll
                    for (int ks = 0; ks < 2; ++ks) G = __builtin_amdgcn_mfma_f32_16x16x32_bf16(qfr[tt][ks], kfr[st][ks], G, 0, 0, 0);
                }
#pragma unroll
                for (int r = 0; r < 4; ++r) { const float v = (st < tg || (st == tg && fr <= fq * 4 + r)) ? G[r] : 0.f;
                    Pw[(tt * 16 + fq * 4 + r) * 72 + st * 16 + fr] = (bf16_t)f2bf(v); } }
    }
    f32x4 O[2][8];
    {
        const bf16_t* gb = P.gin + ((size_t)(b * 32 + c) * 4 + h) * 8192;
#pragma unroll
        for (int et = 0; et < 8; ++et) { const bf16x8 g0 = *(const bf16x8*)(gb + (et * 16 + fr) * 64 + fq * 8), g1 = *(const bf16x8*)(gb + (et * 16 + fr) * 64 + 32 + fq * 8);
#pragma unroll
            for (int tt = 0; tt < 2; ++tt) { f32x4 a = (f32x4){0.f, 0.f, 0.f, 0.f};
                a = __builtin_amdgcn_mfma_f32_16x16x32_bf16(qfr[tt][0], g0, a, 0, 0, 0); a = __builtin_amdgcn_mfma_f32_16x16x32_bf16(qfr[tt][1], g1, a, 0, 0, 0); O[tt][et] = a; } }
    }
    asm volatile("s_waitcnt lgkmcnt(0)" ::: "memory");
#pragma unroll
    for (int ks = 0; ks < 2; ++ks) { if (ks * 32 > (half * 2 + 1) * 16 + 15) continue;
        bf16x8 pf[2];
#pragma unroll
        for (int tt = 0; tt < 2; ++tt) pf[tt] = *(const LAS bf16x8*)(Pw + (tt * 16 + fr) * 72 + ks * 32 + fq * 8);
#pragma unroll
        for (int et = 0; et < 8; ++et) { const bf16x8 vf = *(const bf16x8*)(P.vT2 + ((size_t)(b * 4 + h) * 128 + et * 16 + fr) * SEQ + s0 + ks * 32 + fq * 8);
#pragma unroll
            for (int tt = 0; tt < 2; ++tt) O[tt][et] = __builtin_amdgcn_mfma_f32_16x16x32_bf16(pf[tt], vf, O[tt][et], 0, 0, 0); } }
#pragma unroll
    for (int tt = 0; tt < 2; ++tt)
#pragma unroll
        for (int r = 0; r < 4; ++r) { float q = 0.f;
#pragma unroll
            for (int et = 0; et < 8; ++et) q += O[tt][et][r] * O[tt][et][r];
            q = xsum16(q); const float rn = 1.0f / sqrtf(q * (1.0f / 128.f) + EPS);
            const size_t tok = tok0 + (half * 2 + tt) * 16 + fq * 4 + r;
#pragma unroll
            for (int et = 0; et < 8; ++et) { const int e = et * 16 + fr; const float g = bf2f(P.proj[tok * NP + C_GG + h * 128 + e]);
                P.mix[tok * DM + 1024 + h * 128 + e] = (bf16_t)f2bf(O[tt][et][r] * rn * P.gla_norm_w[e] * siluf_(g)); } }
    __syncthreads();
}

constexpr int S5W_BYTES = 16 * 132 * 4 + 16 * 136 * 2, S5_FLAG = 8 * S5W_BYTES;
struct S5Coef { bf16x8 bb[8]; float ar, ai; };
__device__ __forceinline__ void s5_load_coef(const LayerP& P, int g, int lane, S5Coef& C) {
    const int fr = lane & 15, fq = lane >> 4;
    C.ar = P.abar[(g * 64 + lane) * 2]; C.ai = P.abar[(g * 64 + lane) * 2 + 1];
#pragma unroll
    for (int nt = 0; nt < 8; ++nt) {
        bf16x8 v = (bf16x8){0, 0, 0, 0, 0, 0, 0, 0};
        if (fq < 2) { const float* bp = P.bbar + (size_t)(g * 64 + (nt & 3) * 16 + fr) * 32 + (nt >> 2) * 16 + fq * 8; const f32x4 c0 = *(const f32x4*)bp, c1 = *(const f32x4*)(bp + 4);
            const unsigned p0 = pk2(c0.x, c0.y), p1 = pk2(c0.z, c0.w), p2 = pk2(c1.x, c1.y), p3 = pk2(c1.z, c1.w);
            v = (bf16x8){(short)(p0 & 0xffff), (short)(p0 >> 16), (short)(p1 & 0xffff), (short)(p1 >> 16), (short)(p2 & 0xffff), (short)(p2 >> 16), (short)(p3 & 0xffff), (short)(p3 >> 16)}; }
        C.bb[nt] = v; }
}
__device__ __forceinline__ void s5_bu16(const LayerP& P, const S5Coef& C, size_t tok, int g, int lane, LAS float* BU) {
    const int fr = lane & 15, fq = lane >> 4;
    bf16x8 ua = (bf16x8){0, 0, 0, 0, 0, 0, 0, 0};
    if (fq < 2) ua = *(const bf16x8*)(P.proj + (tok + fr) * NP + C_S5U + g * 16 + fq * 8);
#pragma unroll
    for (int nt = 0; nt < 8; ++nt) { const f32x4 a = __builtin_amdgcn_mfma_f32_16x16x32_bf16(ua, C.bb[nt], (f32x4){0.f, 0.f, 0.f, 0.f}, 0, 0, 0);
#pragma unroll
        for (int r = 0; r < 4; ++r) BU[(fq * 4 + r) * 132 + nt * 16 + fr] = a[r]; }
    asm volatile("s_waitcnt lgkmcnt(0)" ::: "memory");
}
__device__ __forceinline__ void s5_passA(const LayerP& P, LAS unsigned char* lds, int item, int wave, int lane, bool arrive = true) {
    const int b = item >> 5, c = item & 31, tid = wave * 64 + lane; const size_t tok0 = (size_t)b * SEQ + c * 64;
    volatile LAS unsigned* FLG = (volatile LAS unsigned*)(lds + S5_FLAG);
    LAS float* BU = (LAS float*)(lds + wave * S5W_BYTES);
#pragma unroll 1
    for (int gi = 0; gi < 4; ++gi) {
        const int g = wave * 4 + gi;
        S5Coef C; s5_load_coef(P, g, lane, C);
        float hr = 0.f, hi = 0.f;
#pragma unroll 1
        for (int sb = 0; sb < 4; ++sb) {
            s5_bu16(P, C, tok0 + sb * 16, g, lane, BU);
            float ur[16], ui[16];
#pragma unroll
            for (int t = 0; t < 16; ++t) { ur[t] = BU[t * 132 + lane]; ui[t] = BU[t * 132 + 64 + lane]; }
#pragma unroll
            for (int t = 0; t < 16; ++t) { const float nr = C.ar * hr - C.ai * hi + ur[t], ni = C.ar * hi + C.ai * hr + ui[t]; hr = nr; hi = ni; }
            asm volatile("s_waitcnt lgkmcnt(0)" ::: "memory");
        }
        float* so = P.s5st + ((size_t)(b * 32 + c) * 32 + g) * 128; so[lane] = hr; so[64 + lane] = hi;
    }
    asm volatile("s_waitcnt vmcnt(0)" ::: "memory");
    __syncthreads();
    if (!arrive) return;
    if (tid == 0) {
        __builtin_amdgcn_fence(__ATOMIC_RELEASE, "agent");
        asm volatile("s_waitcnt vmcnt(0)" ::: "memory");
        const unsigned old = __hip_atomic_fetch_add(P.cnt_s5 + 64 * b, 1u, __ATOMIC_RELAXED, __HIP_MEMORY_SCOPE_AGENT);
        if (old == 31u) { __builtin_amdgcn_fence(__ATOMIC_ACQUIRE, "agent"); asm volatile("s_waitcnt vmcnt(0)" ::: "memory"); }
        FLG[0] = (old == 31u) ? 1u : 0u;
    }
    __syncthreads();
    if (FLG[0] != 0u) {
#pragma unroll 1
        for (int k = 0; k < 4; ++k) { const int gn = tid + 512 * k, g = gn >> 6, n = gn & 63;
            const float a64r = P.abar64[gn * 2], a64i = P.abar64[gn * 2 + 1];
            float hr = 0.f, hi = 0.f;
            for (int c2 = 0; c2 < 32; ++c2) { const size_t o = ((size_t)(b * 32 + c2) * 32 + g) * 128 + n;
                P.s5in[o] = hr; P.s5in[o + 64] = hi;
                const float sr = P.s5st[o], si = P.s5st[o + 64];
                const float nr = a64r * hr - a64i * hi + sr, ni = a64r * hi + a64i * hr + si; hr = nr; hi = ni; } }
    }
    __syncthreads();
}
__device__ __forceinline__ void s5_passB(const LayerP& P, LAS unsigned char* lds, int item, int wave, int lane) {
    const int b = item >> 5, c = item & 31, fr = lane & 15, fq = lane >> 4; const size_t tok0 = (size_t)b * SEQ + c * 64;
    LAS float* BU = (LAS float*)(lds + wave * S5W_BYTES); LAS bf16_t* Hm = (LAS bf16_t*)(lds + wave * S5W_BYTES + 16 * 132 * 4);
#pragma unroll 1
    for (int gi = 0; gi < 4; ++gi) {
        const int g = wave * 4 + gi;
        S5Coef C; s5_load_coef(P, g, lane, C);
        bf16x8 cb[4];
#pragma unroll
        for (int ks = 0; ks < 4; ++ks) { const float* cp = ((ks < 2) ? P.s5_c_re : P.s5_c_im) + (size_t)(g * 16 + fr) * 64 + (ks & 1) * 32 + fq * 8; const float sg = (ks < 2) ? 1.f : -1.f;
            const f32x4 c0 = *(const f32x4*)cp, c1 = *(const f32x4*)(cp + 4);
            const unsigned p0 = pk2(sg * c0.x, sg * c0.y), p1 = pk2(sg * c0.z, sg * c0.w), p2 = pk2(sg * c1.x, sg * c1.y), p3 = pk2(sg * c1.z, sg * c1.w);
            cb[ks] = (bf16x8){(short)(p0 & 0xffff), (short)(p0 >> 16), (short)(p1 & 0xffff), (short)(p1 >> 16), (short)(p2 & 0xffff), (short)(p2 >> 16), (short)(p3 & 0xffff), (short)(p3 >> 16)}; }
        const size_t so = ((size_t)(b * 32 + c) * 32 + g) * 128;
        float hr = P.s5in[so + lane], hi = P.s5in[so + 64 + lane];
        const float dsk = P.s5_d[g * 16 + fr];
#pragma unroll 1
        for (int sb = 0; sb < 4; ++sb) {
            s5_bu16(P, C, tok0 + sb * 16, g, lane, BU);
            float ur[16], ui[16];
#pragma unroll
            for (int t = 0; t < 16; ++t) { ur[t] = BU[t * 132 + lane]; ui[t] = BU[t * 132 + 64 + lane]; }
#pragma unroll
            for (int t = 0; t < 16; ++t) { const float nr = C.ar * hr - C.ai * hi + ur[t], ni = C.ar * hi + C.ai * hr + ui[t]; hr = nr; hi = ni;
                Hm[t * 136 + lane] = (bf16_t)f2bf(hr); Hm[t * 136 + 64 + lane] = (bf16_t)f2bf(hi); }
            asm volatile("s_waitcnt lgkmcnt(0)" ::: "memory");
            f32x4 acc = (f32x4){0.f, 0.f, 0.f, 0.f};
#pragma unroll
            for (int ks = 0; ks < 4; ++ks) { const bf16x8 af = *(const LAS bf16x8*)(Hm + fr * 136 + ks * 32 + fq * 8);
                acc = __builtin_amdgcn_mfma_f32_16x16x32_bf16(af, cb[ks], acc, 0, 0, 0); }
#pragma unroll
            for (int r = 0; r < 4; ++r) { const size_t tok = tok0 + sb * 16 + fq * 4 + r;
                const float y = acc[r] + dsk * bf2f(P.proj[tok * NP + C_S5U + g * 16 + fr]);
                P.yg[tok * 512 + g * 16 + fr] = (bf16_t)f2bf(gelu_tanh(y)); }
            asm volatile("s_waitcnt lgkmcnt(0)" ::: "memory");
        }
    }
    __syncthreads();
}

constexpr int AT_KP = 200, AT_VP = 72, AT_PP = 72;
constexpr int AT_K_OFF = 0, AT_V_OFF = 64 * AT_KP * 2, AT_P_OFF = AT_V_OFF + 128 * AT_VP * 2, AT_LDS = AT_P_OFF + 8 * 16 * AT_PP * 2;
__device__ __forceinline__ void attn_unit(const LayerP& P, LAS unsigned char* lds, int unit, int wave, int lane) {
    const int bh = unit >> 4, p = unit & 15, grp = wave >> 2, wq = wave & 3, tid = wave * 64 + lane;
    const int qb = grp ? 31 - p : p, q0 = qb * 64 + wq * 16, ntiles = 32 - p;
    const int fr = lane & 15, fq = lane >> 4;
    const bf16_t* Q = P.qf + (size_t)bh * SEQ * 192; const bf16_t* K = P.kf + (size_t)bh * SEQ * 192; const bf16_t* VT = P.vt + (size_t)bh * 128 * SEQ;
    bf16x8 qa[6];
#pragma unroll
    for (int ks = 0; ks < 6; ++ks) qa[ks] = *(const bf16x8*)(Q + (size_t)(q0 + fr) * 192 + ks * 32 + fq * 8);
    f32x4 o[8];
#pragma unroll
    for (int e = 0; e < 8; ++e) o[e] = (f32x4){0.f, 0.f, 0.f, 0.f};
    float m[4], l[4];
#pragma unroll
    for (int r = 0; r < 4; ++r) { m[r] = -1e30f; l[r] = 0.f; }
    u32x4 kr[3], vr[2];
    int krow[3], kcol[3], vrow[2], vcol[2];
#pragma unroll
    for (int i = 0; i < 3; ++i) { const int c = tid + 512 * i; krow[i] = c / 24; kcol[i] = c % 24; }
#pragma unroll
    for (int i = 0; i < 2; ++i) { const int c = tid + 512 * i; vrow[i] = c >> 3; vcol[i] = c & 7; }
#pragma unroll
    for (int i = 0; i < 3; ++i) kr[i] = *(const u32x4*)(K + (size_t)krow[i] * 192 + kcol[i] * 8);
#pragma unroll
    for (int i = 0; i < 2; ++i) vr[i] = *(const u32x4*)(VT + (size_t)vrow[i] * SEQ + vcol[i] * 8);
    LAS unsigned char* Ks = lds + AT_K_OFF; LAS unsigned char* Vs = lds + AT_V_OFF; LAS unsigned char* Ps = lds + AT_P_OFF + wave * (16 * AT_PP * 2);
    const float SCL = 0.07216878364870322f * 1.4426950408889634f;
    for (int j = 0; j < ntiles; ++j) {
        __syncthreads();
#pragma unroll
        for (int i = 0; i < 3; ++i) *(LAS u32x4*)(Ks + (krow[i] * AT_KP + kcol[i] * 8) * 2) = kr[i];
#pragma unroll
        for (int i = 0; i < 2; ++i) *(LAS u32x4*)(Vs + (vrow[i] * AT_VP + vcol[i] * 8) * 2) = vr[i];
        __syncthreads();
        if (j + 1 < ntiles) {
#pragma unroll
            for (int i = 0; i < 3; ++i) kr[i] = *(const u32x4*)(K + (size_t)((j + 1) * 64 + krow[i]) * 192 + kcol[i] * 8);
#pragma unroll
            for (int i = 0; i < 2; ++i) vr[i] = *(const u32x4*)(VT + (size_t)vrow[i] * SEQ + (j + 1) * 64 + vcol[i] * 8);
        }
        if (j <= qb) {
            f32x4 s[4];
#pragma unroll
            for (int nt = 0; nt < 4; ++nt) { s[nt] = (f32x4){0.f, 0.f, 0.f, 0.f};
#pragma unroll
                for (int ks = 0; ks < 6; ++ks) { const bf16x8 kb = *(const LAS bf16x8*)(Ks + ((nt * 16 + fr) * AT_KP + ks * 32 + fq * 8) * 2);
                    s[nt] = __builtin_amdgcn_mfma_f32_16x16x32_bf16(qa[ks], kb, s[nt], 0, 0, 0); } }
            const bool diag = (j == qb);
            float alpha[4];
#pragma unroll
            for (int r = 0; r < 4; ++r) {
                const int rowl = wq * 16 + fq * 4 + r;
                float mx = -1e30f;
#pragma unroll
                for (int nt = 0; nt < 4; ++nt) { float v = s[nt][r] * SCL; if (diag && (nt * 16 + fr) > rowl) v = -1e30f; s[nt][r] = v; mx = fmaxf(mx, v); }
                mx = xmax16(mx);
                const float mn = fmaxf(m[r], mx); alpha[r] = exp2f(m[r] - mn); m[r] = mn;
                float rs = 0.f;
#pragma unroll
                for (int nt = 0; nt < 4; ++nt) { const float pv = exp2f(s[nt][r] - mn); s[nt][r] = pv; rs += pv; }
                rs = xsum16(rs); l[r] = l[r] * alpha[r] + rs;
            }
#pragma unroll
            for (int e = 0; e < 8; ++e)
#pragma unroll
                for (int r = 0; r < 4; ++r) o[e][r] *= alpha[r];
#pragma unroll
            for (int nt = 0; nt < 4; ++nt)
#pragma unroll
                for (int r = 0; r < 4; ++r) *(LAS bf16_t*)(Ps + ((fq * 4 + r) * AT_PP + nt * 16 + fr) * 2) = (bf16_t)f2bf(s[nt][r]);
            asm volatile("s_waitcnt lgkmcnt(0)" ::: "memory");
#pragma unroll
            for (int ks = 0; ks < 2; ++ks) { const bf16x8 pa = *(const LAS bf16x8*)(Ps + (fr * AT_PP + ks * 32 + fq * 8) * 2);
#pragma unroll
                for (int e = 0; e < 8; ++e) { const bf16x8 vb = *(const LAS bf16x8*)(Vs + ((e * 16 + fr) * AT_VP + ks * 32 + fq * 8) * 2);
                    o[e] = __builtin_amdgcn_mfma_f32_16x16x32_bf16(pa, vb, o[e], 0, 0, 0); } }
        }
    }
    const int b = bh >> 2, h = bh & 3;
#pragma unroll
    for (int r = 0; r < 4; ++r) { const size_t tok = (size_t)b * SEQ + q0 + fq * 4 + r; const float il = 1.0f / l[r];
#pragma unroll
        for (int e = 0; e < 8; ++e) { const int col = h * 128 + e * 16 + fr; const float g = bf2f(P.proj[tok * NP + C_MG + col]);
            P.mix[tok * DM + 1536 + col] = (bf16_t)f2bf(o[e][r] * il * siluf_(g)); } }
    __syncthreads();
}


#define XB_TMO      128
#define XB_XCNT(j)  (256  + 64 * (j))
#define XB_XSUB(j)  (1280 + 64 * (j))
#define XB_XGEN(j)  (2304 + 64 * (j))
#define XB_TOP      3328
#define XB_TOPGEN   3392
#define XCD_BAR_WORDS 3456
#define XB_SPIN_CAP (1u << 18)
__device__ __forceinline__ unsigned xb_ld(unsigned* p)              { return __hip_atomic_load(p, __ATOMIC_RELAXED, __HIP_MEMORY_SCOPE_AGENT); }
__device__ __forceinline__ unsigned xb_add(unsigned* p, unsigned v) { return __hip_atomic_fetch_add(p, v, __ATOMIC_RELAXED, __HIP_MEMORY_SCOPE_AGENT); }
__device__ __forceinline__ unsigned xb_xcc_id() { return (unsigned)__builtin_amdgcn_s_getreg((3 << 11) | 20) & 0xFu; }
#define XB_SPIN(cond, bar) do { unsigned _sp = 0; while (cond) { __builtin_amdgcn_s_sleep(1); \
    if ((++_sp & 255u) == 0u) { if (xb_ld(&(bar)[XB_TMO])) break; if (_sp > XB_SPIN_CAP) { atomicAdd(&(bar)[XB_TMO], 1u); break; } } } } while (0)
struct XcdBarrier { unsigned* bar; unsigned x; volatile LAS unsigned* st; };
__device__ __forceinline__ XcdBarrier xcd_barrier_post(unsigned* bar, volatile LAS unsigned* st, bool leader) {
    XcdBarrier b; b.bar = bar; b.x = xb_xcc_id(); b.st = st;
    if (leader) (void)xb_add(&bar[XB_XCNT(b.x)], 1u);
    return b;
}
__device__ __forceinline__ void xcd_barrier_complete(unsigned* bar, unsigned x, unsigned& nloc, unsigned& nx) {
    const unsigned G = gridDim.x * gridDim.y * gridDim.z;
    unsigned sum, cnt, mine, sp = 0u;
    for (;;) {
        sum = 0u; cnt = 0u; mine = 0u;
#pragma unroll
        for (unsigned j = 0; j < 16; ++j) { const unsigned c = xb_ld(&bar[XB_XCNT(j)]); sum += c; cnt += (c > 0u) ? 1u : 0u; mine = (j == x) ? c : mine; }
        if (sum == G) break;
        __builtin_amdgcn_s_sleep(1);
        if ((++sp & 255u) == 0u) { if (xb_ld(&bar[XB_TMO])) break; if (sp > XB_SPIN_CAP) { atomicAdd(&bar[XB_TMO], 1u); break; } }
    }
    nloc = mine > 0u ? mine : 1u; nx = cnt > 0u ? cnt : 1u;
}
__device__ __forceinline__ void xcd_barrier(const XcdBarrier& b, bool leader) {
    asm volatile("s_waitcnt vmcnt(0)" ::: "memory");
    __syncthreads();
    if (leader) {
        unsigned* bar = b.bar;
        __builtin_amdgcn_s_waitcnt(0);
        unsigned nloc = b.st[0], nx = b.st[1];
        if (nloc == 0u) { xcd_barrier_complete(bar, b.x, nloc, nx); b.st[0] = nloc; b.st[1] = nx; }
        const unsigned old = xb_add(&bar[XB_XSUB(b.x)], 1u);
        const unsigned gen = old / nloc;
        if (old + 1u == (gen + 1u) * nloc) {
            __builtin_amdgcn_fence(__ATOMIC_RELEASE, "agent");
            asm volatile("s_waitcnt vmcnt(0)" ::: "memory");
            const unsigned og = xb_add(&bar[XB_TOP], 1u);
            const unsigned tg = og / nx;
            if (og + 1u == (tg + 1u) * nx) xb_add(&bar[XB_TOPGEN], 1u);
            else XB_SPIN(xb_ld(&bar[XB_TOPGEN]) == tg, bar);
            __builtin_amdgcn_fence(__ATOMIC_ACQUIRE, "agent");
            xb_add(&bar[XB_XGEN(b.x)], 1u);
            asm volatile("s_waitcnt vmcnt(0)" ::: "memory");
        } else {
            XB_SPIN(xb_ld(&bar[XB_XGEN(b.x)]) == gen, bar);
            __builtin_amdgcn_fence(__ATOMIC_ACQUIRE, "agent");
            asm volatile("s_waitcnt vmcnt(0)" ::: "memory");
        }
    }
    __syncthreads();
}

constexpr size_t MiB = 1u << 20;
constexpr size_t WS_CTL = 0, CTL_ZERO_BYTES = 65536;
constexpr size_t WS_WIN = 1 * MiB;
constexpr size_t WS_WOUT = WS_WIN + 80 * MiB;
constexpr size_t WS_WUQ = WS_WOUT + 32 * MiB;
constexpr size_t WS_WUKV = WS_WUQ + 3 * MiB;
constexpr size_t WS_WGLU = WS_WUKV + 1 * MiB;
constexpr size_t WS_ABAR = WS_WGLU + 2 * MiB;
constexpr size_t WS_BBAR = WS_ABAR + 1 * MiB;
constexpr size_t WS_HB = WS_BBAR + 2 * MiB;
constexpr size_t WS_RSTD = WS_HB + 32 * MiB;
constexpr size_t WS_PROJ = WS_RSTD + 1 * MiB;
constexpr size_t WS_DTF = WS_PROJ + 80 * MiB;
constexpr size_t WS_DTV = WS_DTF + 1 * MiB;
constexpr size_t WS_XBCC = WS_DTV + 1 * MiB;
constexpr size_t WS_YS = WS_XBCC + 24 * MiB;
constexpr size_t WS_MIX = WS_YS + 16 * MiB;
constexpr size_t WS_HS = WS_MIX + 32 * MiB;
constexpr size_t WS_YG = WS_HS + 128 * MiB;
constexpr size_t WS_EG = WS_YG + 8 * MiB;
constexpr size_t WS_OG = WS_EG + 8 * MiB;
constexpr size_t WS_QRAW = WS_OG + 16 * MiB;
constexpr size_t WS_KVRAW = WS_QRAW + 12 * MiB;
constexpr size_t WS_QF = WS_KVRAW + 16 * MiB;
constexpr size_t WS_KF = WS_QF + 12 * MiB;
constexpr size_t WS_VF = WS_KF + 12 * MiB;
constexpr size_t WS_SST = WS_VF + 8 * MiB;
constexpr size_t WS_HIN = WS_SST + 16 * MiB;
constexpr size_t WS_GST = WS_HIN + 8 * MiB;
constexpr size_t WS_GIN = WS_GST + 16 * MiB;
constexpr size_t WS_END = WS_GIN + 8 * MiB;
constexpr int CW_GLA = 10240, CW_S5 = 12288;
constexpr int CW_SSD = 8192;
constexpr int CW_BAR = 1024;

#ifndef REP_D1
#define REP_D1 1
#endif
#ifndef REP_D2
#define REP_D2 1
#endif
#ifndef REP_D3
#define REP_D3 1
#endif
#ifndef REP_D4
#define REP_D4 1
#endif
#ifndef REP_F
#define REP_F 1
#endif
#ifndef REP_P
#define REP_P 1
#endif
#ifndef REP_A
#define REP_A 1
#endif
#ifndef REP_B
#define REP_B 1
#endif
#ifndef REP_C
#define REP_C 1
#endif
#ifndef REP_D
#define REP_D 1
#endif
#ifndef REP_E
#define REP_E 1
#endif
#ifndef REP_BAR
#define REP_BAR 1
#endif
__device__ __forceinline__ void* uptr_(unsigned long long v) {
    const unsigned lo = __builtin_amdgcn_readfirstlane((unsigned)v), hi = __builtin_amdgcn_readfirstlane((unsigned)(v >> 32));
    return (void*)(((unsigned long long)hi << 32) | lo);
}
struct MegaArgs { const float* in[30]; float* out; unsigned char* ws; };
constexpr int LDS_TAB = pg8::STAGE_BYTES + 64, LDS_TOTAL = LDS_TAB + 256;

__global__ void __launch_bounds__(512, 2) mega_fwd(MegaArgs a) {
    __shared__ __attribute__((aligned(16))) unsigned char lds_raw[LDS_TOTAL];
    LAS unsigned char* lds = (LAS unsigned char*)lds_raw;
    const int wave_s = __builtin_amdgcn_readfirstlane((int)threadIdx.x >> 6);
    const int G = (int)gridDim.x, ngw = G * 8; const size_t gth = (size_t)G * 512;
#define IDS() int lane_ = lane_id(), wave_ = wave_s, bid_ = blockIdx.x; asm volatile("" : "+v"(lane_), "+s"(wave_), "+s"(bid_)); const int lane = lane_, wave = __builtin_amdgcn_readfirstlane(wave_), tid_ = wave * 64 + lane_, gw = __builtin_amdgcn_readfirstlane(bid_) * 8 + wave; (void)tid_; const size_t gtid = (size_t)bid_ * 512 + tid_; (void)lane; (void)gw; (void)gtid;
    volatile LAS unsigned* st = (volatile LAS unsigned*)(lds + pg8::STAGE_BYTES);
    { const int tid = wave_s * 64 + lane_id(); if (tid < 16) st[tid] = 0u; }
    __syncthreads();
    LAS unsigned long long* tab = (LAS unsigned long long*)(lds + LDS_TAB);
    { const int tid = wave_s * 64 + lane_id();
      if (tid < 30) tab[tid] = (unsigned long long)a.in[tid];
      if (tid == 30) tab[30] = (unsigned long long)a.out;
      if (tid == 31) tab[31] = (unsigned long long)a.ws; }
    __syncthreads();
#define TABP(i) ((const float*)uptr_(tab[i]))
#define WSP() ((unsigned char*)uptr_(tab[31]))
#define OUTP() ((float*)uptr_(tab[30]))
    (void)xcd_barrier_post((unsigned*)(WSP() + WS_CTL) + CW_BAR, st, wave_s == 0 && lane_id() == 0);
#define GRID_BAR() do { XcdBarrier b2_; b2_.bar = (unsigned*)(WSP() + WS_CTL) + CW_BAR; b2_.x = xb_xcc_id(); b2_.st = st; int w_ = wave_s; asm volatile("" : "+s"(w_)); xcd_barrier(b2_, (w_ * 64 + lane_id()) == 0); } while (0)
#define FIN(i) TABP(i)
    for (int rep = 0; rep < REP_P; ++rep) {
        unsigned char* ws = WSP();
        bf16_t* win = (bf16_t*)(ws + WS_WIN); bf16_t* wout = (bf16_t*)(ws + WS_WOUT); bf16_t* wuq = (bf16_t*)(ws + WS_WUQ); bf16_t* wukv = (bf16_t*)(ws + WS_WUKV); bf16_t* wglu = (bf16_t*)(ws + WS_WGLU);
        float* abar = (float*)(ws + WS_ABAR); float* bbar = (float*)(ws + WS_BBAR);
        constexpr int T0 = 80 * 32 * 4, T1 = 32 * 32 * 4, T2 = 12 * 6 * 4, T3 = 16 * 2 * 4, T4 = 8 * 8 * 4, TT = T0 + T1 + T2 + T3 + T4;
        IDS(); const int half = tid_ >> 8, t256 = tid_ & 255;
        LAS float* tile = (LAS float*)(lds + half * 16640);
        for (int it = (int)blockIdx.x; it * 2 < TT; it += G) {
            int r = it * 2 + half; const bool valid = r < TT;
            const float* s = nullptr; const float* sc = nullptr; bf16_t* d = nullptr; int K = 0, Nsrc = 0, Ndst = 0, mode = 0, tn = 1, tpl = 1;
            if (r < T0) { s = FIN(3); sc = FIN(2); d = win; K = DM; Nsrc = D_IN; Ndst = NP; mode = 1; tn = 80; tpl = 80 * 32; }
            else if ((r -= T0) < T1) { s = FIN(4); d = wout; K = DM; Nsrc = DM; Ndst = DM; tn = 32; tpl = 32 * 32; }
            else if ((r -= T1) < T2) { s = FIN(25); sc = FIN(24); d = wuq; K = 384; Nsrc = 768; Ndst = 768; tn = 12; tpl = 72; }
            else if ((r -= T2) < T3) { s = FIN(27); sc = FIN(26); d = wukv; K = 128; Nsrc = 1024; Ndst = 1024; tn = 16; tpl = 32; }
            else { r -= T3; s = FIN(19); d = wglu; K = 512; Nsrc = 512; Ndst = 512; tn = 8; tpl = 64; }
            const int l = r / tpl, r2 = r % tpl, n0 = (r2 % tn) * 64, k0 = (r2 / tn) * 64;
            if (valid) wtrans_read(s + (size_t)l * K * Nsrc, Nsrc, sc ? sc + (size_t)l * K : nullptr, mode, n0, k0, tile, t256);
            __syncthreads();
            if (valid) wtrans_write(d + (size_t)l * Ndst * K, K, n0, k0, tile, t256);
            __syncthreads();
        }
        if (gtid < (size_t)(DEPTH * 32 * 64)) s5prep_item((int)gtid, FIN(11), FIN(12), FIN(13), FIN(14), FIN(15), abar, bbar, (float*)(ws + WS_ABAR + 512 * 1024));
    }

#define MAKE_P() LayerP P; { unsigned char* ws = WSP(); \
        P.conv_w = FIN(5) + (size_t)lq * 4 * 768; P.conv_b = FIN(6) + (size_t)lq * 768; P.dt_bias = FIN(7) + lq * 8; P.a_log = FIN(8) + lq * 8; P.ssd_d = FIN(9) + lq * 8; P.ssd_norm_w = FIN(10) + lq * 512; \
        P.s5_c_re = FIN(16) + (size_t)lq * 32 * 16 * 64; P.s5_c_im = FIN(17) + (size_t)lq * 32 * 16 * 64; P.s5_d = FIN(18) + lq * 512; P.abar = (float*)(ws + WS_ABAR) + (size_t)lq * 32 * 64 * 2; P.bbar = (float*)(ws + WS_BBAR) + (size_t)lq * 32 * 64 * 32; \
        P.gla_w2 = FIN(21) + (size_t)lq * 16 * 256; P.gla_gb = FIN(22) + lq * 256; P.gla_norm_w = FIN(23) + lq * 128; \
        P.qh_w = FIN(28) + lq * 192; P.kh_w = FIN(29) + lq * 192; P.pos = (const int*)FIN(1); \
        P.proj = (bf16_t*)(ws + WS_PROJ); P.dtf = (float*)(ws + WS_DTF); \
        P.xbcc = (float*)(ws + WS_XBCC); P.dtv = (float*)(ws + WS_DTV); P.ys = (float*)(ws + WS_YS); P.hs = (float*)(ws + WS_HS); P.eg = (float*)(ws + WS_EG); P.og = (float*)(ws + WS_OG); \
        P.yg = (bf16_t*)(ws + WS_YG); P.mix = (bf16_t*)(ws + WS_MIX); P.qraw = (bf16_t*)(ws + WS_QRAW); P.kvraw = (bf16_t*)(ws + WS_KVRAW); \
        P.qf = (bf16_t*)(ws + WS_QF); P.kf = (bf16_t*)(ws + WS_KF); P.vf = (bf16_t*)(ws + WS_VF); P.vt = (bf16_t*)(ws + WS_VF); \
        P.xbcn = (bf16_t*)(ws + WS_XBCC); P.xT = (bf16_t*)(ws + WS_YS); P.hin = (bf16_t*)(ws + WS_HIN); P.csv = (float*)(ws + WS_DTV + 512 * 1024); P.cse = (float*)(ws + WS_DTV + 768 * 1024); P.sst = (float*)(ws + WS_SST); \
        P.cnt_ssd = (unsigned*)(ws + WS_CTL) + CW_SSD + lq * 8 * 64; \
        P.qt = (bf16_t*)(ws + WS_EG); P.kt = (bf16_t*)(ws + WS_EG + 4 * MiB); P.vT2 = (bf16_t*)(ws + WS_OG); P.glb = (float*)(ws + WS_OG + 8 * MiB); P.gst = (float*)(ws + WS_GST); P.gin = (bf16_t*)(ws + WS_GIN); \
        P.cnt_gla = (unsigned*)(ws + WS_CTL) + CW_GLA + lq * 8 * 64; \
        P.abar64 = (const float*)(ws + WS_ABAR + 512 * 1024) + (size_t)lq * 32 * 64 * 2; P.s5st = (float*)(ws + WS_HS); P.s5in = (float*)(ws + WS_HS + 4 * MiB); P.cnt_s5 = (unsigned*)(ws + WS_CTL) + CW_S5 + lq * 8 * 64; }
#define RUN_GEMM(EPI, gA, gBt, gN, gK, glda, gldb, ESET) do { pg8::Gemm g; g.A = (gA); g.Bt = (gBt); g.M = TOK; g.N = (gN); g.K = (gK); g.lda = (glda); g.ldb = (gldb); g.pad = 0; \
        pg8::EPI E; ESET; int bid_ = blockIdx.x; asm volatile("" : "+s"(bid_)); pg8::StaticOrder S; S.init(g.M, g.N, G, bid_); pg8::gemm_phase<pg8::EPI, pg8::StaticOrder, true>(lds, g, S, E, wave_s); } while (0)

#define HBUF_IN(q) ((q) == 0 ? FIN(0) : (const float*)OUTP())
#define HBUF_OUT(q) OUTP()
#define LQ() int lq = l; asm volatile("" : "+s"(lq))
#pragma clang loop unroll(disable)
    for (int l = 0; l < DEPTH; ++l) {
        for (int rep = 0; rep < REP_A; ++rep)
        { LQ(); IDS(); unsigned char* ws = WSP(); const float* hin = HBUF_IN(lq);
          k_rowprep(hin, (bf16_t*)(ws + WS_HB), (float*)(ws + WS_RSTD), lane, gw, ngw); }
        GRID_BAR();
        for (int rep = 0; rep < REP_B; ++rep)
        { LQ(); unsigned char* ws = WSP();
          RUN_GEMM(EpiP1, (const bf16_t*)(ws + WS_HB), (const bf16_t*)(ws + WS_WIN) + (size_t)lq * NP * DM, NP, DM, DM, DM,
                   (E.O = (bf16_t*)(ws + WS_PROJ), E.rstd = (const float*)(ws + WS_RSTD), E.dtf = (float*)(ws + WS_DTF))); }
        GRID_BAR();
        for (int rep = 0; rep < REP_C; ++rep) {
        { LQ(); IDS(); MAKE_P();
          for (int it = bid_; it < 128; it += G) ssd_passA(P, lds, it, wave, lane, rep == 0);
          for (int it = bid_ - 128; it < 128; it += G) if (it >= 0) { gla_passA(P, lds, it, wave, lane, rep == 0); s5_passA(P, lds, it, wave, lane, rep == 0); } }
        { LQ(); unsigned char* ws = WSP();
          RUN_GEMM(EpiBf16, (const bf16_t*)(ws + WS_PROJ) + C_CQ, (const bf16_t*)(ws + WS_WUQ) + (size_t)lq * 768 * 384, 768, 384, NP, 384, (E.O = (bf16_t*)(ws + WS_QRAW), E.ldc = 768, E.pad = 0)); }
        { LQ(); unsigned char* ws = WSP();
          RUN_GEMM(EpiBf16, (const bf16_t*)(ws + WS_PROJ) + C_CKV, (const bf16_t*)(ws + WS_WUKV) + (size_t)lq * 1024 * 128, 1024, 128, NP, 128, (E.O = (bf16_t*)(ws + WS_KVRAW), E.ldc = 1024, E.pad = 0)); }
        }
        GRID_BAR();
        { LQ(); IDS(); MAKE_P(); k_mla_fin(P, lane, gw, ngw); }
#if REP_D1 > 1
        { LQ(); IDS(); MAKE_P(); k_mla_fin(P, lane, gw, ngw); }
#endif
        { LQ(); IDS(); MAKE_P(); for (int it = bid_; it < 128; it += G) s5_passB(P, lds, it, wave, lane); }
#if REP_D2 > 1
        { LQ(); IDS(); MAKE_P(); for (int it = bid_; it < 128; it += G) s5_passB(P, lds, it, wave, lane); }
#endif
        { LQ(); IDS(); MAKE_P(); for (int it = bid_; it < 128; it += G) ssd_passB(P, lds, it, wave, lane); }
#if REP_D3 > 1
        { LQ(); IDS(); MAKE_P(); for (int it = bid_; it < 128; it += G) ssd_passB(P, lds, it, wave, lane); }
#endif
        { LQ(); IDS(); MAKE_P(); for (int it = bid_ - 128; it < 128; it += G) if (it >= 0) gla_passB(P, lds, it, wave, lane); }
#if REP_D4 > 1
        { LQ(); IDS(); MAKE_P(); for (int it = bid_ - 128; it < 128; it += G) if (it >= 0) gla_passB(P, lds, it, wave, lane); }
#endif
        GRID_BAR();
        { LQ(); IDS(); MAKE_P();
          for (int u = bid_; u < 256; u += G) attn_unit(P, lds, u, wave, lane); }
        { LQ(); unsigned char* ws = WSP();
          RUN_GEMM(EpiGlu, (const bf16_t*)(ws + WS_YG), (const bf16_t*)(ws + WS_WGLU) + (size_t)lq * 512 * 512, 512, 512, 512, 512,
                   (E.yg = (const bf16_t*)(ws + WS_YG), E.proj = (const bf16_t*)(ws + WS_PROJ), E.bias = FIN(20) + lq * 512, E.mix = (bf16_t*)(ws + WS_MIX))); }
#if REP_E > 1
        { LQ(); IDS(); MAKE_P();
          for (int u = bid_; u < 256; u += G) attn_unit(P, lds, u, wave, lane); }
        { LQ(); unsigned char* ws = WSP();
          RUN_GEMM(EpiGlu, (const bf16_t*)(ws + WS_YG), (const bf16_t*)(ws + WS_WGLU) + (size_t)lq * 512 * 512, 512, 512, 512, 512,
                   (E.yg = (const bf16_t*)(ws + WS_YG), E.proj = (const bf16_t*)(ws + WS_PROJ), E.bias = FIN(20) + lq * 512, E.mix = (bf16_t*)(ws + WS_MIX))); }
#endif
        for (int rep = 0; rep < REP_BAR; ++rep)
        GRID_BAR();
        { LQ(); unsigned char* ws = WSP(); const float* hin = HBUF_IN(lq);
          RUN_GEMM(EpiRes, (const bf16_t*)(ws + WS_MIX), (const bf16_t*)(ws + WS_WOUT) + (size_t)lq * DM * DM, DM, DM, DM, DM, (E.base = hin, E.out = HBUF_OUT(lq))); }
#if REP_F > 1
        if (l == 0)
        { LQ(); unsigned char* ws = WSP(); const float* hin = HBUF_IN(lq);
          RUN_GEMM(EpiRes, (const bf16_t*)(ws + WS_MIX), (const bf16_t*)(ws + WS_WOUT) + (size_t)lq * DM * DM, DM, DM, DM, DM, (E.base = hin, E.out = HBUF_OUT(lq))); }
#endif
        if (l + 1 < DEPTH) GRID_BAR();
    }
}

extern "C" void kernel_launch(void* const* d_in, const int* in_sizes, int n_in, void* d_out, int out_size, void* d_ws, size_t ws_size, hipStream_t stream) {
    static int grid = 0;
    if (grid == 0) {
        if (n_in != 30 || out_size != TOK * DM || ws_size < WS_END) { fprintf(stderr, "kernel_launch: unexpected shapes (n_in %d out %d ws %zu need %zu)\n", n_in, out_size, ws_size, (size_t)WS_END); grid = -1; return; }
        int dev = 0, cus = 0;
        if (hipGetDevice(&dev) != hipSuccess || hipDeviceGetAttribute(&cus, hipDeviceAttributeMultiprocessorCount, dev) != hipSuccess || cus <= 0) { fprintf(stderr, "kernel_launch: device query failed\n"); grid = -1; return; }
        grid = cus;
    }
    if (grid < 0) return;
    (void)hipMemsetAsync((char*)d_ws + WS_CTL, 0, CTL_ZERO_BYTES, stream);
    MegaArgs a{};
    for (int i = 0; i < 30; ++i) a.in[i] = (const float*)d_in[i];
    a.out = (float*)d_out; a.ws = (unsigned char*)d_ws;
    hipLaunchKernelGGL(mega_fwd, dim3(grid), dim3(512), 0, stream, a);
}
```

```cpp
#include <hip/hip_runtime.h>
#include <cstdio>
#include <cstdint>

#define LAS __attribute__((address_space(3)))
typedef unsigned short bf16_t;
typedef short bf16x8 __attribute__((ext_vector_type(8)));
typedef float f32x4 __attribute__((ext_vector_type(4)));
typedef unsigned u32x4 __attribute__((ext_vector_type(4)));
typedef unsigned u32x2 __attribute__((ext_vector_type(2)));
typedef float f32x2v __attribute__((ext_vector_type(2)));

constexpr int DM = 2048, NB = 4, SEQ = 2048, DEPTH = 4, TOK = NB * SEQ;
constexpr int D_IN = 4952, NP = 5120;
constexpr float EPS = 1e-6f;
constexpr int C_Z = 0, C_XBC = 512, C_S5U = 1280, C_S5G = 1792, C_GQ = 2304, C_GK = 2560, C_GV = 2816, C_GG = 3328,
              C_CQ = 3840, C_CKV = 4224, C_KPE = 4352, C_DT = 4416, C_GLR = 4424, C_PAD = 4440, C_MG = 4608;
__host__ __device__ __forceinline__ int win_src_col(int n) {
    if (n < 1280) return n;
    if (n < C_GQ) return n + 8;
    if (n < C_CQ) return n + 8;
    if (n < C_KPE) return n + 24;
    if (n < C_DT) return n + 24;
    if (n < C_GLR) return n - C_DT + 1280;
    if (n < C_PAD) return n - C_GLR + 3848;
    if (n < C_MG) return -1;
    return n - C_MG + 4440;
}

__device__ __forceinline__ int lane_id() { int l; asm volatile("v_mbcnt_lo_u32_b32 %0, -1, 0\n\tv_mbcnt_hi_u32_b32 %0, -1, %0" : "=v"(l)); return l; }
__device__ __forceinline__ float bf2f(bf16_t v) { return __uint_as_float(((unsigned)v) << 16); }
__device__ __forceinline__ unsigned f2bf(float f) { unsigned u = __float_as_uint(f); return (u + 0x7fffu + ((u >> 16) & 1u)) >> 16; }
__device__ __forceinline__ unsigned pk2(float lo, float hi) { return f2bf(lo) | (f2bf(hi) << 16); }
template <int X> __device__ __forceinline__ float swz_xor(float v) { return __int_as_float(__builtin_amdgcn_ds_swizzle(__float_as_int(v), (X << 10) | 0x1f)); }
__device__ __forceinline__ float xor32_other(float v, int lane) {
    auto r = __builtin_amdgcn_permlane32_swap(__float_as_uint(v), __float_as_uint(v), false, false);
    return __uint_as_float(lane < 32 ? r[1] : r[0]); }
__device__ __forceinline__ float wave_sum(float v) {
    v += swz_xor<1>(v); v += swz_xor<2>(v); v += swz_xor<4>(v); v += swz_xor<8>(v); v += swz_xor<16>(v);
    auto r = __builtin_amdgcn_permlane32_swap(__float_as_uint(v), __float_as_uint(v), false, false);
    return __uint_as_float(r[0]) + __uint_as_float(r[1]);
}
__device__ __forceinline__ float xmax16(float v) {
    v = fmaxf(v, swz_xor<1>(v)); v = fmaxf(v, swz_xor<2>(v)); v = fmaxf(v, swz_xor<4>(v)); v = fmaxf(v, swz_xor<8>(v)); return v; }
__device__ __forceinline__ float xsum16(float v) {
    v += swz_xor<1>(v); v += swz_xor<2>(v); v += swz_xor<4>(v); v += swz_xor<8>(v); return v; }
__device__ __forceinline__ float fexp(float x) { return __builtin_amdgcn_exp2f(x * 1.4426950408889634f); }
__device__ __forceinline__ float flog(float x) { return __builtin_amdgcn_logf(x) * 0.6931471805599453f; }
__device__ __forceinline__ float frcp(float x) { return __builtin_amdgcn_rcpf(x); }
__device__ __forceinline__ float frsq(float x) { return __builtin_amdgcn_rsqf(x); }
__device__ __forceinline__ float log1p_small(float e) { return (e < 0.01f) ? e * (1.0f - e * (0.5f - e * (1.0f / 3.0f))) : flog(1.0f + e); }
__device__ __forceinline__ float sigmoidf_(float x) { return frcp(1.0f + fexp(-x)); }
__device__ __forceinline__ float siluf_(float x) { return x * sigmoidf_(x); }
__device__ __forceinline__ float softplusf_(float x) { return x > 20.f ? x : log1p_small(fexp(x)); }
__device__ __forceinline__ float gelu_tanh(float x) { const float y = 0.7978845608028654f * (x + 0.044715f * x * x * x); const float th = 1.0f - 2.0f * frcp(1.0f + fexp(2.0f * y)); return 0.5f * x * (1.0f + th); }

__device__ __forceinline__ void* uptr_(unsigned long long v) {
    const unsigned lo = __builtin_amdgcn_readfirstlane((unsigned)v), hi = __builtin_amdgcn_readfirstlane((unsigned)(v >> 32));
    return (void*)(__attribute__((address_space(1))) void*)(((unsigned long long)hi << 32) | lo);
}
namespace pg8 {
constexpr int BM = 256, BK = 64, HALF = 128, HTB = HALF * BK * 2, STAGE_BYTES = 8 * HTB, NXCD = 8, WGM = 8;
__host__ __device__ __forceinline__ int lds_byte(int r, int c) { const int st = (r >> 4) * 2 + (c >> 5), rr = r & 15, cc = c & 31, ob = rr * 64 + cc * 2; return st * 1024 + (ob ^ (((ob >> 9) & 1) << 5)); }
__host__ __device__ __forceinline__ void stage_rc(int b, int& R, int& C) { const int st = b / 1024, sb = b % 1024, swz = sb ^ (((sb >> 9) & 1) << 5); R = (st >> 1) * 16 + swz / 64; C = (st & 1) * 32 + (swz % 64) / 2; }
__host__ __device__ __forceinline__ int perm32(int rho) { const int n = rho >> 4, i = rho & 15; return 8 * (i >> 2) + 4 * n + (i & 3); }
struct Unit { int pm, pn; };
struct Gemm { const bf16_t* A; const bf16_t* Bt; int M, N, K, lda, ldb, pad; };
__host__ __device__ __forceinline__ int p1_tile(int pl) { const unsigned long long lo = 2ull | (3ull << 5) | (4ull << 10) | (5ull << 15) | (6ull << 20) | (9ull << 25) | (10ull << 30) | (11ull << 35) | (12ull << 40) | (15ull << 45) | (16ull << 50) | (17ull << 55);
    const unsigned long long hi = 0ull | (1ull << 5) | (7ull << 10) | (8ull << 15) | (13ull << 20) | (14ull << 25) | (18ull << 30) | (19ull << 35);
    return pl < 12 ? (int)((lo >> (5 * pl)) & 31ull) : (int)((hi >> (5 * (pl - 12))) & 31ull); }
struct P1Order {
    int G, c, nunits;
    __device__ bool next(int i, Unit& u) const { const int L = i * G + c; if (L >= nunits) return false; u.pm = L & 31; u.pn = p1_tile(L >> 5); return true; }
};
struct OneUnit { int pm, pn; __device__ bool next(int i, Unit& u) const { if (i) return false; u.pm = pm; u.pn = pn; return true; } };
struct StaticOrder {
    int nM, nN, nwg, G, c;
    __host__ __device__ void init(int M, int N, int G_, int c_) { nM = M / BM; nN = N / BM; nwg = nM * nN; G = G_; c = c_; }
    __host__ __device__ bool next(int i, Unit& u) const {
        const long L = (long)i * G + c; if (L >= nwg) return false;
        int wgid = (int)L; { const int q = nwg / NXCD, r = nwg % NXCD, xcd = wgid % NXCD, off = wgid / NXCD; wgid = (xcd < r ? xcd * (q + 1) : r * (q + 1) + (xcd - r) * q) + off; }
        const int nig = WGM * nN, gid = wgid / nig, fm = gid * WGM, gsz = (nM - fm) < WGM ? (nM - fm) : WGM;
        u.pm = fm + ((wgid % nig) % gsz); u.pn = (wgid % nig) / gsz; return true;
    }
};
__device__ __forceinline__ void glds16_s(const void* sbase, unsigned voff, unsigned lds_dst) {
    unsigned keep;
    asm volatile("s_nop 4\n\ts_mov_b32 %0, m0\n\ts_mov_b32 m0, %2\n\ts_nop 0\n\tglobal_load_lds_dwordx4 %1, %3\n\ts_mov_b32 m0, %0" : "=&s"(keep) : "v"(voff), "s"(lds_dst), "s"(sbase) : "memory");
}
__device__ __forceinline__ unsigned cvt_pk_bf16(float lo, float hi) { unsigned r; asm volatile("v_cvt_pk_bf16_f32 %0, %1, %2" : "=v"(r) : "v"(lo), "v"(hi)); return r; }

template <class Epi, class Sched, bool ALIGN_EPI>
__device__ __forceinline__ void gemm_phase(LAS unsigned char* lds, const Gemm g, const Sched& S, const Epi& E, int wid_in) {
    int lane = lane_id(), wid0 = wid_in; asm volatile("" : "+v"(lane), "+s"(wid0)); const int wid = __builtin_amdgcn_readfirstlane(wid0);
    const int tid = wid * 64 + lane, wr = wid >> 2, wc = wid & 3, fr = lane & 15, fq = lane >> 4;
    const int K = g.K, nt = K / BK;
    unsigned voffA[2], voffB[2];
#pragma unroll
    for (int i = 0; i < 2; ++i) { int R, C; stage_rc(tid * 16 + i * 8192, R, C); const int Rb = Epi::PERM ? ((R & ~31) + perm32(R & 31)) : R;
        voffA[i] = (unsigned)(R * g.lda + C) * 2u; voffB[i] = (unsigned)(Rb * g.ldb + C) * 2u; }
    const size_t kstep = (size_t)(BK * 2);
    const size_t hstepA = (size_t)HALF * g.lda * 2, hstepB = (size_t)HALF * g.ldb * 2;
    const size_t tstepA = 2 * hstepA, tstepB = 2 * hstepB;
    const unsigned ldsw = (unsigned)wid * 1024u, ldsbase = (unsigned)(uintptr_t)lds;
    const int aoff = lds_byte(wr * 64 + fr, fq * 8), boff = lds_byte(wc * 32 + fr, fq * 8);
#define PG8_SA(b, h) (((b) * 2 + (h)) * HTB)
#define PG8_SB(b, h) ((4 + (b) * 2 + (h)) * HTB)
#define PG8_STAGE(bufoff, gbase, voff) do { _Pragma("unroll") for (int _i = 0; _i < 2; ++_i) \
        glds16_s((const void*)(gbase), (voff)[_i], (unsigned)__builtin_amdgcn_readfirstlane((int)(ldsbase + (unsigned)(bufoff) + ldsw + (unsigned)(_i * 8192)))); } while (0)
#define PG8_LDA(dst, b, h) do { _Pragma("unroll") for (int m = 0; m < 4; ++m) _Pragma("unroll") for (int k = 0; k < 2; ++k) dst[m][k] = *(const LAS bf16x8*)(lds + PG8_SA(b, h) + aoff + m * 2048 + k * 1024); } while (0)
#define PG8_LDB(dst, b, h) do { _Pragma("unroll") for (int n = 0; n < 2; ++n) _Pragma("unroll") for (int k = 0; k < 2; ++k) dst[n][k] = *(const LAS bf16x8*)(lds + PG8_SB(b, h) + boff + n * 2048 + k * 1024); } while (0)
#define PG8_MMA(ai, bj, At, Bt) do { __builtin_amdgcn_s_setprio(1); _Pragma("unroll") for (int m = 0; m < 4; ++m) _Pragma("unroll") for (int n = 0; n < 2; ++n) _Pragma("unroll") for (int k = 0; k < 2; ++k) \
        acc[ai][bj][m][n] = __builtin_amdgcn_mfma_f32_16x16x32_bf16(Bt[n][k], At[m][k], acc[ai][bj][m][n], 0, 0, 0); __builtin_amdgcn_s_setprio(0); } while (0)
#define PG8_WAIT_V(n) asm volatile("s_waitcnt vmcnt(" #n ")" ::: "memory")
#define PG8_WAIT_L(n) asm volatile("s_waitcnt lgkmcnt(" #n ")" ::: "memory")
#define PG8_BAR __builtin_amdgcn_s_barrier()
#define PG8_SCHED __builtin_amdgcn_sched_barrier(0)
    Unit cur, nxt; int ui = 0;
    if (!S.next(0, cur)) return;
    f32x4 acc[2][2][4][2];
#pragma unroll
    for (int a = 0; a < 2; ++a)
#pragma unroll
        for (int b = 0; b < 2; ++b)
#pragma unroll
            for (int m = 0; m < 4; ++m)
#pragma unroll
                for (int n = 0; n < 2; ++n) acc[a][b][m][n] = (f32x4){0.f, 0.f, 0.f, 0.f};
    bf16x8 At[4][2], B0[2][2], B1[2][2];
    const char* const gA_ = (const char*)uptr_((unsigned long long)g.A); const char* const gB_ = (const char*)uptr_((unsigned long long)g.Bt);
    const char* cA = gA_ + (size_t)__builtin_amdgcn_readfirstlane(cur.pm) * tstepA; const char* cB = gB_ + (size_t)__builtin_amdgcn_readfirstlane(cur.pn) * tstepB;
    PG8_STAGE(PG8_SB(0, 0), cB, voffB); PG8_STAGE(PG8_SB(0, 1), cB + hstepB, voffB); PG8_STAGE(PG8_SA(0, 0), cA, voffA); PG8_STAGE(PG8_SA(0, 1), cA + hstepA, voffA);
    if (wr == 1) PG8_BAR;
    PG8_WAIT_V(2); PG8_BAR;
    PG8_STAGE(PG8_SB(1, 0), cB + kstep, voffB); PG8_STAGE(PG8_SA(1, 0), cA + kstep, voffA); PG8_STAGE(PG8_SB(1, 1), cB + hstepB + kstep, voffB);
    PG8_WAIT_V(6); PG8_BAR;
    for (;;) {
        const bool has_next = S.next(ui + 1, nxt);
        const char* nA = has_next ? gA_ + (size_t)__builtin_amdgcn_readfirstlane(nxt.pm) * tstepA : cA; const char* nB = has_next ? gB_ + (size_t)__builtin_amdgcn_readfirstlane(nxt.pn) * tstepB : cB;
        for (int t = 0; t < nt; t += 2) {
            const bool last = (t == nt - 2);
            const char* a1 = cA + (size_t)(t + 1) * kstep;
            const char* a2 = last ? nA : cA + (size_t)(t + 2) * kstep; const char* b2 = last ? nB : cB + (size_t)(t + 2) * kstep;
            const char* a3 = a2 + kstep; const char* b3 = b2 + kstep;
            PG8_LDB(B0, 0, 0); PG8_LDB(B1, 0, 1); PG8_SCHED; PG8_LDA(At, 0, 0); PG8_STAGE(PG8_SA(1, 1), a1 + hstepA, voffA);
            PG8_WAIT_V(8); PG8_WAIT_L(0); PG8_BAR; PG8_MMA(0, 0, At, B0); PG8_MMA(0, 1, At, B1); PG8_BAR; PG8_SCHED;
            PG8_LDA(At, 0, 1); PG8_STAGE(PG8_SB(0, 0), b2, voffB); PG8_STAGE(PG8_SB(0, 1), b2 + hstepB, voffB); PG8_STAGE(PG8_SA(0, 0), a2, voffA);
            PG8_WAIT_V(8); PG8_WAIT_L(0); PG8_BAR; PG8_MMA(1, 0, At, B0); PG8_MMA(1, 1, At, B1); PG8_BAR; PG8_SCHED;
            PG8_LDB(B0, 1, 0); PG8_LDB(B1, 1, 1); PG8_SCHED; PG8_LDA(At, 1, 0); PG8_STAGE(PG8_SA(0, 1), a2 + hstepA, voffA);
            PG8_WAIT_V(8); PG8_WAIT_L(0); PG8_BAR; PG8_MMA(0, 0, At, B0); PG8_MMA(0, 1, At, B1); PG8_BAR; PG8_SCHED;
            PG8_LDA(At, 1, 1); PG8_STAGE(PG8_SB(1, 0), b3, voffB); PG8_STAGE(PG8_SB(1, 1), b3 + hstepB, voffB); PG8_STAGE(PG8_SA(1, 0), a3, voffA);
            PG8_WAIT_V(8); PG8_WAIT_L(0); PG8_BAR; PG8_MMA(1, 0, At, B0); PG8_MMA(1, 1, At, B1); PG8_BAR; PG8_SCHED;
        }
        if constexpr (ALIGN_EPI) { if (wr == 0) PG8_BAR; }
        E(acc, cur, wr, wc, fr, fq);
        if (!has_next) break;
#pragma unroll
        for (int a = 0; a < 2; ++a)
#pragma unroll
            for (int b = 0; b < 2; ++b)
#pragma unroll
                for (int m = 0; m < 4; ++m)
#pragma unroll
                    for (int n = 0; n < 2; ++n) acc[a][b][m][n] = (f32x4){0.f, 0.f, 0.f, 0.f};
        cur = nxt; cA = nA; cB = nB; ++ui;
        if constexpr (ALIGN_EPI) { if (wr == 1) PG8_BAR; }
    }
    PG8_WAIT_V(0);
    if constexpr (!ALIGN_EPI) { if (wr == 0) PG8_BAR; }
    PG8_BAR;
#undef PG8_SA
#undef PG8_SB
#undef PG8_STAGE
#undef PG8_LDA
#undef PG8_LDB
#undef PG8_MMA
#undef PG8_WAIT_V
#undef PG8_WAIT_L
#undef PG8_BAR
#undef PG8_SCHED
}

struct EpiBf16 {
    static constexpr bool PERM = true;
    bf16_t* O; int ldc, pad;
    __device__ __forceinline__ void operator()(const f32x4 (&acc)[2][2][4][2], const Unit& u, int wr_, int wc_, int fr_, int fq_) const {
        const int ln_ = lane_id(), fr = ln_ & 15, fq = ln_ >> 4; (void)fr_; (void)fq_; const int wr = wr_, wc = wc_;
        const int row0 = u.pm * BM + wr * 64 + fr, col0 = u.pn * BM + wc * 32 + 8 * fq;
#pragma unroll
        for (int ai = 0; ai < 2; ++ai)
#pragma unroll
            for (int m = 0; m < 4; ++m) { bf16_t* rowp = O + (size_t)(row0 + ai * HALF + m * 16) * ldc + col0;
#pragma unroll
                for (int bj = 0; bj < 2; ++bj) { const f32x4 v0 = acc[ai][bj][m][0], v1 = acc[ai][bj][m][1];
                    u32x4 w; w.x = cvt_pk_bf16(v0[0], v0[1]); w.y = cvt_pk_bf16(v0[2], v0[3]); w.z = cvt_pk_bf16(v1[0], v1[1]); w.w = cvt_pk_bf16(v1[2], v1[3]);
                    *(u32x4*)(rowp + bj * HALF) = w; } }
    }
};
struct EpiBf16Sig {
    static constexpr bool PERM = true;
    bf16_t* O; unsigned* cnt; int ldc, pad;
    __device__ __forceinline__ void operator()(const f32x4 (&acc)[2][2][4][2], const Unit& u, int wr_, int wc_, int fr_, int fq_) const {
        const int ln_ = lane_id(), fr = ln_ & 15, fq = ln_ >> 4; (void)fr_; (void)fq_; const int wr = wr_, wc = wc_;
        const int row0 = u.pm * BM + wr * 64 + fr, col0 = u.pn * BM + wc * 32 + 8 * fq;
#pragma unroll
        for (int ai = 0; ai < 2; ++ai)
#pragma unroll
            for (int m = 0; m < 4; ++m) { bf16_t* rowp = O + (size_t)(row0 + ai * HALF + m * 16) * ldc + col0;
#pragma unroll
                for (int bj = 0; bj < 2; ++bj) { const f32x4 v0 = acc[ai][bj][m][0], v1 = acc[ai][bj][m][1];
                    u32x4 w; w.x = cvt_pk_bf16(v0[0], v0[1]); w.y = cvt_pk_bf16(v0[2], v0[3]); w.z = cvt_pk_bf16(v1[0], v1[1]); w.w = cvt_pk_bf16(v1[2], v1[3]);
                    *(u32x4*)(rowp + bj * HALF) = w; } }
        asm volatile("s_waitcnt vmcnt(0)" ::: "memory"); __builtin_amdgcn_s_barrier(); asm volatile("" ::: "memory");
        if ((wr * 4 + wc) == 0 && ln_ == 0) { __builtin_amdgcn_fence(__ATOMIC_RELEASE, "agent"); asm volatile("s_waitcnt vmcnt(0)" ::: "memory");
            (void)__hip_atomic_fetch_add(cnt + 64 * u.pm, 1u, __ATOMIC_RELAXED, __HIP_MEMORY_SCOPE_AGENT); }
    }
};
struct EpiP1 {
    static constexpr bool PERM = true;
    bf16_t* O; const float* rstd; float* dtf;
    __device__ __forceinline__ void operator()(const f32x4 (&acc)[2][2][4][2], const Unit& u, int wr_, int wc_, int fr_, int fq_) const {
        const int ln_ = lane_id(), fr = ln_ & 15, fq = ln_ >> 4; (void)fr_; (void)fq_; const int wr = wr_, wc = wc_;
        const int row0 = u.pm * BM + wr * 64 + fr, col0 = u.pn * BM + wc * 32 + 8 * fq;
        const bool isdt = (u.pn == C_DT / 256) && (wc * 32 + 8 * fq == C_DT % 256);
#pragma unroll
        for (int ai = 0; ai < 2; ++ai)
#pragma unroll
            for (int m = 0; m < 4; ++m) { const int row = row0 + ai * HALF + m * 16; const f32x4 q0 = *(const f32x4*)(rstd + (size_t)row * 8), q1 = *(const f32x4*)(rstd + (size_t)row * 8 + 4);
                const float rs = frsq((((q0.x + q0.y) + (q0.z + q0.w)) + ((q1.x + q1.y) + (q1.z + q1.w))) * (1.0f / DM) + EPS); bf16_t* rowp = O + (size_t)row * NP + col0;
#pragma unroll
                for (int bj = 0; bj < 2; ++bj) { const f32x4 v0 = acc[ai][bj][m][0] * rs, v1 = acc[ai][bj][m][1] * rs;
                    u32x4 w; w.x = cvt_pk_bf16(v0[0], v0[1]); w.y = cvt_pk_bf16(v0[2], v0[3]); w.z = cvt_pk_bf16(v1[0], v1[1]); w.w = cvt_pk_bf16(v1[2], v1[3]);
                    *(u32x4*)(rowp + bj * HALF) = w;
                    if (bj == 0 && isdt) { *(f32x4*)(dtf + (size_t)row * 8) = v0; *(f32x4*)(dtf + (size_t)row * 8 + 4) = v1; } } }
    }
};
struct EpiRes {
    static constexpr bool PERM = false;
    const float* base; float* out;
    __device__ __forceinline__ void operator()(const f32x4 (&acc)[2][2][4][2], const Unit& u, int wr_, int wc_, int fr_, int fq_) const {
        const int ln_ = lane_id(), fr = ln_ & 15, fq = ln_ >> 4; (void)fr_; (void)fq_; const int wr = wr_, wc = wc_;
        const int row0 = u.pm * BM + wr * 64 + fr, col0 = u.pn * BM + wc * 32 + 4 * fq;
#pragma unroll
        for (int ai = 0; ai < 2; ++ai)
#pragma unroll
            for (int m = 0; m < 4; ++m) { const size_t off = (size_t)(row0 + ai * HALF + m * 16) * DM + col0;
#pragma unroll
                for (int bj = 0; bj < 2; ++bj)
#pragma unroll
                    for (int n = 0; n < 2; ++n) { const size_t ix = off + bj * HALF + n * 16; const f32x4 b = *(const f32x4*)(base + ix); *(f32x4*)(out + ix) = b + acc[ai][bj][m][n]; } }
    }
};
struct EpiRes2 {
    static constexpr bool PERM = false;
    const float* base; float* out; bf16_t* hb; float* rsq; LAS float* xs;
    __device__ __forceinline__ void operator()(const f32x4 (&acc)[2][2][4][2], const Unit& u, int wr_, int wc_, int fr_, int fq_) const {
        const int ln_ = lane_id(), fr = ln_ & 15, fq = ln_ >> 4; (void)fr_; (void)fq_; const int wr = wr_, wc = wc_;
        const int row0 = u.pm * BM + wr * 64 + fr, col0 = u.pn * BM + wc * 32 + 4 * fq;
#pragma unroll
        for (int ai = 0; ai < 2; ++ai)
#pragma unroll
            for (int m = 0; m < 4; ++m) { const size_t off = (size_t)(row0 + ai * HALF + m * 16) * DM + col0; float q = 0.f;
#pragma unroll
                for (int bj = 0; bj < 2; ++bj)
#pragma unroll
                    for (int n = 0; n < 2; ++n) { const size_t ix = off + bj * HALF + n * 16; const f32x4 v = *(const f32x4*)(base + ix) + acc[ai][bj][m][n]; *(f32x4*)(out + ix) = v;
                        u32x2 w; w.x = cvt_pk_bf16(v.x, v.y); w.y = cvt_pk_bf16(v.z, v.w); *(u32x2*)(hb + ix) = w;
                        q += (v.x * v.x + v.y * v.y) + (v.z * v.z + v.w * v.w); }
                q += swz_xor<16>(q);
                { auto r = __builtin_amdgcn_permlane32_swap(__float_as_uint(q), __float_as_uint(q), false, false); q = __uint_as_float(r[0]) + __uint_as_float(r[1]); }
                if (fq == 0) xs[(ai * HALF + wr * 64 + m * 16 + fr) * 4 + wc] = q; }
        asm volatile("s_waitcnt lgkmcnt(0)" ::: "memory"); __builtin_amdgcn_s_barrier(); asm volatile("" ::: "memory");
        const int tid = (wr * 4 + wc) * 64 + ln_;
        if (tid < 256) { const f32x4 p = *(const LAS f32x4*)(xs + tid * 4); rsq[(size_t)(u.pm * BM + tid) * 8 + u.pn] = (p.x + p.y) + (p.z + p.w); }
    }
};
struct EpiGlu {
    static constexpr bool PERM = true;
    const bf16_t* yg; const bf16_t* proj; const float* bias; bf16_t* mix;
    __device__ __forceinline__ void operator()(const f32x4 (&acc)[2][2][4][2], const Unit& u, int wr_, int wc_, int fr_, int fq_) const {
        const int ln_ = lane_id(), fr = ln_ & 15, fq = ln_ >> 4; (void)fr_; (void)fq_; const int wr = wr_, wc = wc_;
        const int row0 = u.pm * BM + wr * 64 + fr, col0 = u.pn * BM + wc * 32 + 8 * fq;
#pragma unroll
        for (int ai = 0; ai < 2; ++ai)
#pragma unroll
            for (int m = 0; m < 4; ++m) { const int row = row0 + ai * HALF + m * 16;
#pragma unroll
                for (int bj = 0; bj < 2; ++bj) { const int col = col0 + bj * HALF;
                    const u32x4 yv = *(const u32x4*)(yg + (size_t)row * 512 + col), gv = *(const u32x4*)(proj + (size_t)row * NP + C_S5G + col);
                    const f32x4 b0 = *(const f32x4*)(bias + col), b1 = *(const f32x4*)(bias + col + 4);
                    float o[8];
#pragma unroll
                    for (int j = 0; j < 8; ++j) { const unsigned yw = yv[j >> 1], gw = gv[j >> 1];
                        const float y = (j & 1) ? __uint_as_float(yw & 0xffff0000u) : __uint_as_float(yw << 16);
                        const float gt = (j & 1) ? __uint_as_float(gw & 0xffff0000u) : __uint_as_float(gw << 16);
                        const float a = (j < 4 ? acc[ai][bj][m][0][j & 3] : acc[ai][bj][m][1][j & 3]) + (j < 4 ? b0[j & 3] : b1[j & 3]);
                        o[j] = y * sigmoidf_(a) * siluf_(gt); }
                    u32x4 w; w.x = cvt_pk_bf16(o[0], o[1]); w.y = cvt_pk_bf16(o[2], o[3]); w.z = cvt_pk_bf16(o[4], o[5]); w.w = cvt_pk_bf16(o[6], o[7]);
                    *(u32x4*)(mix + (size_t)row * DM + 512 + col) = w; } }
    }
};
}


__device__ __forceinline__ void wtrans_tile(const float* s, int Nsrc, const float* sc, int mode, bf16_t* d, int K, int n0, int k0, LAS unsigned char* lds, int tid) {
    LAS bf16_t* T = (LAS bf16_t*)lds;
    const int q = tid & 63, kp = tid >> 6;
    int sn = n0 + 4 * q; if (mode == 1) sn = win_src_col(sn);
#pragma unroll
    for (int i = 0; i < 4; ++i) { const int k = 2 * (kp + 8 * i);
        f32x4 a = (f32x4){0.f, 0.f, 0.f, 0.f}, b = a;
        if (sn >= 0) { a = *(const f32x4*)(s + (size_t)(k0 + k) * Nsrc + sn); b = *(const f32x4*)(s + (size_t)(k0 + k + 1) * Nsrc + sn);
            if (sc) { const float s0 = sc[k0 + k], s1 = sc[k0 + k + 1]; a = a * s0; b = b * s1; } }
        *(LAS unsigned*)(T + (4 * q + 0) * 72 + k) = pk2(a.x, b.x); *(LAS unsigned*)(T + (4 * q + 1) * 72 + k) = pk2(a.y, b.y);
        *(LAS unsigned*)(T + (4 * q + 2) * 72 + k) = pk2(a.z, b.z); *(LAS unsigned*)(T + (4 * q + 3) * 72 + k) = pk2(a.w, b.w); }
    __syncthreads();
#pragma unroll
    for (int i = 0; i < 4; ++i) { const int ci = tid + 512 * i, n = ci >> 3, cc = ci & 7;
        *(u32x4*)(d + (size_t)(n0 + n) * K + k0 + cc * 8) = *(const LAS u32x4*)(T + n * 72 + cc * 8); }
    __syncthreads();
}
__device__ __forceinline__ void s5prep_item(int i, const float* a_re, const float* a_im, const float* log_dt, const float* b_re, const float* b_im, float* abar, float* bbar, float* abar64, bf16_t* bmp) {
    const int lg = i / 64;
    const double are = a_re[i], aim = a_im[i], delta = exp((double)log_dt[lg]);
    const double mag = exp(are * delta), abr = mag * cos(aim * delta), abi = mag * sin(aim * delta), den = are * are + aim * aim;
    const double cr = ((abr - 1.0) * are + abi * aim) / den, ci = (abi * are - (abr - 1.0) * aim) / den;
    abar[2 * i] = (float)abr; abar[2 * i + 1] = (float)abi;
    { const double m64 = exp(64.0 * are * delta); abar64[2 * i] = (float)(m64 * cos(64.0 * aim * delta)); abar64[2 * i + 1] = (float)(m64 * sin(64.0 * aim * delta)); }
#pragma unroll
    for (int j = 0; j < 16; ++j) { const double br = b_re[(size_t)i * 16 + j], bi = b_im[(size_t)i * 16 + j];
        bbar[(size_t)i * 32 + j] = (float)(cr * br - ci * bi); bbar[(size_t)i * 32 + 16 + j] = (float)(cr * bi + ci * br); }
    {
        const int n = i & 63; bf16_t* r0 = bmp + ((size_t)lg * 128 + n) * 32; bf16_t* r1 = bmp + ((size_t)lg * 128 + 64 + n) * 32;
#pragma unroll
        for (int j = 0; j < 16; ++j) { r0[j] = (bf16_t)f2bf(bbar[(size_t)i * 32 + j]); r1[j] = (bf16_t)f2bf(bbar[(size_t)i * 32 + 16 + j]); r0[16 + j] = 0; r1[16 + j] = 0; } }
}
__device__ __forceinline__ void k_rowprep(const float* h, bf16_t* hb, float* rstd, int lane, int gw, int ngw) {
    for (int row = gw; row < TOK; row += ngw) {
        const f32x4* xr = (const f32x4*)(h + (size_t)row * DM) + lane; f32x4 v[8]; float s = 0.f;
#pragma unroll
        for (int j = 0; j < 8; ++j) { v[j] = xr[64 * j]; s += (v[j].x * v[j].x + v[j].y * v[j].y) + (v[j].z * v[j].z + v[j].w * v[j].w); }
        s = wave_sum(s);
        if (lane < 8) rstd[(size_t)row * 8 + lane] = (lane == 0) ? s : 0.f;
        u32x2* o = (u32x2*)(hb + (size_t)row * DM) + lane;
#pragma unroll
        for (int j = 0; j < 8; ++j) { u32x2 w; w.x = pk2(v[j].x, v[j].y); w.y = pk2(v[j].z, v[j].w); o[64 * j] = w; }
    }
}

struct LayerP {
    const float *conv_w, *conv_b, *dt_bias, *a_log, *ssd_d, *ssd_norm_w;
    const float *s5_c_re, *s5_c_im, *s5_d, *abar, *bbar;
    const float *gla_w2, *gla_gb, *gla_norm_w;
    const float *qh_w, *kh_w;
    const int* pos;
    const bf16_t* proj; const float* dtf;
    float *xbcc, *dtv, *ys, *hs, *eg, *og;
    bf16_t *yg, *mix, *qraw, *kvraw, *qf, *kf, *vf, *vt;
    bf16_t *xbcn, *xT, *hin; float *csv, *cse, *sst; unsigned* cnt_ssd;
    bf16_t *qt, *kt, *vT2, *gin; float *glb, *gst; unsigned* cnt_gla; unsigned* cnt_mla;
    const float* abar64; float *s5st, *s5in; unsigned* cnt_s5; const bf16_t *bmp, *cmp; unsigned* cnt_s5b;
};
__device__ __forceinline__ void mla_fin4(const LayerP& P, int lane, int tok0) {
    const int b = tok0 / SEQ, s0 = tok0 % SEQ;
    float cq[4][6], ckv[4][2], kpe[4], posf[4];
#pragma unroll
    for (int t = 0; t < 4; ++t) { const bf16_t* pr = P.proj + (size_t)(tok0 + t) * NP;
#pragma unroll
        for (int j = 0; j < 6; ++j) cq[t][j] = bf2f(pr[C_CQ + lane + 64 * j]);
        ckv[t][0] = bf2f(pr[C_CKV + lane]); ckv[t][1] = bf2f(pr[C_CKV + 64 + lane]); kpe[t] = bf2f(pr[C_KPE + lane]); posf[t] = (float)P.pos[tok0 + t]; }
    float rq[4], rk[4], cs[4], sn[4];
    const float inv_freq = __builtin_amdgcn_exp2f(-(float)(lane & 31) * (13.287712379549449f / 32.0f));
#pragma unroll
    for (int t = 0; t < 4; ++t) { float sq = 0.f;
#pragma unroll
        for (int j = 0; j < 6; ++j) sq += cq[t][j] * cq[t][j];
        rq[t] = sq; rk[t] = ckv[t][0] * ckv[t][0] + ckv[t][1] * ckv[t][1];
        const float rev = __builtin_amdgcn_fractf(posf[t] * inv_freq * 0.15915494309189535f); cs[t] = __builtin_amdgcn_cosf(rev); sn[t] = __builtin_amdgcn_sinf(rev); }
#pragma unroll
    for (int t = 0; t < 4; ++t) { rq[t] = frsq(wave_sum(rq[t]) * (1.0f / 384.f) + EPS); rk[t] = frsq(wave_sum(rk[t]) * (1.0f / 128.f) + EPS); }
    const float wq0 = P.qh_w[lane], wq1 = P.qh_w[64 + lane], wq2 = P.qh_w[128 + lane], wk0 = P.kh_w[lane], wk1 = P.kh_w[64 + lane], wk2 = P.kh_w[128 + lane];
#pragma unroll 1
    for (int h = 0; h < 4; ++h) {
        float q[4][3], k[4][2], v[4][2];
#pragma unroll
        for (int t = 0; t < 4; ++t) { const bf16_t* qr = P.qraw + (size_t)(tok0 + t) * 768 + h * 192 + lane; const bf16_t* kr = P.kvraw + (size_t)(tok0 + t) * 1024 + h * 256 + lane;
            q[t][0] = bf2f(qr[0]); q[t][1] = bf2f(qr[64]); q[t][2] = bf2f(qr[128]); k[t][0] = bf2f(kr[0]); k[t][1] = bf2f(kr[64]); v[t][0] = bf2f(kr[128]); v[t][1] = bf2f(kr[192]); }
        float nq[4], nk[4];
#pragma unroll
        for (int t = 0; t < 4; ++t) { q[t][0] *= rq[t]; q[t][1] *= rq[t]; q[t][2] *= rq[t]; k[t][0] *= rk[t]; k[t][1] *= rk[t];
            nq[t] = q[t][0] * q[t][0] + q[t][1] * q[t][1] + q[t][2] * q[t][2]; nk[t] = k[t][0] * k[t][0] + k[t][1] * k[t][1] + kpe[t] * kpe[t]; }
#pragma unroll
        for (int t = 0; t < 4; ++t) { nq[t] = frsq(wave_sum(nq[t]) * (1.0f / 192.f) + EPS); nk[t] = frsq(wave_sum(nk[t]) * (1.0f / 192.f) + EPS); }
#pragma unroll
        for (int t = 0; t < 4; ++t) { const size_t ob = ((size_t)(b * 4 + h) * SEQ + s0 + t) * 192;
            const float a0 = q[t][0] * nq[t] * wq0, a1 = q[t][1] * nq[t] * wq1, a2 = q[t][2] * nq[t] * wq2, oa = xor32_other(a2, lane);
            const float ra = (lane < 32) ? (a2 * cs[t] - oa * sn[t]) : (a2 * cs[t] + oa * sn[t]);
            bf16_t* qo = P.qf + ob; qo[lane] = (bf16_t)f2bf(a0); qo[64 + lane] = (bf16_t)f2bf(a1); qo[128 + lane] = (bf16_t)f2bf(ra);
            const float b0 = k[t][0] * nk[t] * wk0, b1 = k[t][1] * nk[t] * wk1, b2 = kpe[t] * nk[t] * wk2, ob2 = xor32_other(b2, lane);
            const float rb = (lane < 32) ? (b2 * cs[t] - ob2 * sn[t]) : (b2 * cs[t] + ob2 * sn[t]);
            bf16_t* ko = P.kf + ob; ko[lane] = (bf16_t)f2bf(b0); ko[64 + lane] = (bf16_t)f2bf(b1); ko[128 + lane] = (bf16_t)f2bf(rb); }
        bf16_t* vo = P.vt + (size_t)(b * 4 + h) * 128 * SEQ + (size_t)(s0 >> 6) * (128 * 64) + (s0 & 63);
        u32x2 w0, w1; w0.x = pk2(v[0][0] * rk[0], v[1][0] * rk[1]); w0.y = pk2(v[2][0] * rk[2], v[3][0] * rk[3]); w1.x = pk2(v[0][1] * rk[0], v[1][1] * rk[1]); w1.y = pk2(v[2][1] * rk[2], v[3][1] * rk[3]);
        *(u32x2*)(vo + (size_t)lane * 64) = w0; *(u32x2*)(vo + (size_t)(64 + lane) * 64) = w1;
    }
}

__device__ __forceinline__ void job_publish(unsigned* flag, int tid) {
    asm volatile("s_waitcnt vmcnt(0)" ::: "memory");
    __syncthreads();
    if (tid == 0) { __builtin_amdgcn_fence(__ATOMIC_RELEASE, "agent"); asm volatile("s_waitcnt vmcnt(0)" ::: "memory");
        (void)__hip_atomic_fetch_add(flag, 1u, __ATOMIC_RELAXED, __HIP_MEMORY_SCOPE_AGENT); }
}
__device__ __forceinline__ void job_wait(unsigned* flag, unsigned need, int tid) {
    if (tid == 0) { unsigned sp = 0;
        while (__hip_atomic_load(flag, __ATOMIC_RELAXED, __HIP_MEMORY_SCOPE_AGENT) < need) { __builtin_amdgcn_s_sleep(2); if (++sp > (1u << 24)) break; }
        __builtin_amdgcn_fence(__ATOMIC_ACQUIRE, "agent"); asm volatile("s_waitcnt vmcnt(0)" ::: "memory"); }
    __syncthreads();
}
__device__ __forceinline__ int queue_pop(unsigned* q, volatile LAS unsigned* slot, int tid) {
    if (tid == 0) slot[0] = __hip_atomic_fetch_add(q, 1u, __ATOMIC_RELAXED, __HIP_MEMORY_SCOPE_AGENT);
    __syncthreads(); const unsigned v = slot[0]; __syncthreads(); return __builtin_amdgcn_readfirstlane((int)v);
}
__device__ __forceinline__ u32x2 pk4(const f32x4& v) { u32x2 w; w.x = pk2(v.x, v.y); w.y = pk2(v.z, v.w); return w; }

constexpr int SA_XT = 0, SA_BT = 8 * 64 * 72 * 2, SA_AA = SA_BT + 2 * 64 * 72 * 2, SA_WW = SA_AA + 2048, SA_FLAG = SA_WW + 2048;
__device__ __forceinline__ bf16x8 scale_frag(bf16x8 v, const float (&w)[8]) {
    bf16x8 o;
#pragma unroll
    for (int j = 0; j < 8; j += 2) { const unsigned pk = pk2(bf2f((bf16_t)v[j]) * w[j], bf2f((bf16_t)v[j + 1]) * w[j + 1]); o[j] = (short)(pk & 0xffffu); o[j + 1] = (short)(pk >> 16); }
    return o;
}
__device__ __forceinline__ void ssd_passA(const LayerP& P, LAS unsigned char* lds, int item, int wave, int lane, bool arrive = true) {
    const int b = item >> 5, c = item & 31, tid = wave * 64 + lane, s0 = c * 64; const size_t tok0 = (size_t)b * SEQ + s0;
    LAS bf16_t* XT = (LAS bf16_t*)(lds + SA_XT); LAS bf16_t* BT = (LAS bf16_t*)(lds + SA_BT); LAS float* AA = (LAS float*)(lds + SA_AA); LAS float* WW = (LAS float*)(lds + SA_WW);
    volatile LAS unsigned* FLG = (volatile LAS unsigned*)(lds + SA_FLAG);
    if (tid < 384) {
        const int cc = tid % 96, seg = tid / 96, ch0 = cc * 8, t0 = seg * 16;
        u32x4 raw[19];
#pragma unroll
        for (int i = 0; i < 19; ++i) { const int row = t0 - 3 + i;
            raw[i] = (s0 + row >= 0) ? *(const u32x4*)(P.proj + (size_t)((long)tok0 + row) * NP + C_XBC + ch0) : (u32x4){0u, 0u, 0u, 0u}; }
        float w[4][8], bb[8];
#pragma unroll
        for (int k = 0; k < 4; ++k) { const f32x4 a = *(const f32x4*)(P.conv_w + k * 768 + ch0), b2 = *(const f32x4*)(P.conv_w + k * 768 + ch0 + 4);
            w[k][0] = a.x; w[k][1] = a.y; w[k][2] = a.z; w[k][3] = a.w; w[k][4] = b2.x; w[k][5] = b2.y; w[k][6] = b2.z; w[k][7] = b2.w; }
        { const f32x4 a = *(const f32x4*)(P.conv_b + ch0), b2 = *(const f32x4*)(P.conv_b + ch0 + 4); bb[0] = a.x; bb[1] = a.y; bb[2] = a.z; bb[3] = a.w; bb[4] = b2.x; bb[5] = b2.y; bb[6] = b2.z; bb[7] = b2.w; }
        LAS bf16_t* TT = (ch0 < 512) ? (XT + ch0 * 72) : (BT + (ch0 - 512) * 72);
#pragma unroll
        for (int t = 0; t < 16; ++t) {
            float o[8];
#pragma unroll
            for (int c = 0; c < 8; ++c) { float a = bb[c];
#pragma unroll
                for (int k = 0; k < 4; ++k) { const unsigned wd = raw[t + k][c >> 1]; const float x = (c & 1) ? __uint_as_float(wd & 0xffff0000u) : __uint_as_float(wd << 16); a += w[k][c] * x; }
                o[c] = siluf_(a); }
            u32x4 pk; pk.x = pk2(o[0], o[1]); pk.y = pk2(o[2], o[3]); pk.z = pk2(o[4], o[5]); pk.w = pk2(o[6], o[7]);
            *(u32x4*)(P.xbcn + (tok0 + t0 + t) * 768 + ch0) = pk;
            if (ch0 < 640) {
#pragma unroll
                for (int c = 0; c < 8; ++c) TT[c * 72 + t0 + t] = (bf16_t)((c & 1) ? (pk[c >> 1] >> 16) : (pk[c >> 1] & 0xffffu)); }
        }
    }
    {
        const int h = wave; const float A = -fexp(P.a_log[h]);
        const float dt = softplusf_(P.dtf[(tok0 + lane) * 8 + h] + P.dt_bias[h]);
        AA[h * 64 + lane] = dt * A;
        asm volatile("s_waitcnt lgkmcnt(0)" ::: "memory");
        float cs = 0.f;
        for (int s = 0; s < 64; ++s) { const float av = AA[h * 64 + s]; cs += (s <= lane) ? av : 0.f; }
        const float cend = __int_as_float(__builtin_amdgcn_readlane(__float_as_int(cs), 63));
        P.dtv[(tok0 + lane) * 8 + h] = dt; P.csv[(tok0 + lane) * 8 + h] = cs;
        WW[h * 64 + lane] = fexp(cend - cs) * dt;
        if (lane == 63) P.cse[(size_t)(b * 32 + c) * 8 + h] = cs;
    }
    __syncthreads();
#pragma unroll
    for (int k = 0; k < 8; ++k) { const int ci = tid + 512 * k, row = ci >> 3, cc = ci & 7;
        const u32x4 v = *(const LAS u32x4*)(XT + row * 72 + cc * 8);
        *(u32x4*)(P.xT + ((size_t)(b * 8 + (row >> 6)) * 64 + (row & 63)) * SEQ + s0 + cc * 8) = v; }
    {
        const int h = wave, g = h >> 2, fr = lane & 15, fq = lane >> 4;
        f32x4 acc[4][4];
#pragma unroll
        for (int i = 0; i < 4; ++i)
#pragma unroll
            for (int j = 0; j < 4; ++j) acc[i][j] = (f32x4){0.f, 0.f, 0.f, 0.f};
#pragma unroll
        for (int ks = 0; ks < 2; ++ks) {
            float wv[8];
#pragma unroll
            for (int j = 0; j < 8; ++j) wv[j] = WW[h * 64 + ks * 32 + fq * 8 + j];
            bf16x8 bfr[4];
#pragma unroll
            for (int nt = 0; nt < 4; ++nt) bfr[nt] = *(const LAS bf16x8*)(BT + (g * 64 + nt * 16 + fr) * 72 + ks * 32 + fq * 8);
#pragma unroll
            for (int pt = 0; pt < 4; ++pt) { const bf16x8 af = scale_frag(*(const LAS bf16x8*)(XT + (h * 64 + pt * 16 + fr) * 72 + ks * 32 + fq * 8), wv);
#pragma unroll
                for (int nt = 0; nt < 4; ++nt) acc[pt][nt] = __builtin_amdgcn_mfma_f32_16x16x32_bf16(af, bfr[nt], acc[pt][nt], 0, 0, 0); }
        }
        float* so = P.sst + ((size_t)(b * 32 + c) * 8 + h) * 4096;
#pragma unroll
        for (int pt = 0; pt < 4; ++pt)
#pragma unroll
            for (int nt = 0; nt < 4; ++nt)
#pragma unroll
                for (int r = 0; r < 4; ++r) so[(pt * 16 + fq * 4 + r) * 64 + nt * 16 + fr] = acc[pt][nt][r];
    }
    job_publish(P.cnt_ssd + 64 * (item >> 5), wave * 64 + lane);
}
constexpr int SB_M = 0, SB_RS = 8 * 64 * 72 * 2;
__device__ __forceinline__ void ssd_passB(const LayerP& P, LAS unsigned char* lds, int item, int wave, int lane) {
    const int b = item >> 5, c = item & 31, s0 = c * 64, h = wave, g = h >> 2, fr = lane & 15, fq = lane >> 4; const size_t tok0 = (size_t)b * SEQ + s0;
    LAS bf16_t* Mw = (LAS bf16_t*)(lds + SB_M) + wave * 64 * 72; LAS float* RS = (LAS float*)(lds + SB_RS);
    bf16x8 cfr[4][2], bfr[4][2];
#pragma unroll
    for (int t = 0; t < 4; ++t)
#pragma unroll
        for (int ks = 0; ks < 2; ++ks) {
            cfr[t][ks] = *(const bf16x8*)(P.xbcn + (tok0 + t * 16 + fr) * 768 + 640 + g * 64 + ks * 32 + fq * 8);
            bfr[t][ks] = *(const bf16x8*)(P.xbcn + (tok0 + t * 16 + fr) * 768 + 512 + g * 64 + ks * 32 + fq * 8); }
    float cst[4][4], css[4], dts[4];
#pragma unroll
    for (int tt = 0; tt < 4; ++tt)
#pragma unroll
        for (int r = 0; r < 4; ++r) cst[tt][r] = P.csv[(tok0 + tt * 16 + fq * 4 + r) * 8 + h];
#pragma unroll
    for (int st = 0; st < 4; ++st) { css[st] = P.csv[(tok0 + st * 16 + fr) * 8 + h]; dts[st] = P.dtv[(tok0 + st * 16 + fr) * 8 + h]; }
#pragma unroll
    for (int tt = 0; tt < 4; ++tt)
#pragma unroll
        for (int st = 0; st < 4; ++st) {
            f32x4 G = (f32x4){0.f, 0.f, 0.f, 0.f};
            if (st <= tt) {
#pragma unroll
                for (int ks = 0; ks < 2; ++ks) G = __builtin_amdgcn_mfma_f32_16x16x32_bf16(cfr[tt][ks], bfr[st][ks], G, 0, 0, 0);
            }
#pragma unroll
            for (int r = 0; r < 4; ++r) { const int t = tt * 16 + fq * 4 + r, s = st * 16 + fr;
                const float v = (st <= tt && s <= t) ? G[r] * fexp(cst[tt][r] - css[st]) * dts[st] : 0.f;
                Mw[t * 72 + s] = (bf16_t)f2bf(v); }
        }
    u32x4 xc[8], zc[8];
#pragma unroll
    for (int k = 0; k < 8; ++k) { const size_t tok = tok0 + (lane >> 3) + 8 * k; xc[k] = *(const u32x4*)(P.xbcn + tok * 768 + h * 64 + (lane & 7) * 8); zc[k] = *(const u32x4*)(P.proj + tok * NP + C_Z + h * 64 + (lane & 7) * 8); }
    f32x4 Y[4][4];
    {
        const bf16_t* hb = P.hin + ((size_t)(b * 32 + c) * 8 + h) * 4096;
        bf16x8 hfr[4][2];
#pragma unroll
        for (int pt = 0; pt < 4; ++pt)
#pragma unroll
            for (int ks = 0; ks < 2; ++ks) hfr[pt][ks] = *(const bf16x8*)(hb + (pt * 16 + fr) * 64 + ks * 32 + fq * 8);
#pragma unroll
        for (int tt = 0; tt < 4; ++tt)
#pragma unroll
            for (int pt = 0; pt < 4; ++pt) { f32x4 a = (f32x4){0.f, 0.f, 0.f, 0.f};
#pragma unroll
                for (int ks = 0; ks < 2; ++ks) a = __builtin_amdgcn_mfma_f32_16x16x32_bf16(cfr[tt][ks], hfr[pt][ks], a, 0, 0, 0);
#pragma unroll
                for (int r = 0; r < 4; ++r) a[r] *= fexp(cst[tt][r]);
                Y[tt][pt] = a; }
    }
    {
        bf16x8 xfr[4][2];
#pragma unroll
        for (int pt = 0; pt < 4; ++pt)
#pragma unroll
            for (int ks = 0; ks < 2; ++ks) xfr[pt][ks] = *(const bf16x8*)(P.xT + ((size_t)(b * 8 + h) * 64 + pt * 16 + fr) * SEQ + s0 + ks * 32 + fq * 8);
        asm volatile("s_waitcnt lgkmcnt(0)" ::: "memory");
#pragma unroll
        for (int tt = 0; tt < 4; ++tt)
#pragma unroll
            for (int ks = 0; ks < 2; ++ks) { if (ks * 32 > tt * 16 + 15) continue;
                const bf16x8 af = *(const LAS bf16x8*)(Mw + (tt * 16 + fr) * 72 + ks * 32 + fq * 8);
#pragma unroll
                for (int pt = 0; pt < 4; ++pt) Y[tt][pt] = __builtin_amdgcn_mfma_f32_16x16x32_bf16(af, xfr[pt][ks], Y[tt][pt], 0, 0, 0); }
    }
#pragma unroll
    for (int tt = 0; tt < 4; ++tt)
#pragma unroll
        for (int pt = 0; pt < 4; ++pt)
#pragma unroll
            for (int r = 0; r < 4; ++r) Mw[(tt * 16 + fq * 4 + r) * 72 + pt * 16 + fr] = (bf16_t)f2bf(Y[tt][pt][r]);
    asm volatile("s_waitcnt lgkmcnt(0)" ::: "memory");
    const float Dh = P.ssd_d[h];
    const int ck = lane & 7, tq = lane >> 3;
    float nw[8];
    { const f32x4 a = *(const f32x4*)(P.ssd_norm_w + h * 64 + ck * 8), b2 = *(const f32x4*)(P.ssd_norm_w + h * 64 + ck * 8 + 4); nw[0] = a.x; nw[1] = a.y; nw[2] = a.z; nw[3] = a.w; nw[4] = b2.x; nw[5] = b2.y; nw[6] = b2.z; nw[7] = b2.w; }
    float v[8][8];
#pragma unroll
    for (int k = 0; k < 8; ++k) { const int t = tq + 8 * k; const u32x4 yv = *(const LAS u32x4*)(Mw + t * 72 + ck * 8); float q = 0.f;
#pragma unroll
        for (int jj = 0; jj < 8; ++jj) { const unsigned yw = yv[jj >> 1], xw = xc[k][jj >> 1], zw = zc[k][jj >> 1];
            const float y = (jj & 1) ? __uint_as_float(yw & 0xffff0000u) : __uint_as_float(yw << 16), x = (jj & 1) ? __uint_as_float(xw & 0xffff0000u) : __uint_as_float(xw << 16), z = (jj & 1) ? __uint_as_float(zw & 0xffff0000u) : __uint_as_float(zw << 16);
            const float vv = (y + Dh * x) * siluf_(z); v[k][jj] = vv; q += vv * vv; }
        q += swz_xor<1>(q); q += swz_xor<2>(q); q += swz_xor<4>(q);
        if (ck == 0) RS[h * 64 + t] = q; }
    __syncthreads();
#pragma unroll
    for (int k = 0; k < 8; ++k) { const int t = tq + 8 * k; float tot = 0.f;
#pragma unroll
        for (int hh = 0; hh < 8; ++hh) tot += RS[hh * 64 + t];
        const float rn = frsq(tot * (1.0f / 512.f) + EPS);
        u32x4 w; w.x = pk2(v[k][0] * rn * nw[0], v[k][1] * rn * nw[1]); w.y = pk2(v[k][2] * rn * nw[2], v[k][3] * rn * nw[3]); w.z = pk2(v[k][4] * rn * nw[4], v[k][5] * rn * nw[5]); w.w = pk2(v[k][6] * rn * nw[6], v[k][7] * rn * nw[7]);
        *(u32x4*)(P.mix + (tok0 + t) * DM + h * 64 + ck * 8) = w; }
    __syncthreads();
}

constexpr int GA_KH = 0, GA_VT = 256 * 72 * 2, GA_HT = GA_VT + 512 * 72 * 2, GA_FLAG = GA_HT + 2048, GA_GL = GA_FLAG + 64;
__device__ __forceinline__ float logsig16(float x) { return (fminf(x, 0.f) - log1p_small(fexp(-fabsf(x)))) * (1.0f / 16.0f); }
__device__ __forceinline__ void gla_passA(const LayerP& P, LAS unsigned char* lds, int item, int wave, int lane, bool arrive = true) {
    const int b = item >> 5, c = item & 31, tid = wave * 64 + lane, s0 = c * 64; const size_t tok0 = (size_t)b * SEQ + s0;
    LAS bf16_t* KH = (LAS bf16_t*)(lds + GA_KH); LAS bf16_t* VT = (LAS bf16_t*)(lds + GA_VT); LAS float* HT = (LAS float*)(lds + GA_HT);
    volatile LAS unsigned* FLG = (volatile LAS unsigned*)(lds + GA_FLAG);
    const int j = tid & 255, half = tid >> 8;
    LAS bf16_t* QS = (LAS bf16_t*)(lds + GA_VT); LAS bf16_t* KS = QS + 64 * 256; LAS bf16_t* GL = (LAS bf16_t*)(lds + GA_GL);
    u32x4 vreg[8], qreg[4], kreg[4], greg = (u32x4){0u, 0u, 0u, 0u};
#pragma unroll
    for (int k = 0; k < 8; ++k) { const int ci = tid + 512 * k; vreg[k] = *(const u32x4*)(P.proj + (tok0 + (ci >> 6)) * NP + C_GV + (ci & 63) * 8); }
#pragma unroll
    for (int k = 0; k < 4; ++k) { const int ci = tid + 512 * k; qreg[k] = *(const u32x4*)(P.proj + (tok0 + (ci >> 5)) * NP + C_GQ + (ci & 31) * 8); kreg[k] = *(const u32x4*)(P.proj + (tok0 + (ci >> 5)) * NP + C_GK + (ci & 31) * 8); }
    if (tid < 128) greg = *(const u32x4*)(P.proj + (tok0 + (tid >> 1)) * NP + C_GLR + (tid & 1) * 8);
    float w2[16];
#pragma unroll
    for (int r = 0; r < 16; ++r) w2[r] = P.gla_w2[r * 256 + j];
    const float gb = P.gla_gb[j];
#pragma unroll
    for (int k = 0; k < 4; ++k) { const int ci = tid + 512 * k; *(LAS u32x4*)(QS + (ci >> 5) * 256 + (ci & 31) * 8) = qreg[k]; *(LAS u32x4*)(KS + (ci >> 5) * 256 + (ci & 31) * 8) = kreg[k]; }
    if (tid < 128) *(LAS u32x4*)(GL + (tid >> 1) * 16 + (tid & 1) * 8) = greg;
    __syncthreads();
    float gl[32]; float run = 0.f;
#pragma unroll
    for (int i = 0; i < 32; ++i) { const int t = half * 32 + i; const u32x4 g0 = *(const LAS u32x4*)(GL + t * 16), g1 = *(const LAS u32x4*)(GL + t * 16 + 8);
        float x = gb;
#pragma unroll
        for (int r = 0; r < 8; ++r) { const unsigned wlo = g0[r >> 1], whi = g1[r >> 1];
            x += ((r & 1) ? __uint_as_float(wlo & 0xffff0000u) : __uint_as_float(wlo << 16)) * w2[r] + ((r & 1) ? __uint_as_float(whi & 0xffff0000u) : __uint_as_float(whi << 16)) * w2[8 + r]; }
        gl[i] = logsig16(x); run += gl[i]; }
    HT[half * 256 + j] = run;
    __syncthreads();
    const float off = half ? HT[j] : 0.f, blast = HT[j] + HT[256 + j];
    if (half == 0) P.glb[(size_t)(b * 32 + c) * 256 + j] = blast;
    run = off;
#pragma unroll
    for (int i = 0; i < 32; ++i) { const int t = half * 32 + i; const size_t tok = tok0 + t;
        run += gl[i];
        const float q = bf2f(QS[t * 256 + j]), k = bf2f(KS[t * 256 + j]);
        P.qt[tok * 256 + j] = (bf16_t)f2bf(q * 0.125f * fexp(run));
        P.kt[tok * 256 + j] = (bf16_t)f2bf(k * fexp(-run));
        KH[j * 72 + t] = (bf16_t)f2bf(k * fexp(blast - run)); }
    __syncthreads();
#pragma unroll
    for (int k = 0; k < 8; ++k) { const int ci = tid + 512 * k, t = ci >> 6, e0 = (ci & 63) * 8;
#pragma unroll
        for (int cI = 0; cI < 8; ++cI) VT[(e0 + cI) * 72 + t] = (bf16_t)((cI & 1) ? (vreg[k][cI >> 1] >> 16) : (vreg[k][cI >> 1] & 0xffffu)); }
    __syncthreads();
#pragma unroll
    for (int k = 0; k < 8; ++k) { const int ci = tid + 512 * k, row = ci >> 3, cc = ci & 7;
        const u32x4 v = *(const LAS u32x4*)(VT + row * 72 + cc * 8);
        *(u32x4*)(P.vT2 + ((size_t)(b * 4 + (row >> 7)) * 128 + (row & 127)) * SEQ + s0 + cc * 8) = v; }
    {
        const int h = wave >> 1, eh = wave & 1, fr = lane & 15, fq = lane >> 4;
        f32x4 acc[4][4];
#pragma unroll
        for (int i = 0; i < 4; ++i)
#pragma unroll
            for (int jj = 0; jj < 4; ++jj) acc[i][jj] = (f32x4){0.f, 0.f, 0.f, 0.f};
#pragma unroll
        for (int ks = 0; ks < 2; ++ks) {
            bf16x8 kf[4];
#pragma unroll
            for (int dt = 0; dt < 4; ++dt) kf[dt] = *(const LAS bf16x8*)(KH + (h * 64 + dt * 16 + fr) * 72 + ks * 32 + fq * 8);
#pragma unroll
            for (int et = 0; et < 4; ++et) { const bf16x8 vf = *(const LAS bf16x8*)(VT + (h * 128 + eh * 64 + et * 16 + fr) * 72 + ks * 32 + fq * 8);
#pragma unroll
                for (int dt = 0; dt < 4; ++dt) acc[et][dt] = __builtin_amdgcn_mfma_f32_16x16x32_bf16(vf, kf[dt], acc[et][dt], 0, 0, 0); }
        }
        float* so = P.gst + ((size_t)(b * 32 + c) * 4 + h) * 8192 + eh * 4096;
#pragma unroll
        for (int et = 0; et < 4; ++et)
#pragma unroll
            for (int dt = 0; dt < 4; ++dt)
#pragma unroll
                for (int r = 0; r < 4; ++r) so[(et * 16 + fq * 4 + r) * 64 + dt * 16 + fr] = acc[et][dt][r];
    }
    job_publish(P.cnt_gla + 64 * (item >> 5), wave * 64 + lane);
}
__device__ __forceinline__ void gla_passB(const LayerP& P, LAS unsigned char* lds, int item, int wave, int lane) {
    const int b = item >> 5, c = item & 31, s0 = c * 64, h = wave >> 1, half = wave & 1, fr = lane & 15, fq = lane >> 4; const size_t tok0 = (size_t)b * SEQ + s0;
    LAS bf16_t* Pw = (LAS bf16_t*)lds + wave * 32 * 72;
    bf16x8 qfr[2][2];
#pragma unroll
    for (int tt = 0; tt < 2; ++tt)
#pragma unroll
        for (int ks = 0; ks < 2; ++ks) qfr[tt][ks] = *(const bf16x8*)(P.qt + (tok0 + (half * 2 + tt) * 16 + fr) * 256 + h * 64 + ks * 32 + fq * 8);
    {
        bf16x8 kfr[4][2];
#pragma unroll
        for (int st = 0; st < 4; ++st)
#pragma unroll
            for (int ks = 0; ks < 2; ++ks) kfr[st][ks] = *(const bf16x8*)(P.kt + (tok0 + st * 16 + fr) * 256 + h * 64 + ks * 32 + fq * 8);
#pragma unroll
        for (int tt = 0; tt < 2; ++tt)
#pragma unroll
            for (int st = 0; st < 4; ++st) { const int tg = half * 2 + tt;
                f32x4 G = (f32x4){0.f, 0.f, 0.f, 0.f};
                if (st <= tg) {
#pragma unroll
                    for (int ks = 0; ks < 2; ++ks) G = __builtin_amdgcn_mfma_f32_16x16x32_bf16(qfr[tt][ks], kfr[st][ks], G, 0, 0, 0);
                }
#pragma unroll
                for (int r = 0; r < 4; ++r) { const float v = (st < tg || (st == tg && fr <= fq * 4 + r)) ? G[r] : 0.f;
                    Pw[(tt * 16 + fq * 4 + r) * 72 + st * 16 + fr] = (bf16_t)f2bf(v); } }
    }
    u32x4 gc[8];
#pragma unroll
    for (int k = 0; k < 8; ++k) gc[k] = *(const u32x4*)(P.proj + (tok0 + half * 32 + (lane >> 4) + 4 * k) * NP + C_GG + h * 128 + (lane & 15) * 8);
    f32x4 O[2][8];
    {
        const bf16_t* gb = P.gin + ((size_t)(b * 32 + c) * 4 + h) * 8192;
#pragma unroll
        for (int et = 0; et < 8; ++et) { const bf16x8 g0 = *(const bf16x8*)(gb + (et * 16 + fr) * 64 + fq * 8), g1 = *(const bf16x8*)(gb + (et * 16 + fr) * 64 + 32 + fq * 8);
#pragma unroll
            for (int tt = 0; tt < 2; ++tt) { f32x4 a = (f32x4){0.f, 0.f, 0.f, 0.f};
                a = __builtin_amdgcn_mfma_f32_16x16x32_bf16(qfr[tt][0], g0, a, 0, 0, 0); a = __builtin_amdgcn_mfma_f32_16x16x32_bf16(qfr[tt][1], g1, a, 0, 0, 0); O[tt][et] = a; } }
    }
    asm volatile("s_waitcnt lgkmcnt(0)" ::: "memory");
#pragma unroll
    for (int ks = 0; ks < 2; ++ks) { if (ks * 32 > (half * 2 + 1) * 16 + 15) continue;
        bf16x8 pf[2];
#pragma unroll
        for (int tt = 0; tt < 2; ++tt) pf[tt] = *(const LAS bf16x8*)(Pw + (tt * 16 + fr) * 72 + ks * 32 + fq * 8);
#pragma unroll
        for (int et = 0; et < 8; ++et) { const bf16x8 vf = *(const bf16x8*)(P.vT2 + ((size_t)(b * 4 + h) * 128 + et * 16 + fr) * SEQ + s0 + ks * 32 + fq * 8);
#pragma unroll
            for (int tt = 0; tt < 2; ++tt) O[tt][et] = __builtin_amdgcn_mfma_f32_16x16x32_bf16(pf[tt], vf, O[tt][et], 0, 0, 0); } }
    LAS bf16_t* OT = (LAS bf16_t*)(lds + 8 * 32 * 72 * 2) + wave * 32 * 136;
#pragma unroll
    for (int tt = 0; tt < 2; ++tt)
#pragma unroll
        for (int r = 0; r < 4; ++r) { float q = 0.f;
#pragma unroll
            for (int et = 0; et < 8; ++et) q += O[tt][et][r] * O[tt][et][r];
            q = xsum16(q); const float rn = frsq(q * (1.0f / 128.f) + EPS);
#pragma unroll
            for (int et = 0; et < 8; ++et) OT[(tt * 16 + fq * 4 + r) * 136 + et * 16 + fr] = (bf16_t)f2bf(O[tt][et][r] * rn); }
    asm volatile("s_waitcnt lgkmcnt(0)" ::: "memory");
    {
        const int ck = lane & 15, tq = lane >> 4;
        float nw[8];
        { const f32x4 a = *(const f32x4*)(P.gla_norm_w + ck * 8), b2 = *(const f32x4*)(P.gla_norm_w + ck * 8 + 4); nw[0] = a.x; nw[1] = a.y; nw[2] = a.z; nw[3] = a.w; nw[4] = b2.x; nw[5] = b2.y; nw[6] = b2.z; nw[7] = b2.w; }
#pragma unroll
        for (int k = 0; k < 8; ++k) { const int t = tq + 4 * k; const u32x4 yv = *(const LAS u32x4*)(OT + t * 136 + ck * 8); float o8[8];
#pragma unroll
            for (int jj = 0; jj < 8; ++jj) { const unsigned yw = yv[jj >> 1], gw = gc[k][jj >> 1];
                const float y = (jj & 1) ? __uint_as_float(yw & 0xffff0000u) : __uint_as_float(yw << 16), g = (jj & 1) ? __uint_as_float(gw & 0xffff0000u) : __uint_as_float(gw << 16);
                o8[jj] = y * nw[jj] * siluf_(g); }
            u32x4 w; w.x = pk2(o8[0], o8[1]); w.y = pk2(o8[2], o8[3]); w.z = pk2(o8[4], o8[5]); w.w = pk2(o8[6], o8[7]);
            *(u32x4*)(P.mix + (tok0 + half * 32 + t) * DM + 1024 + h * 128 + ck * 8) = w; }
    }
    __syncthreads();
}

constexpr int S5W_BYTES = 16 * 132 * 4 + 16 * 136 * 2, S5_FLAG = 8 * S5W_BYTES;
struct S5G { bf16x8 bb[8]; bf16x8 ua[4]; bf16x8 cb[4]; float ar, ai, hr, hi, dsk; };
template <bool PB> __device__ __forceinline__ void s5_load_group(const LayerP& P, int b, int c, size_t tok0, int g, int lane, S5G& G) {
    const int fr = lane & 15, fq = lane >> 4;
    G.ar = P.abar[(g * 64 + lane) * 2]; G.ai = P.abar[(g * 64 + lane) * 2 + 1];
#pragma unroll
    for (int nt = 0; nt < 8; ++nt) G.bb[nt] = *(const bf16x8*)(P.bmp + ((size_t)(g * 128 + nt * 16 + fr)) * 32 + fq * 8);
#pragma unroll
    for (int sb = 0; sb < 4; ++sb) { G.ua[sb] = (bf16x8){0, 0, 0, 0, 0, 0, 0, 0}; if (fq < 2) G.ua[sb] = *(const bf16x8*)(P.proj + (tok0 + sb * 16 + fr) * NP + C_S5U + g * 16 + fq * 8); }
    if (PB) {
#pragma unroll
        for (int ks = 0; ks < 4; ++ks) G.cb[ks] = *(const bf16x8*)(P.cmp + (size_t)(g * 16 + fr) * 128 + ks * 32 + fq * 8);
        const size_t so = ((size_t)(b * 32 + c) * 32 + g) * 128; G.hr = P.s5in[so + lane]; G.hi = P.s5in[so + 64 + lane]; G.dsk = P.s5_d[g * 16 + fr];
    } else { G.hr = 0.f; G.hi = 0.f; G.dsk = 0.f; }
}
template <bool PB> __device__ __forceinline__ void s5_run_group(const LayerP& P, int b, int c, size_t tok0, int g, int lane, const S5G& G, LAS float* BU, LAS bf16_t* Hm) {
    const int fr = lane & 15, fq = lane >> 4;
    float hr = G.hr, hi = G.hi;
#pragma unroll
    for (int sb = 0; sb < 4; ++sb) {
#pragma unroll
        for (int nt = 0; nt < 8; ++nt) { const f32x4 a = __builtin_amdgcn_mfma_f32_16x16x32_bf16(G.ua[sb], G.bb[nt], (f32x4){0.f, 0.f, 0.f, 0.f}, 0, 0, 0);
#pragma unroll
            for (int r = 0; r < 4; ++r) BU[(fq * 4 + r) * 132 + nt * 16 + fr] = a[r]; }
        asm volatile("s_waitcnt lgkmcnt(0)" ::: "memory");
        float ur[16], ui[16];
#pragma unroll
        for (int t = 0; t < 16; ++t) { ur[t] = BU[t * 132 + lane]; ui[t] = BU[t * 132 + 64 + lane]; }
#pragma unroll
        for (int t = 0; t < 16; ++t) { const float nr = G.ar * hr - G.ai * hi + ur[t], ni = G.ar * hi + G.ai * hr + ui[t]; hr = nr; hi = ni;
            if (PB) { Hm[t * 136 + lane] = (bf16_t)f2bf(hr); Hm[t * 136 + 64 + lane] = (bf16_t)f2bf(hi); } }
        asm volatile("s_waitcnt lgkmcnt(0)" ::: "memory");
        if (PB) {
            f32x4 acc = (f32x4){0.f, 0.f, 0.f, 0.f};
#pragma unroll
            for (int ks = 0; ks < 4; ++ks) { const bf16x8 af = *(const LAS bf16x8*)(Hm + fr * 136 + ks * 32 + fq * 8); acc = __builtin_amdgcn_mfma_f32_16x16x32_bf16(af, G.cb[ks], acc, 0, 0, 0); }
            if (fq < 2) {
#pragma unroll
                for (int jj = 0; jj < 8; ++jj) BU[fr * 132 + fq * 8 + jj] = bf2f((bf16_t)G.ua[sb][jj]); }
            asm volatile("s_waitcnt lgkmcnt(0)" ::: "memory");
#pragma unroll
            for (int r = 0; r < 4; ++r) { const size_t tok = tok0 + sb * 16 + fq * 4 + r;
                const float y = acc[r] + G.dsk * BU[(fq * 4 + r) * 132 + fr];
                P.yg[tok * 512 + g * 16 + fr] = (bf16_t)f2bf(gelu_tanh(y)); }
            asm volatile("s_waitcnt lgkmcnt(0)" ::: "memory");
        }
    }
    if (!PB) { float* so = P.s5st + ((size_t)(b * 32 + c) * 32 + g) * 128; so[lane] = hr; so[64 + lane] = hi; }
}
template <bool PB> __device__ __forceinline__ void s5_pass(const LayerP& P, LAS unsigned char* lds, int item, int wave, int lane) {
    const int b = item >> 5, c = item & 31; const size_t tok0 = (size_t)b * SEQ + c * 64;
    LAS float* BU = (LAS float*)(lds + wave * S5W_BYTES); LAS bf16_t* Hm = (LAS bf16_t*)(lds + wave * S5W_BYTES + 16 * 132 * 4);
    S5G A, B;
    s5_load_group<PB>(P, b, c, tok0, wave * 4 + 0, lane, A);
    s5_load_group<PB>(P, b, c, tok0, wave * 4 + 1, lane, B); s5_run_group<PB>(P, b, c, tok0, wave * 4 + 0, lane, A, BU, Hm);
    s5_load_group<PB>(P, b, c, tok0, wave * 4 + 2, lane, A); s5_run_group<PB>(P, b, c, tok0, wave * 4 + 1, lane, B, BU, Hm);
    s5_load_group<PB>(P, b, c, tok0, wave * 4 + 3, lane, B); s5_run_group<PB>(P, b, c, tok0, wave * 4 + 2, lane, A, BU, Hm);
    s5_run_group<PB>(P, b, c, tok0, wave * 4 + 3, lane, B, BU, Hm);
    if (!PB) job_publish(P.cnt_s5 + 64 * b, wave * 64 + lane);
    else job_publish(P.cnt_s5b + 64 * (b * 8 + (c >> 2)), wave * 64 + lane);
}
__device__ __forceinline__ void s5_passA(const LayerP& P, LAS unsigned char* lds, int item, int wave, int lane) { s5_pass<false>(P, lds, item, wave, lane); }
__device__ __forceinline__ void s5_passB(const LayerP& P, LAS unsigned char* lds, int item, int wave, int lane) { s5_pass<true>(P, lds, item, wave, lane); }

__device__ __forceinline__ void ssd_prefix_job(const LayerP& P, int job, int tid) {
    const int b = job >> 4, h = (job >> 1) & 7, hf = job & 1;
    job_wait(P.cnt_ssd + 64 * b, 32u, tid);
    f32x4 H = (f32x4){0.f, 0.f, 0.f, 0.f};
#pragma unroll 1
    for (int q = 0; q < 2; ++q) {
        f32x4 S[16]; float dec[16];
#pragma unroll
        for (int i = 0; i < 16; ++i) { const int c2 = q * 16 + i; const size_t base = ((size_t)(b * 32 + c2) * 8 + h) * 4096 + hf * 2048;
            S[i] = *(const f32x4*)(P.sst + base + tid * 4); dec[i] = P.cse[(size_t)(b * 32 + c2) * 8 + h]; }
#pragma unroll
        for (int i = 0; i < 16; ++i) { const int c2 = q * 16 + i; const size_t base = ((size_t)(b * 32 + c2) * 8 + h) * 4096 + hf * 2048;
            *(u32x2*)(P.hin + base + tid * 4) = pk4(H); H = H * fexp(dec[i]) + S[i]; }
    }
}
__device__ __forceinline__ void gla_prefix_job(const LayerP& P, int job, int tid) {
    const int b = job >> 4, h = (job >> 2) & 3, eh = (job >> 1) & 1, hf = job & 1;
    job_wait(P.cnt_gla + 64 * b, 32u, tid);
    f32x4 H = (f32x4){0.f, 0.f, 0.f, 0.f};
#pragma unroll 1
    for (int q = 0; q < 4; ++q) {
        f32x4 S[8], dc[8];
#pragma unroll
        for (int i = 0; i < 8; ++i) { const int c2 = q * 8 + i; const size_t base = ((size_t)(b * 32 + c2) * 4 + h) * 8192 + eh * 4096 + hf * 2048;
            S[i] = *(const f32x4*)(P.gst + base + tid * 4); dc[i] = *(const f32x4*)(P.glb + (size_t)(b * 32 + c2) * 256 + h * 64 + (tid & 15) * 4); }
#pragma unroll
        for (int i = 0; i < 8; ++i) { const int c2 = q * 8 + i; const size_t base = ((size_t)(b * 32 + c2) * 4 + h) * 8192 + eh * 4096 + hf * 2048;
            *(u32x2*)(P.gin + base + tid * 4) = pk4(H);
            const f32x4 d = (f32x4){fexp(dc[i].x), fexp(dc[i].y), fexp(dc[i].z), fexp(dc[i].w)}; H = H * d + S[i]; }
    }
}
__device__ __forceinline__ void s5_prefix_job(const LayerP& P, int job, int tid) {
    const int b = job >> 1, g = (job & 1) * 16 + (tid >> 5), n2 = (tid & 31) * 2;
    job_wait(P.cnt_s5 + 64 * b, 32u, tid);
    const f32x4 a = *(const f32x4*)(P.abar64 + (size_t)(g * 64 + n2) * 2);
    const f32x2v ar = (f32x2v){a.x, a.z}, ai = (f32x2v){a.y, a.w};
    f32x2v Hr = (f32x2v){0.f, 0.f}, Hi = Hr;
#pragma unroll 1
    for (int q = 0; q < 2; ++q) {
        f32x2v Sr[16], Si[16];
#pragma unroll
        for (int i = 0; i < 16; ++i) { const size_t o = ((size_t)(b * 32 + q * 16 + i) * 32 + g) * 128 + n2; Sr[i] = *(const f32x2v*)(P.s5st + o); Si[i] = *(const f32x2v*)(P.s5st + o + 64); }
#pragma unroll
        for (int i = 0; i < 16; ++i) { const size_t o = ((size_t)(b * 32 + q * 16 + i) * 32 + g) * 128 + n2;
            *(f32x2v*)(P.s5in + o) = Hr; *(f32x2v*)(P.s5in + o + 64) = Hi;
            const f32x2v nr = ar * Hr - ai * Hi + Sr[i], ni = ar * Hi + ai * Hr + Si[i]; Hr = nr; Hi = ni; }
    }
}

#ifndef PROBE_PHASE
#define PROBE_PHASE -1
#endif
#if PROBE_PHASE >= 0
#define SECT_BEGIN() const unsigned long long sb_ = __builtin_amdgcn_s_memrealtime()
#define SECT_END(k) do { if ((k) == PROBE_PHASE && p == 7) tacc += __builtin_amdgcn_s_memrealtime() - sb_; } while (0)
#else
#define SECT_BEGIN() do { } while (0)
#define SECT_END(k) do { } while (0)
#endif
typedef float f32x16 __attribute__((ext_vector_type(16)));
constexpr int A2_KP = 200, A2_VP = 68, A2_KB = 64 * A2_KP * 2, A2_VB = 128 * A2_VP * 2, A2_BUF = A2_KB + A2_VB, A2_SCR = 2 * A2_BUF;
__device__ __forceinline__ bf16x8 pack8(const f32x16& p, int b) {
    const unsigned a0 = pg8::cvt_pk_bf16(p[b + 0], p[b + 1]), a1 = pg8::cvt_pk_bf16(p[b + 2], p[b + 3]), a2 = pg8::cvt_pk_bf16(p[b + 4], p[b + 5]), a3 = pg8::cvt_pk_bf16(p[b + 6], p[b + 7]);
    const u32x4 w = (u32x4){a0, a1, a2, a3}; return __builtin_bit_cast(bf16x8, w);
}
__device__ __forceinline__ void attn2_unit(const LayerP& P, LAS unsigned char* lds, int unit, int wave, int lane, unsigned long long& tacc) {
    const int bh = unit >> 3, p = unit & 7, grp = wave >> 2, tid = wave * 64 + lane;
    const int qblk = 2 * p + grp, q0 = qblk * 128 + (wave & 3) * 32, ntiles = 4 * p + 4, jd = q0 >> 6;
    const int r32 = lane & 31, hi = lane >> 5;
    const bf16_t* Q = P.qf + (size_t)bh * SEQ * 192; const bf16_t* K = P.kf + (size_t)bh * SEQ * 192; const bf16_t* VT = P.vt + (size_t)bh * 128 * SEQ;
    LAS float* scr = (LAS float*)(lds + A2_SCR) + wave * 32;
    bf16x8 qb[12];
#pragma unroll
    for (int s = 0; s < 12; ++s) qb[s] = *(const bf16x8*)(Q + (size_t)(q0 + r32) * 192 + s * 16 + hi * 8);
    f32x16 o[4];
#pragma unroll
    for (int e = 0; e < 4; ++e)
#pragma unroll
        for (int r = 0; r < 16; ++r) o[e][r] = 0.f;
    float m = -1e30f, l = 0.f;
    u32x4 kr[3], vr[2];
#define A2_LOAD(j, T) do { _Pragma("unroll") for (int i = 0; i < 3; ++i) kr[i] = *(const u32x4*)(K + (size_t)(j) * 64 * 192 + ((T) + 512 * i) * 8); \
        _Pragma("unroll") for (int i = 0; i < 2; ++i) vr[i] = *(const u32x4*)(VT + (size_t)(j) * (128 * 64) + ((T) + 512 * i) * 8); } while (0)
#define A2_STORE(buf, T) do { LAS unsigned char* kb_ = lds + (buf) * A2_BUF; LAS unsigned char* vb_ = kb_ + A2_KB; \
        _Pragma("unroll") for (int i = 0; i < 3; ++i) { const int c_ = (T) + 512 * i; *(LAS u32x4*)(kb_ + ((c_ / 24) * A2_KP + (c_ % 24) * 8) * 2) = kr[i]; } \
        _Pragma("unroll") for (int i = 0; i < 2; ++i) { LAS u32x2* d_ = (LAS u32x2*)(vb_ + ((((T) >> 3) + 64 * i) * A2_VP + ((T) & 7) * 8) * 2); d_[0] = (u32x2){vr[i].x, vr[i].y}; d_[1] = (u32x2){vr[i].z, vr[i].w}; } } while (0)
    A2_LOAD(0, tid); A2_STORE(0, tid);
    if (ntiles > 1) A2_LOAD(1, tid);
    __syncthreads();
    const float SCL = 0.07216878364870322f * 1.4426950408889634f;
#pragma unroll 1
    for (int j = 0; j < ntiles; ++j) {
        int t_ = tid, r_ = r32, h_ = hi; asm volatile("" : "+v"(t_), "+v"(r_), "+v"(h_));
        { SECT_BEGIN(); if (j + 1 < ntiles) { A2_STORE((j + 1) & 1, t_); if (j + 2 < ntiles) A2_LOAD(j + 2, t_); } SECT_END(20); }
        if (j <= jd) {
            const LAS unsigned char* Kb = lds + (j & 1) * A2_BUF; const LAS unsigned char* Vb = Kb + A2_KB;
            f32x16 p0, p1;
#pragma unroll
            for (int r = 0; r < 16; ++r) { p0[r] = 0.f; p1[r] = 0.f; }
            SECT_BEGIN();
            {
                const unsigned ka = (unsigned)(uintptr_t)Kb + (unsigned)((r_ * A2_KP + h_ * 8) * 2);
                bf16x8 kf[12];
#define A2_KRD(dst, s, blk) asm volatile("ds_read_b128 %0, %1 offset:%2" : "=v"(dst) : "v"(ka), "i"((s) * 32 + (blk) * 32 * A2_KP * 2))
#define A2_KGRP(g, base) do { A2_KRD(kf[(base) + 0], 3 * (g) + 0, 0); A2_KRD(kf[(base) + 1], 3 * (g) + 0, 1); A2_KRD(kf[(base) + 2], 3 * (g) + 1, 0); A2_KRD(kf[(base) + 3], 3 * (g) + 1, 1); A2_KRD(kf[(base) + 4], 3 * (g) + 2, 0); A2_KRD(kf[(base) + 5], 3 * (g) + 2, 1); } while (0)
#define A2_KWAIT(n, base) asm volatile("s_waitcnt lgkmcnt(" #n ")" : "+v"(kf[(base) + 0]), "+v"(kf[(base) + 1]), "+v"(kf[(base) + 2]), "+v"(kf[(base) + 3]), "+v"(kf[(base) + 4]), "+v"(kf[(base) + 5]) :: "memory")
#define A2_KMMA(g, base) do { _Pragma("unroll") for (int t = 0; t < 3; ++t) { p0 = __builtin_amdgcn_mfma_f32_32x32x16_bf16(kf[(base) + 2 * t], qb[3 * (g) + t], p0, 0, 0, 0); p1 = __builtin_amdgcn_mfma_f32_32x32x16_bf16(kf[(base) + 2 * t + 1], qb[3 * (g) + t], p1, 0, 0, 0); } } while (0)
                A2_KGRP(0, 0);
                A2_KGRP(1, 6); A2_KWAIT(6, 0); __builtin_amdgcn_sched_barrier(0); A2_KMMA(0, 0); __builtin_amdgcn_sched_barrier(0);
                A2_KGRP(2, 0); A2_KWAIT(6, 6); __builtin_amdgcn_sched_barrier(0); A2_KMMA(1, 6); __builtin_amdgcn_sched_barrier(0);
                A2_KGRP(3, 6); A2_KWAIT(6, 0); __builtin_amdgcn_sched_barrier(0); A2_KMMA(2, 0); __builtin_amdgcn_sched_barrier(0);
                A2_KWAIT(0, 6); __builtin_amdgcn_sched_barrier(0); A2_KMMA(3, 6); __builtin_amdgcn_sched_barrier(0);
#undef A2_KRD
#undef A2_KGRP
#undef A2_KMMA
#undef A2_KWAIT
            }
            SECT_END(21);
#if PROBE_PHASE == 22
            const unsigned long long sb2_ = __builtin_amdgcn_s_memrealtime();
#endif
            if (j == jd) { const int qlim = (q0 & 63) + r_ - 4 * h_;
#pragma unroll
                for (int r = 0; r < 16; ++r) { const int cc = (r & 3) + 8 * (r >> 2);
                    p0[r] = (cc > qlim) ? -1e30f : p0[r]; p1[r] = (cc + 32 > qlim) ? -1e30f : p1[r]; }
            }
            float mx = -1e30f;
#pragma unroll
            for (int r = 0; r < 16; ++r) mx = fmaxf(mx, fmaxf(p0[r], p1[r]));
            { auto rr = __builtin_amdgcn_permlane32_swap(__float_as_uint(mx), __float_as_uint(mx), false, false); mx = fmaxf(__uint_as_float(rr[0]), __uint_as_float(rr[1])); }
            float mn = m, alpha = 1.0f;
            const bool grow = __builtin_amdgcn_ballot_w64(mx * SCL > m + 8.0f) != 0ull;
            if (grow) { mn = fmaxf(m, mx * SCL); alpha = __builtin_amdgcn_exp2f(m - mn); m = mn; }
            float rs = 0.f;
#pragma unroll
            for (int r = 0; r < 16; ++r) { p0[r] = __builtin_amdgcn_exp2f(__builtin_fmaf(p0[r], SCL, -mn)); p1[r] = __builtin_amdgcn_exp2f(__builtin_fmaf(p1[r], SCL, -mn)); rs += p0[r] + p1[r]; }
            l = l * alpha + rs;
            if (grow) {
                if (h_ == 0) scr[r_] = alpha;
                asm volatile("s_waitcnt lgkmcnt(0)" ::: "memory");
                const LAS float* sp = scr + 4 * h_;
#pragma unroll
                for (int r = 0; r < 16; ++r) { const float a = sp[(r & 3) + 8 * (r >> 2)];
#pragma unroll
                    for (int e = 0; e < 4; ++e) o[e][r] *= a; }
            }
#if PROBE_PHASE == 22
            if (p == 7) tacc += __builtin_amdgcn_s_memrealtime() - sb2_;
#endif
#if PROBE_PHASE == 23
            const unsigned long long sb3_ = __builtin_amdgcn_s_memrealtime();
#endif
            {
                const bf16x8 pa0 = pack8(p0, 0), pa1 = pack8(p0, 8), pa2 = pack8(p1, 0), pa3 = pack8(p1, 8);
                const unsigned va = (unsigned)(uintptr_t)Vb + (unsigned)((r_ * A2_VP + 4 * h_) * 2);
                u32x2 vf[2][8];
#define A2_VRD(dst, e, c) asm volatile("ds_read_b64 %0, %1 offset:%2" : "=v"(dst) : "v"(va), "i"(((e) * 32 * A2_VP + (c) * 8) * 2))
#define A2_VGRP(e, b) do { _Pragma("unroll") for (int c = 0; c < 8; ++c) A2_VRD(vf[b][c], e, c); } while (0)
#define A2_VWAIT(n, b) asm volatile("s_waitcnt lgkmcnt(" #n ")" : "+v"(vf[b][0]), "+v"(vf[b][1]), "+v"(vf[b][2]), "+v"(vf[b][3]), "+v"(vf[b][4]), "+v"(vf[b][5]), "+v"(vf[b][6]), "+v"(vf[b][7]) :: "memory")
#define A2_VMMA(e, b) do { \
        o[e] = __builtin_amdgcn_mfma_f32_32x32x16_bf16(pa0, __builtin_bit_cast(bf16x8, ((u32x4){vf[b][0].x, vf[b][0].y, vf[b][1].x, vf[b][1].y})), o[e], 0, 0, 0); \
        o[e] = __builtin_amdgcn_mfma_f32_32x32x16_bf16(pa1, __builtin_bit_cast(bf16x8, ((u32x4){vf[b][2].x, vf[b][2].y, vf[b][3].x, vf[b][3].y})), o[e], 0, 0, 0); \
        o[e] = __builtin_amdgcn_mfma_f32_32x32x16_bf16(pa2, __builtin_bit_cast(bf16x8, ((u32x4){vf[b][4].x, vf[b][4].y, vf[b][5].x, vf[b][5].y})), o[e], 0, 0, 0); \
        o[e] = __builtin_amdgcn_mfma_f32_32x32x16_bf16(pa3, __builtin_bit_cast(bf16x8, ((u32x4){vf[b][6].x, vf[b][6].y, vf[b][7].x, vf[b][7].y})), o[e], 0, 0, 0); } while (0)
                A2_VGRP(0, 0);
                A2_VGRP(1, 1); A2_VWAIT(8, 0); __builtin_amdgcn_sched_barrier(0); A2_VMMA(0, 0); __builtin_amdgcn_sched_barrier(0);
                A2_VGRP(2, 0); A2_VWAIT(8, 1); __builtin_amdgcn_sched_barrier(0); A2_VMMA(1, 1); __builtin_amdgcn_sched_barrier(0);
                A2_VGRP(3, 1); A2_VWAIT(8, 0); __builtin_amdgcn_sched_barrier(0); A2_VMMA(2, 0); __builtin_amdgcn_sched_barrier(0);
                A2_VWAIT(0, 1); __builtin_amdgcn_sched_barrier(0); A2_VMMA(3, 1); __builtin_amdgcn_sched_barrier(0);
#undef A2_VRD
#undef A2_VGRP
#undef A2_VMMA
#undef A2_VWAIT
            }
#if PROBE_PHASE == 23
            if (p == 7) tacc += __builtin_amdgcn_s_memrealtime() - sb3_;
#endif
        }
        { SECT_BEGIN(); __syncthreads(); SECT_END(24); }
    }
    { auto rr = __builtin_amdgcn_permlane32_swap(__float_as_uint(l), __float_as_uint(l), false, false); l = __uint_as_float(rr[0]) + __uint_as_float(rr[1]); }
    int r2 = r32, h2 = hi; asm volatile("" : "+v"(r2), "+v"(h2));
    if (h2 == 0) scr[r2] = 1.0f / l;
    asm volatile("s_waitcnt lgkmcnt(0)" ::: "memory");
    const int b = bh >> 2, h = bh & 3;
    const bf16_t* gp = P.proj + ((size_t)b * SEQ + q0 + 4 * h2) * NP + C_MG + h * 128 + r2;
    bf16_t* mp = P.mix + ((size_t)b * SEQ + q0 + 4 * h2) * DM + 1536 + h * 128 + r2;
    const LAS float* sp2 = scr + 4 * h2;
#pragma unroll
    for (int r = 0; r < 16; ++r) { const int qo = (r & 3) + 8 * (r >> 2); const float il = sp2[qo];
#pragma unroll
        for (int e = 0; e < 4; ++e) { const float g = bf2f(gp[(size_t)qo * NP + e * 32]);
            mp[(size_t)qo * DM + e * 32] = (bf16_t)f2bf(o[e][r] * il * siluf_(g)); } }
    __syncthreads();
#undef A2_LOAD
#undef A2_STORE
}

#define XB_TMO      128
#define XB_XCNT(j)  (256  + 64 * (j))
#define XB_XSUB(j)  (1280 + 64 * (j))
#define XB_XGEN(j)  (2304 + 64 * (j))
#define XB_TOP      3328
#define XB_TOPGEN   3392
#define XCD_BAR_WORDS 3456
#define XB_SPIN_CAP (1u << 18)
__device__ __forceinline__ unsigned xb_ld(unsigned* p)              { return __hip_atomic_load(p, __ATOMIC_RELAXED, __HIP_MEMORY_SCOPE_AGENT); }
__device__ __forceinline__ unsigned xb_add(unsigned* p, unsigned v) { return __hip_atomic_fetch_add(p, v, __ATOMIC_RELAXED, __HIP_MEMORY_SCOPE_AGENT); }
__device__ __forceinline__ unsigned xb_xcc_id() { return (unsigned)__builtin_amdgcn_s_getreg((3 << 11) | 20) & 0xFu; }
#define XB_SPIN(cond, bar) do { unsigned _sp = 0; while (cond) { __builtin_amdgcn_s_sleep(1); \
    if ((++_sp & 255u) == 0u) { if (xb_ld(&(bar)[XB_TMO])) break; if (_sp > XB_SPIN_CAP) { atomicAdd(&(bar)[XB_TMO], 1u); break; } } } } while (0)
struct XcdBarrier { unsigned* bar; unsigned x; volatile LAS unsigned* st; };
__device__ __forceinline__ XcdBarrier xcd_barrier_post(unsigned* bar, volatile LAS unsigned* st, bool leader) {
    XcdBarrier b; b.bar = bar; b.x = xb_xcc_id(); b.st = st;
    if (leader) (void)xb_add(&bar[XB_XCNT(b.x)], 1u);
    return b;
}
__device__ __forceinline__ void xcd_barrier_complete(unsigned* bar, unsigned x, unsigned& nloc, unsigned& nx) {
    const unsigned G = gridDim.x * gridDim.y * gridDim.z;
    unsigned sum, cnt, mine, sp = 0u;
    for (;;) {
        sum = 0u; cnt = 0u; mine = 0u;
#pragma unroll
        for (unsigned j = 0; j < 16; ++j) { const unsigned c = xb_ld(&bar[XB_XCNT(j)]); sum += c; cnt += (c > 0u) ? 1u : 0u; mine = (j == x) ? c : mine; }
        if (sum == G) break;
        __builtin_amdgcn_s_sleep(1);
        if ((++sp & 255u) == 0u) { if (xb_ld(&bar[XB_TMO])) break; if (sp > XB_SPIN_CAP) { atomicAdd(&bar[XB_TMO], 1u); break; } }
    }
    nloc = mine > 0u ? mine : 1u; nx = cnt > 0u ? cnt : 1u;
}
__device__ __forceinline__ void xcd_barrier(const XcdBarrier& b, bool leader) {
    asm volatile("s_waitcnt vmcnt(0)" ::: "memory");
    __syncthreads();
    if (leader) {
        unsigned* bar = b.bar;
        __builtin_amdgcn_s_waitcnt(0);
        unsigned nloc = b.st[0], nx = b.st[1];
        if (nloc == 0u) { xcd_barrier_complete(bar, b.x, nloc, nx); b.st[0] = nloc; b.st[1] = nx; }
        const unsigned old = xb_add(&bar[XB_XSUB(b.x)], 1u);
        const unsigned gen = old / nloc;
        if (old + 1u == (gen + 1u) * nloc) {
            __builtin_amdgcn_fence(__ATOMIC_RELEASE, "agent");
            asm volatile("s_waitcnt vmcnt(0)" ::: "memory");
            const unsigned og = xb_add(&bar[XB_TOP], 1u);
            const unsigned tg = og / nx;
            if (og + 1u == (tg + 1u) * nx) xb_add(&bar[XB_TOPGEN], 1u);
            else XB_SPIN(xb_ld(&bar[XB_TOPGEN]) == tg, bar);
            __builtin_amdgcn_fence(__ATOMIC_ACQUIRE, "agent");
            xb_add(&bar[XB_XGEN(b.x)], 1u);
            asm volatile("s_waitcnt vmcnt(0)" ::: "memory");
        } else {
            XB_SPIN(xb_ld(&bar[XB_XGEN(b.x)]) == gen, bar);
            __builtin_amdgcn_fence(__ATOMIC_ACQUIRE, "agent");
            asm volatile("s_waitcnt vmcnt(0)" ::: "memory");
        }
    }
    __syncthreads();
}

constexpr size_t MiB = 1u << 20;
constexpr size_t WS_CTL = 0, CTL_ZERO_BYTES = 262144;
constexpr size_t WS_WIN = 1 * MiB;
constexpr size_t WS_WOUT = WS_WIN + 80 * MiB;
constexpr size_t WS_WUQ = WS_WOUT + 32 * MiB;
constexpr size_t WS_WUKV = WS_WUQ + 3 * MiB;
constexpr size_t WS_WGLU = WS_WUKV + 1 * MiB;
constexpr size_t WS_ABAR = WS_WGLU + 2 * MiB;
constexpr size_t WS_BBAR = WS_ABAR + 1 * MiB;
constexpr size_t WS_HB = WS_BBAR + 2 * MiB;
constexpr size_t WS_RSTD = WS_HB + 32 * MiB;
constexpr size_t WS_PROJ = WS_RSTD + 1 * MiB;
constexpr size_t WS_DTF = WS_PROJ + 80 * MiB;
constexpr size_t WS_DTV = WS_DTF + 1 * MiB;
constexpr size_t WS_XBCC = WS_DTV + 1 * MiB;
constexpr size_t WS_YS = WS_XBCC + 24 * MiB;
constexpr size_t WS_MIX = WS_YS + 16 * MiB;
constexpr size_t WS_HS = WS_MIX + 32 * MiB;
constexpr size_t WS_YG = WS_HS + 128 * MiB;
constexpr size_t WS_EG = WS_YG + 8 * MiB;
constexpr size_t WS_OG = WS_EG + 8 * MiB;
constexpr size_t WS_QRAW = WS_OG + 16 * MiB;
constexpr size_t WS_KVRAW = WS_QRAW + 12 * MiB;
constexpr size_t WS_QF = WS_KVRAW + 16 * MiB;
constexpr size_t WS_KF = WS_QF + 12 * MiB;
constexpr size_t WS_VF = WS_KF + 12 * MiB;
constexpr size_t WS_SST = WS_VF + 8 * MiB;
constexpr size_t WS_HIN = WS_SST + 16 * MiB;
constexpr size_t WS_GST = WS_HIN + 8 * MiB;
constexpr size_t WS_GIN = WS_GST + 16 * MiB;
constexpr size_t WS_END = WS_GIN + 8 * MiB;
constexpr int CW_GLA = 10240, CW_S5 = 12288, CW_MLA = 16384, CW_Q = 24576, CW_S5B = 32768;
constexpr int CW_SSD = 8192;
constexpr int CW_BAR = 1024;

#ifndef PROBE_PHASE
#define PROBE_PHASE -1
#endif
#define PROBE_AMP 4
#ifndef GLU_SPLIT
#define GLU_SPLIT 0
#endif
#define GLU_Q_END (GLU_SPLIT ? 512 : 576)
#ifndef RACE_SCREEN
#define RACE_SCREEN 0
#endif
#ifndef PROBE_BLOCK
#define PROBE_BLOCK 0
#endif
#ifndef REP_D1
#define REP_D1 1
#endif
#ifndef REP_D2
#define REP_D2 1
#endif
#ifndef REP_D3
#define REP_D3 1
#endif
#ifndef REP_D4
#define REP_D4 1
#endif
#ifndef REP_F
#define REP_F 1
#endif
#ifndef REP_P
#define REP_P 1
#endif
#ifndef REP_A
#define REP_A 1
#endif
#ifndef REP_B
#define REP_B 1
#endif
#ifndef REP_C
#define REP_C 1
#endif
#ifndef REP_D
#define REP_D 1
#endif
#ifndef REP_E
#define REP_E 1
#endif
#ifndef REP_BAR
#define REP_BAR 1
#endif
struct MegaArgs { const float* in[30]; float* out; unsigned char* ws; };
constexpr int LDS_TAB = pg8::STAGE_BYTES + 64, LDS_XS = LDS_TAB + 256, LDS_TS = LDS_XS + 4096, LDS_TOTAL = LDS_TS + 64;

__global__ void __launch_bounds__(512, 2) mega_fwd(MegaArgs a) {
    __shared__ __attribute__((aligned(16))) unsigned char lds_raw[LDS_TOTAL];
    LAS unsigned char* lds = (LAS unsigned char*)lds_raw;
    const int wave_s = __builtin_amdgcn_readfirstlane((int)threadIdx.x >> 6);
    const int G = (int)gridDim.x, ngw = G * 8; const size_t gth = (size_t)G * 512;
#define IDS() int lane_ = lane_id(), wave_ = wave_s, bid_ = blockIdx.x; asm volatile("" : "+v"(lane_), "+s"(wave_), "+s"(bid_)); const int lane = lane_, wave = __builtin_amdgcn_readfirstlane(wave_), tid_ = wave * 64 + lane_, gw = __builtin_amdgcn_readfirstlane(bid_) * 8 + wave; (void)tid_; const size_t gtid = (size_t)bid_ * 512 + tid_; (void)lane; (void)gw; (void)gtid;
    volatile LAS unsigned* st = (volatile LAS unsigned*)(lds + pg8::STAGE_BYTES);
    { const int tid = wave_s * 64 + lane_id(); if (tid < 16) st[tid] = 0u; }
    __syncthreads();
    LAS unsigned long long* tab = (LAS unsigned long long*)(lds + LDS_TAB);
    { const int tid = wave_s * 64 + lane_id();
      if (tid < 30) tab[tid] = (unsigned long long)a.in[tid];
      if (tid == 30) tab[30] = (unsigned long long)a.out;
      if (tid == 31) tab[31] = (unsigned long long)a.ws; }
    __syncthreads();
#define TABP(i) ((const float*)uptr_(tab[i]))
#define WSP() ((unsigned char*)uptr_(tab[31]))
#define OUTP() ((float*)uptr_(tab[30]))
#if PROBE_PHASE >= 0
    unsigned long long t_last = __builtin_amdgcn_s_memrealtime();
#endif
    unsigned long long t_acc = 0ull;
    (void)xcd_barrier_post((unsigned*)(WSP() + WS_CTL) + CW_BAR, st, wave_s == 0 && lane_id() == 0);
#define GRID_BAR() do { XcdBarrier b2_; b2_.bar = (unsigned*)(WSP() + WS_CTL) + CW_BAR; b2_.x = xb_xcc_id(); b2_.st = st; int w_ = wave_s; asm volatile("" : "+s"(w_)); xcd_barrier(b2_, (w_ * 64 + lane_id()) == 0); } while (0)
#define FIN(i) TABP(i)
#if PROBE_PHASE >= 0
#define STAMP(k) do { const unsigned long long now_ = __builtin_amdgcn_s_memrealtime(); if ((k) == PROBE_PHASE) t_acc += now_ - t_last; t_last = now_; } while (0)
#else
#define STAMP(k) do { } while (0)
#endif
    for (int rep = 0; rep < REP_P; ++rep) {
        unsigned char* ws = WSP();
        bf16_t* win = (bf16_t*)(ws + WS_WIN); bf16_t* wout = (bf16_t*)(ws + WS_WOUT); bf16_t* wuq = (bf16_t*)(ws + WS_WUQ); bf16_t* wukv = (bf16_t*)(ws + WS_WUKV); bf16_t* wglu = (bf16_t*)(ws + WS_WGLU);
        float* abar = (float*)(ws + WS_ABAR); float* bbar = (float*)(ws + WS_BBAR);
        constexpr int T0 = 20 * 32 * 4, T1 = 8 * 32 * 4, T2 = 3 * 6 * 4, T3 = 4 * 2 * 4, T4 = 2 * 8 * 4, TT = T0 + T1 + T2 + T3 + T4;
        IDS();
        for (int it = bid_; it < TT; it += G) {
            int r = it;
            const float* s = nullptr; const float* sc = nullptr; bf16_t* d = nullptr; int K = 0, Nsrc = 0, Ndst = 0, mode = 0, tn = 1, tpl = 1;
            if (r < T0) { s = FIN(3); sc = FIN(2); d = win; K = DM; Nsrc = D_IN; Ndst = NP; mode = 1; tn = 20; tpl = 20 * 32; }
            else if ((r -= T0) < T1) { s = FIN(4); d = wout; K = DM; Nsrc = DM; Ndst = DM; tn = 8; tpl = 8 * 32; }
            else if ((r -= T1) < T2) { s = FIN(25); sc = FIN(24); d = wuq; K = 384; Nsrc = 768; Ndst = 768; tn = 3; tpl = 18; }
            else if ((r -= T2) < T3) { s = FIN(27); sc = FIN(26); d = wukv; K = 128; Nsrc = 1024; Ndst = 1024; tn = 4; tpl = 8; }
            else { r -= T3; s = FIN(19); d = wglu; K = 512; Nsrc = 512; Ndst = 512; tn = 2; tpl = 16; }
            const int l = r / tpl, r2 = r % tpl, n0 = (r2 % tn) * 256, k0 = (r2 / tn) * 64;
            wtrans_tile(s + (size_t)l * K * Nsrc, Nsrc, sc ? sc + (size_t)l * K : nullptr, mode, d + (size_t)l * Ndst * K, K, n0, k0, lds, tid_);
        }
        if (gtid < (size_t)(DEPTH * 32 * 64)) s5prep_item((int)gtid, FIN(11), FIN(12), FIN(13), FIN(14), FIN(15), abar, bbar, (float*)(ws + WS_ABAR + 512 * 1024), (bf16_t*)(ws + WS_BBAR + 1 * MiB));
        for (size_t e = gtid; e < (size_t)DEPTH * 32 * 16 * 128; e += gth) { const size_t gi_ = e >> 7; const int np = (int)(e & 127);
            const float v = (np < 64) ? FIN(16)[gi_ * 64 + np] : -FIN(17)[gi_ * 64 + np - 64]; ((bf16_t*)(ws + WS_DTF + 512 * 1024))[e] = (bf16_t)f2bf(v); }
    }

#define MAKE_P() LayerP P; { unsigned char* ws = WSP(); \
        P.conv_w = FIN(5) + (size_t)lq * 4 * 768; P.conv_b = FIN(6) + (size_t)lq * 768; P.dt_bias = FIN(7) + lq * 8; P.a_log = FIN(8) + lq * 8; P.ssd_d = FIN(9) + lq * 8; P.ssd_norm_w = FIN(10) + lq * 512; \
        P.s5_c_re = FIN(16) + (size_t)lq * 32 * 16 * 64; P.s5_c_im = FIN(17) + (size_t)lq * 32 * 16 * 64; P.s5_d = FIN(18) + lq * 512; P.abar = (float*)(ws + WS_ABAR) + (size_t)lq * 32 * 64 * 2; P.bbar = (float*)(ws + WS_BBAR) + (size_t)lq * 32 * 64 * 32; \
        P.gla_w2 = FIN(21) + (size_t)lq * 16 * 256; P.gla_gb = FIN(22) + lq * 256; P.gla_norm_w = FIN(23) + lq * 128; \
        P.qh_w = FIN(28) + lq * 192; P.kh_w = FIN(29) + lq * 192; P.pos = (const int*)FIN(1); \
        P.proj = (bf16_t*)(ws + WS_PROJ); P.dtf = (float*)(ws + WS_DTF); \
        P.xbcc = (float*)(ws + WS_XBCC); P.dtv = (float*)(ws + WS_DTV); P.ys = (float*)(ws + WS_YS); P.hs = (float*)(ws + WS_HS); P.eg = (float*)(ws + WS_EG); P.og = (float*)(ws + WS_OG); \
        P.yg = (bf16_t*)(ws + WS_YG); P.mix = (bf16_t*)(ws + WS_MIX); P.qraw = (bf16_t*)(ws + WS_QRAW); P.kvraw = (bf16_t*)(ws + WS_KVRAW); \
        P.qf = (bf16_t*)(ws + WS_QF); P.kf = (bf16_t*)(ws + WS_KF); P.vf = (bf16_t*)(ws + WS_VF); P.vt = (bf16_t*)(ws + WS_VF); \
        P.xbcn = (bf16_t*)(ws + WS_XBCC); P.xT = (bf16_t*)(ws + WS_YS); P.hin = (bf16_t*)(ws + WS_HIN); P.csv = (float*)(ws + WS_DTV + 512 * 1024); P.cse = (float*)(ws + WS_DTV + 768 * 1024); P.sst = (float*)(ws + WS_SST); \
        P.cnt_ssd = (unsigned*)(ws + WS_CTL) + CW_SSD + lq * 8 * 64; \
        P.qt = (bf16_t*)(ws + WS_EG); P.kt = (bf16_t*)(ws + WS_EG + 4 * MiB); P.vT2 = (bf16_t*)(ws + WS_OG); P.glb = (float*)(ws + WS_OG + 8 * MiB); P.gst = (float*)(ws + WS_GST); P.gin = (bf16_t*)(ws + WS_GIN); \
        P.cnt_gla = (unsigned*)(ws + WS_CTL) + CW_GLA + lq * 8 * 64; P.cnt_mla = (unsigned*)(ws + WS_CTL) + CW_MLA + lq * 32 * 64; \
        P.abar64 = (const float*)(ws + WS_ABAR + 512 * 1024) + (size_t)lq * 32 * 64 * 2; P.bmp = (const bf16_t*)(ws + WS_BBAR + 1 * MiB) + (size_t)lq * 32 * 128 * 32; P.cmp = (const bf16_t*)(ws + WS_DTF + 512 * 1024) + (size_t)lq * 32 * 16 * 128; P.cnt_s5b = (unsigned*)(ws + WS_CTL) + CW_S5B + lq * 32 * 64; P.s5st = (float*)(ws + WS_HS); P.s5in = (float*)(ws + WS_HS + 4 * MiB); P.cnt_s5 = (unsigned*)(ws + WS_CTL) + CW_S5 + lq * 8 * 64; }
#define RUN_GEMM(EPI, gA, gBt, gN, gK, glda, gldb, ESET) do { pg8::Gemm g; g.A = (gA); g.Bt = (gBt); g.M = TOK; g.N = (gN); g.K = (gK); g.lda = (glda); g.ldb = (gldb); g.pad = 0; \
        pg8::EPI E; ESET; int bid_ = blockIdx.x; asm volatile("" : "+s"(bid_)); pg8::StaticOrder S; S.init(g.M, g.N, G, bid_); pg8::gemm_phase<pg8::EPI, pg8::StaticOrder, true>(lds, g, S, E, wave_s); } while (0)

#define HBUF_IN(q) ((q) == 0 ? FIN(0) : (const float*)OUTP())
#define HBUF_OUT(q) OUTP()
#define LQ() int lq = l; asm volatile("" : "+s"(lq))
#pragma clang loop unroll(disable)
    for (int l = 0; l < DEPTH; ++l) {
        if (l == 0)
        { LQ(); IDS(); unsigned char* ws = WSP(); const float* hin = HBUF_IN(lq);
          k_rowprep(hin, (bf16_t*)(ws + WS_HB), (float*)(ws + WS_RSTD), lane, gw, ngw); }
        if (l == 0) { GRID_BAR(); STAMP(0); }
        { LQ(); unsigned char* ws = WSP();
          pg8::Gemm g; g.A = (const bf16_t*)(ws + WS_HB); g.Bt = (const bf16_t*)(ws + WS_WIN) + (size_t)lq * NP * DM; g.M = TOK; g.N = NP; g.K = DM; g.lda = DM; g.ldb = DM; g.pad = 0;
          pg8::EpiP1 E; E.O = (bf16_t*)(ws + WS_PROJ); E.rstd = (const float*)(ws + WS_RSTD); E.dtf = (float*)(ws + WS_DTF);
          int bid_ = blockIdx.x; asm volatile("" : "+s"(bid_)); pg8::P1Order S; S.G = G; S.c = bid_; S.nunits = 640;
          pg8::gemm_phase<pg8::EpiP1, pg8::P1Order, true>(lds, g, S, E, wave_s); }
        GRID_BAR(); STAMP(1);
        { LQ(); unsigned char* ws = WSP(); unsigned* qh = (unsigned*)(ws + WS_CTL) + CW_Q + (lq * 2 + 0) * 64;
          const int nb1 = 640, nleft = 0;
          for (;;) { IDS(); int ix = queue_pop(qh, st + 4, tid_); if (ix >= 1000 + nleft) break; MAKE_P();
            if (RACE_SCREEN && ((bid_ * 7 + ix) % 5 == 0)) { for (int z_ = 0; z_ < 40; ++z_) __builtin_amdgcn_s_sleep(127); }
            if (ix < nleft) { const int L = nb1 + ix;
                pg8::Gemm g; g.A = (const bf16_t*)(ws + WS_HB); g.Bt = (const bf16_t*)(ws + WS_WIN) + (size_t)lq * NP * DM; g.M = TOK; g.N = NP; g.K = DM; g.lda = DM; g.ldb = DM; g.pad = 0;
                pg8::EpiP1 E; E.O = (bf16_t*)(ws + WS_PROJ); E.rstd = (const float*)(ws + WS_RSTD); E.dtf = (float*)(ws + WS_DTF);
                pg8::OneUnit S; S.pm = L & 31; S.pn = pg8::p1_tile(L >> 5);
                pg8::gemm_phase<pg8::EpiP1, pg8::OneUnit, true>(lds, g, S, E, wave); continue; }
            ix -= nleft;
            if (ix < 128) gla_passA(P, lds, ix, wave, lane);
            else if (ix < 256) ssd_passA(P, lds, ix - 128, wave, lane);
            else if (ix < 384) s5_passA(P, lds, ix - 256, wave, lane);
            else if (ix < 480) { const int un = ix - 384;
                pg8::Gemm g; g.M = TOK; g.pad = 0; g.lda = NP; g.A = (const bf16_t*)(ws + WS_PROJ) + C_CQ; g.Bt = (const bf16_t*)(ws + WS_WUQ) + (size_t)lq * 768 * 384; g.N = 768; g.K = 384; g.ldb = 384;
                pg8::EpiBf16Sig E; E.O = (bf16_t*)(ws + WS_QRAW); E.cnt = P.cnt_mla; E.ldc = 768; E.pad = 0;
                pg8::OneUnit S; S.pm = un / 3; S.pn = un % 3;
                pg8::gemm_phase<pg8::EpiBf16Sig, pg8::OneUnit, true>(lds, g, S, E, wave); }
            else if (ix < 608) { const int un = ix - 480;
                pg8::Gemm g; g.M = TOK; g.pad = 0; g.lda = NP; g.A = (const bf16_t*)(ws + WS_PROJ) + C_CKV; g.Bt = (const bf16_t*)(ws + WS_WUKV) + (size_t)lq * 1024 * 128; g.N = 1024; g.K = 128; g.ldb = 128;
                pg8::EpiBf16Sig E; E.O = (bf16_t*)(ws + WS_KVRAW); E.cnt = P.cnt_mla; E.ldc = 1024; E.pad = 0;
                pg8::OneUnit S; S.pm = un >> 2; S.pn = un & 3;
                pg8::gemm_phase<pg8::EpiBf16Sig, pg8::OneUnit, true>(lds, g, S, E, wave); }
            else if (ix < 744) { const int jb = ix - 608; if (jb < 64) ssd_prefix_job(P, jb, tid_); else if (jb < 128) gla_prefix_job(P, jb - 64, tid_); else s5_prefix_job(P, jb - 128, tid_); }
            else { const int sl = ix - 744; job_wait(P.cnt_mla + 64 * (sl >> 3), 7u, tid_); mla_fin4(P, lane, sl * 32 + wave * 4); }
 } }
        STAMP(13);
        GRID_BAR(); STAMP(2);
        { LQ(); unsigned char* ws = WSP(); unsigned* qh = (unsigned*)(ws + WS_CTL) + CW_Q + (lq * 2 + 1) * 64;
          for (;;) { IDS(); const int ix = queue_pop(qh, st + 4, tid_); if (ix >= GLU_Q_END) break; MAKE_P();
            if (RACE_SCREEN && ((bid_ * 3 + ix) % 7 == 0)) { for (int z_ = 0; z_ < 40; ++z_) __builtin_amdgcn_s_sleep(127); }
            if (ix < 128) attn2_unit(P, lds, (ix & 15) * 8 + (7 - (ix >> 4)), wave, lane, t_acc);
            else if (ix < 256) s5_passB(P, lds, ix - 128, wave, lane);
            else if (ix < 384) gla_passB(P, lds, ix - 256, wave, lane);
            else if (ix < 512) ssd_passB(P, lds, ix - 384, wave, lane);
            else { const int un = ix - 512, pm = un >> 1;
                job_wait(P.cnt_s5b + 64 * pm, 4u, tid_);
                pg8::Gemm g; g.M = TOK; g.pad = 0; g.A = (const bf16_t*)(ws + WS_YG); g.Bt = (const bf16_t*)(ws + WS_WGLU) + (size_t)lq * 512 * 512; g.N = 512; g.K = 512; g.lda = 512; g.ldb = 512;
                pg8::EpiGlu E; E.yg = (const bf16_t*)(ws + WS_YG); E.proj = (const bf16_t*)(ws + WS_PROJ); E.bias = FIN(20) + lq * 512; E.mix = (bf16_t*)(ws + WS_MIX);
                pg8::OneUnit S; S.pm = pm; S.pn = un & 1;
                pg8::gemm_phase<pg8::EpiGlu, pg8::OneUnit, true>(lds, g, S, E, wave); } } }
        STAMP(10);
        GRID_BAR(); STAMP(3);
#if GLU_SPLIT
        { LQ(); unsigned char* ws = WSP();
          RUN_GEMM(EpiGlu, (const bf16_t*)(ws + WS_YG), (const bf16_t*)(ws + WS_WGLU) + (size_t)lq * 512 * 512, 512, 512, 512, 512,
                   (E.yg = (const bf16_t*)(ws + WS_YG), E.proj = (const bf16_t*)(ws + WS_PROJ), E.bias = FIN(20) + lq * 512, E.mix = (bf16_t*)(ws + WS_MIX))); }
        GRID_BAR();
#endif
        { LQ(); unsigned char* ws = WSP(); const float* hin = HBUF_IN(lq);
          RUN_GEMM(EpiRes2, (const bf16_t*)(ws + WS_MIX), (const bf16_t*)(ws + WS_WOUT) + (size_t)lq * DM * DM, DM, DM, DM, DM, (E.base = hin, E.out = HBUF_OUT(lq), E.hb = (bf16_t*)(ws + WS_HB), E.rsq = (float*)(ws + WS_RSTD), E.xs = (LAS float*)(lds + LDS_XS))); }
        if (l + 1 < DEPTH) GRID_BAR();
        STAMP(5);
    }
#if PROBE_PHASE >= 0
    if ((blockIdx.x == PROBE_BLOCK || PROBE_PHASE >= 20) && wave_s == (PROBE_PHASE >= 20 ? 4 : 0)) { const unsigned long long t_end = __builtin_amdgcn_s_memrealtime() + PROBE_AMP * t_acc; while (__builtin_amdgcn_s_memrealtime() < t_end) __builtin_amdgcn_s_sleep(8); }
#endif
}

extern "C" void kernel_launch(void* const* d_in, const int* in_sizes, int n_in, void* d_out, int out_size, void* d_ws, size_t ws_size, hipStream_t stream) {
    static int grid = 0;
    if (grid == 0) {
        if (n_in != 30 || out_size != TOK * DM || ws_size < WS_END) { fprintf(stderr, "kernel_launch: unexpected shapes (n_in %d out %d ws %zu need %zu)\n", n_in, out_size, ws_size, (size_t)WS_END); grid = -1; return; }
        int dev = 0, cus = 0;
        if (hipGetDevice(&dev) != hipSuccess || hipDeviceGetAttribute(&cus, hipDeviceAttributeMultiprocessorCount, dev) != hipSuccess || cus <= 0) { fprintf(stderr, "kernel_launch: device query failed\n"); grid = -1; return; }
        grid = cus;
    }
    if (grid < 0) return;
    (void)hipMemsetAsync((char*)d_ws + WS_CTL, 0, CTL_ZERO_BYTES, stream);
    MegaArgs a{};
    for (int i = 0; i < 30; ++i) a.in[i] = (const float*)d_in[i];
    a.out = (float*)d_out; a.ws = (unsigned char*)d_ws;
    hipLaunchKernelGGL(mega_fwd, dim3(grid), dim3(512), 0, stream, a);
}
```

```cpp
#include <hip/hip_runtime.h>
#include <cstdio>
#include <cstdint>

#define LAS __attribute__((address_space(3)))
typedef unsigned short bf16_t;
typedef short bf16x8 __attribute__((ext_vector_type(8)));
typedef float f32x4 __attribute__((ext_vector_type(4)));
typedef unsigned u32x4 __attribute__((ext_vector_type(4)));
typedef unsigned u32x2 __attribute__((ext_vector_type(2)));
typedef float f32x2v __attribute__((ext_vector_type(2)));

constexpr int DM = 2048, NB = 4, SEQ = 2048, DEPTH = 4, TOK = NB * SEQ;
constexpr int D_IN = 4952, NP = 5120;
constexpr float EPS = 1e-6f;
constexpr int C_Z = 0, C_XBC = 512, C_S5U = 1280, C_S5G = 1792, C_GQ = 2304, C_GK = 2560, C_GV = 2816, C_GG = 3328,
              C_CQ = 3840, C_CKV = 4224, C_KPE = 4352, C_DT = 4416, C_GLR = 4424, C_PAD = 4440, C_MG = 4608;
__host__ __device__ __forceinline__ int win_src_col(int n) {
    if (n < 1280) return n;
    if (n < C_GQ) return n + 8;
    if (n < C_CQ) return n + 8;
    if (n < C_KPE) return n + 24;
    if (n < C_DT) return n + 24;
    if (n < C_GLR) return n - C_DT + 1280;
    if (n < C_PAD) return n - C_GLR + 3848;
    if (n < C_MG) return -1;
    return n - C_MG + 4440;
}

__device__ __forceinline__ int lane_id() { int l; asm volatile("v_mbcnt_lo_u32_b32 %0, -1, 0\n\tv_mbcnt_hi_u32_b32 %0, -1, %0" : "=v"(l)); return l; }
__device__ __forceinline__ float bf2f(bf16_t v) { return __uint_as_float(((unsigned)v) << 16); }
__device__ __forceinline__ unsigned f2bf(float f) { unsigned u = __float_as_uint(f); return (u + 0x7fffu + ((u >> 16) & 1u)) >> 16; }
__device__ __forceinline__ unsigned pk2(float lo, float hi) { return f2bf(lo) | (f2bf(hi) << 16); }
template <int X> __device__ __forceinline__ float swz_xor(float v) { return __int_as_float(__builtin_amdgcn_ds_swizzle(__float_as_int(v), (X << 10) | 0x1f)); }
__device__ __forceinline__ float xor32_other(float v, int lane) {
    auto r = __builtin_amdgcn_permlane32_swap(__float_as_uint(v), __float_as_uint(v), false, false);
    return __uint_as_float(lane < 32 ? r[1] : r[0]); }
__device__ __forceinline__ float wave_sum(float v) {
    v += swz_xor<1>(v); v += swz_xor<2>(v); v += swz_xor<4>(v); v += swz_xor<8>(v); v += swz_xor<16>(v);
    auto r = __builtin_amdgcn_permlane32_swap(__float_as_uint(v), __float_as_uint(v), false, false);
    return __uint_as_float(r[0]) + __uint_as_float(r[1]);
}
__device__ __forceinline__ float xmax16(float v) {
    v = fmaxf(v, swz_xor<1>(v)); v = fmaxf(v, swz_xor<2>(v)); v = fmaxf(v, swz_xor<4>(v)); v = fmaxf(v, swz_xor<8>(v)); return v; }
__device__ __forceinline__ float xsum16(float v) {
    v += swz_xor<1>(v); v += swz_xor<2>(v); v += swz_xor<4>(v); v += swz_xor<8>(v); return v; }
__device__ __forceinline__ float fexp(float x) { return __builtin_amdgcn_exp2f(x * 1.4426950408889634f); }
__device__ __forceinline__ float flog(float x) { return __builtin_amdgcn_logf(x) * 0.6931471805599453f; }
__device__ __forceinline__ float frcp(float x) { return __builtin_amdgcn_rcpf(x); }
__device__ __forceinline__ float frsq(float x) { return __builtin_amdgcn_rsqf(x); }
__device__ __forceinline__ float log1p_small(float e) { return (e < 0.01f) ? e * (1.0f - e * (0.5f - e * (1.0f / 3.0f))) : flog(1.0f + e); }
__device__ __forceinline__ float sigmoidf_(float x) { return frcp(1.0f + fexp(-x)); }
__device__ __forceinline__ float siluf_(float x) { return x * sigmoidf_(x); }
__device__ __forceinline__ float softplusf_(float x) { return x > 20.f ? x : log1p_small(fexp(x)); }
__device__ __forceinline__ float gelu_tanh(float x) { const float y = 0.7978845608028654f * (x + 0.044715f * x * x * x); const float th = 1.0f - 2.0f * frcp(1.0f + fexp(2.0f * y)); return 0.5f * x * (1.0f + th); }

__device__ __forceinline__ void* uptr_(unsigned long long v) {
    const unsigned lo = __builtin_amdgcn_readfirstlane((unsigned)v), hi = __builtin_amdgcn_readfirstlane((unsigned)(v >> 32));
    return (void*)(__attribute__((address_space(1))) void*)(((unsigned long long)hi << 32) | lo);
}
namespace pg8 {
constexpr int BM = 256, BK = 64, HALF = 128, HTB = HALF * BK * 2, STAGE_BYTES = 8 * HTB, NXCD = 8, WGM = 8;
__host__ __device__ __forceinline__ int lds_byte(int r, int c) { const int st = (r >> 4) * 2 + (c >> 5), rr = r & 15, cc = c & 31, ob = rr * 64 + cc * 2; return st * 1024 + (ob ^ (((ob >> 9) & 1) << 5)); }
__host__ __device__ __forceinline__ void stage_rc(int b, int& R, int& C) { const int st = b / 1024, sb = b % 1024, swz = sb ^ (((sb >> 9) & 1) << 5); R = (st >> 1) * 16 + swz / 64; C = (st & 1) * 32 + (swz % 64) / 2; }
__host__ __device__ __forceinline__ int perm32(int rho) { const int n = rho >> 4, i = rho & 15; return 8 * (i >> 2) + 4 * n + (i & 3); }
struct Unit { int pm, pn; };
struct Gemm { const bf16_t* A; const bf16_t* Bt; int M, N, K, lda, ldb, pad; };
__host__ __device__ __forceinline__ int p1_tile(int pl) { const unsigned long long lo = 2ull | (3ull << 5) | (4ull << 10) | (5ull << 15) | (6ull << 20) | (9ull << 25) | (10ull << 30) | (11ull << 35) | (12ull << 40) | (15ull << 45) | (16ull << 50) | (17ull << 55);
    const unsigned long long hi = 0ull | (1ull << 5) | (7ull << 10) | (8ull << 15) | (13ull << 20) | (14ull << 25) | (18ull << 30) | (19ull << 35);
    return pl < 12 ? (int)((lo >> (5 * pl)) & 31ull) : (int)((hi >> (5 * (pl - 12))) & 31ull); }
struct P1Order {
    int G, c, nunits;
    __device__ bool next(int i, Unit& u) const { const int L = i * G + c; if (L >= nunits) return false; u.pm = L & 31; u.pn = p1_tile(L >> 5); return true; }
};
struct OneUnit { int pm, pn; __device__ bool next(int i, Unit& u) const { if (i) return false; u.pm = pm; u.pn = pn; return true; } };
struct StaticOrder {
    int nM, nN, nwg, G, c;
    __host__ __device__ void init(int M, int N, int G_, int c_) { nM = M / BM; nN = N / BM; nwg = nM * nN; G = G_; c = c_; }
    __host__ __device__ bool next(int i, Unit& u) const {
        const long L = (long)i * G + c; if (L >= nwg) return false;
        int wgid = (int)L; { const int q = nwg / NXCD, r = nwg % NXCD, xcd = wgid % NXCD, off = wgid / NXCD; wgid = (xcd < r ? xcd * (q + 1) : r * (q + 1) + (xcd - r) * q) + off; }
        const int nig = WGM * nN, gid = wgid / nig, fm = gid * WGM, gsz = (nM - fm) < WGM ? (nM - fm) : WGM;
        u.pm = fm + ((wgid % nig) % gsz); u.pn = (wgid % nig) / gsz; return true;
    }
};
__device__ __forceinline__ void glds16_s(const void* sbase, unsigned voff, unsigned lds_dst) {
    unsigned keep;
    asm volatile("s_nop 4\n\ts_mov_b32 %0, m0\n\ts_mov_b32 m0, %2\n\ts_nop 0\n\tglobal_load_lds_dwordx4 %1, %3\n\ts_mov_b32 m0, %0" : "=&s"(keep) : "v"(voff), "s"(lds_dst), "s"(sbase) : "memory");
}
__device__ __forceinline__ unsigned cvt_pk_bf16(float lo, float hi) { unsigned r; asm volatile("v_cvt_pk_bf16_f32 %0, %1, %2" : "=v"(r) : "v"(lo), "v"(hi)); return r; }

template <class Epi, class Sched, bool ALIGN_EPI>
__device__ __forceinline__ void gemm_phase(LAS unsigned char* lds, const Gemm g, const Sched& S, const Epi& E, int wid_in) {
    int lane = lane_id(), wid0 = wid_in; asm volatile("" : "+v"(lane), "+s"(wid0)); const int wid = __builtin_amdgcn_readfirstlane(wid0);
    const int tid = wid * 64 + lane, wr = wid >> 2, wc = wid & 3, fr = lane & 15, fq = lane >> 4;
    const int K = g.K, nt = K / BK;
    unsigned voffA[2], voffB[2];
#pragma unroll
    for (int i = 0; i < 2; ++i) { int R, C; stage_rc(tid * 16 + i * 8192, R, C); const int Rb = Epi::PERM ? ((R & ~31) + perm32(R & 31)) : R;
        voffA[i] = (unsigned)(R * g.lda + C) * 2u; voffB[i] = (unsigned)(Rb * g.ldb + C) * 2u; }
    const size_t kstep = (size_t)(BK * 2);
    const size_t hstepA = (size_t)HALF * g.lda * 2, hstepB = (size_t)HALF * g.ldb * 2;
    const size_t tstepA = 2 * hstepA, tstepB = 2 * hstepB;
    const unsigned ldsw = (unsigned)wid * 1024u, ldsbase = (unsigned)(uintptr_t)lds;
    const int aoff = lds_byte(wr * 64 + fr, fq * 8), boff = lds_byte(wc * 32 + fr, fq * 8);
#define PG8_SA(b, h) (((b) * 2 + (h)) * HTB)
#define PG8_SB(b, h) ((4 + (b) * 2 + (h)) * HTB)
#define PG8_STAGE(bufoff, gbase, voff) do { _Pragma("unroll") for (int _i = 0; _i < 2; ++_i) \
        glds16_s((const void*)(gbase), (voff)[_i], (unsigned)__builtin_amdgcn_readfirstlane((int)(ldsbase + (unsigned)(bufoff) + ldsw + (unsigned)(_i * 8192)))); } while (0)
#define PG8_LDA(dst, b, h) do { _Pragma("unroll") for (int m = 0; m < 4; ++m) _Pragma("unroll") for (int k = 0; k < 2; ++k) dst[m][k] = *(const LAS bf16x8*)(lds + PG8_SA(b, h) + aoff + m * 2048 + k * 1024); } while (0)
#define PG8_LDB(dst, b, h) do { _Pragma("unroll") for (int n = 0; n < 2; ++n) _Pragma("unroll") for (int k = 0; k < 2; ++k) dst[n][k] = *(const LAS bf16x8*)(lds + PG8_SB(b, h) + boff + n * 2048 + k * 1024); } while (0)
#define PG8_MMA(ai, bj, At, Bt) do { __builtin_amdgcn_s_setprio(1); _Pragma("unroll") for (int m = 0; m < 4; ++m) _Pragma("unroll") for (int n = 0; n < 2; ++n) _Pragma("unroll") for (int k = 0; k < 2; ++k) \
        acc[ai][bj][m][n] = __builtin_amdgcn_mfma_f32_16x16x32_bf16(Bt[n][k], At[m][k], acc[ai][bj][m][n], 0, 0, 0); __builtin_amdgcn_s_setprio(0); } while (0)
#define PG8_WAIT_V(n) asm volatile("s_waitcnt vmcnt(" #n ")" ::: "memory")
#define PG8_WAIT_L(n) asm volatile("s_waitcnt lgkmcnt(" #n ")" ::: "memory")
#define PG8_BAR __builtin_amdgcn_s_barrier()
#define PG8_SCHED __builtin_amdgcn_sched_barrier(0)
    Unit cur, nxt; int ui = 0;
    if (!S.next(0, cur)) return;
    f32x4 acc[2][2][4][2];
#pragma unroll
    for (int a = 0; a < 2; ++a)
#pragma unroll
        for (int b = 0; b < 2; ++b)
#pragma unroll
            for (int m = 0; m < 4; ++m)
#pragma unroll
                for (int n = 0; n < 2; ++n) acc[a][b][m][n] = (f32x4){0.f, 0.f, 0.f, 0.f};
    bf16x8 At[4][2], B0[2][2], B1[2][2];
    const char* const gA_ = (const char*)uptr_((unsigned long long)g.A); const char* const gB_ = (const char*)uptr_((unsigned long long)g.Bt);
    const char* cA = gA_ + (size_t)__builtin_amdgcn_readfirstlane(cur.pm) * tstepA; const char* cB = gB_ + (size_t)__builtin_amdgcn_readfirstlane(cur.pn) * tstepB;
    PG8_STAGE(PG8_SB(0, 0), cB, voffB); PG8_STAGE(PG8_SB(0, 1), cB + hstepB, voffB); PG8_STAGE(PG8_SA(0, 0), cA, voffA); PG8_STAGE(PG8_SA(0, 1), cA + hstepA, voffA);
    if (wr == 1) PG8_BAR;
    PG8_WAIT_V(2); PG8_BAR;
    PG8_STAGE(PG8_SB(1, 0), cB + kstep, voffB); PG8_STAGE(PG8_SA(1, 0), cA + kstep, voffA); PG8_STAGE(PG8_SB(1, 1), cB + hstepB + kstep, voffB);
    PG8_WAIT_V(6); PG8_BAR;
    for (;;) {
        const bool has_next = S.next(ui + 1, nxt);
        const char* nA = has_next ? gA_ + (size_t)__builtin_amdgcn_readfirstlane(nxt.pm) * tstepA : cA; const char* nB = has_next ? gB_ + (size_t)__builtin_amdgcn_readfirstlane(nxt.pn) * tstepB : cB;
        for (int t = 0; t < nt; t += 2) {
            const bool last = (t == nt - 2);
            const char* a1 = cA + (size_t)(t + 1) * kstep;
            const char* a2 = last ? nA : cA + (size_t)(t + 2) * kstep; const char* b2 = last ? nB : cB + (size_t)(t + 2) * kstep;
            const char* a3 = a2 + kstep; const char* b3 = b2 + kstep;
            PG8_LDB(B0, 0, 0); PG8_LDB(B1, 0, 1); PG8_SCHED; PG8_LDA(At, 0, 0); PG8_STAGE(PG8_SA(1, 1), a1 + hstepA, voffA);
            PG8_WAIT_V(8); PG8_WAIT_L(0); PG8_BAR; PG8_MMA(0, 0, At, B0); PG8_MMA(0, 1, At, B1); PG8_BAR; PG8_SCHED;
            PG8_LDA(At, 0, 1); PG8_STAGE(PG8_SB(0, 0), b2, voffB); PG8_STAGE(PG8_SB(0, 1), b2 + hstepB, voffB); PG8_STAGE(PG8_SA(0, 0), a2, voffA);
            PG8_WAIT_V(8); PG8_WAIT_L(0); PG8_BAR; PG8_MMA(1, 0, At, B0); PG8_MMA(1, 1, At, B1); PG8_BAR; PG8_SCHED;
            PG8_LDB(B0, 1, 0); PG8_LDB(B1, 1, 1); PG8_SCHED; PG8_LDA(At, 1, 0); PG8_STAGE(PG8_SA(0, 1), a2 + hstepA, voffA);
            PG8_WAIT_V(8); PG8_WAIT_L(0); PG8_BAR; PG8_MMA(0, 0, At, B0); PG8_MMA(0, 1, At, B1); PG8_BAR; PG8_SCHED;
            PG8_LDA(At, 1, 1); PG8_STAGE(PG8_SB(1, 0), b3, voffB); PG8_STAGE(PG8_SB(1, 1), b3 + hstepB, voffB); PG8_STAGE(PG8_SA(1, 0), a3, voffA);
            PG8_WAIT_V(8); PG8_WAIT_L(0); PG8_BAR; PG8_MMA(1, 0, At, B0); PG8_MMA(1, 1, At, B1); PG8_BAR; PG8_SCHED;
        }
        if constexpr (ALIGN_EPI) { if (wr == 0) PG8_BAR; }
        E(acc, cur, wr, wc, fr, fq);
        if (!has_next) break;
#pragma unroll
        for (int a = 0; a < 2; ++a)
#pragma unroll
            for (int b = 0; b < 2; ++b)
#pragma unroll
                for (int m = 0; m < 4; ++m)
#pragma unroll
                    for (int n = 0; n < 2; ++n) acc[a][b][m][n] = (f32x4){0.f, 0.f, 0.f, 0.f};
        cur = nxt; cA = nA; cB = nB; ++ui;
        if constexpr (ALIGN_EPI) { if (wr == 1) PG8_BAR; }
    }
    PG8_WAIT_V(0);
    if constexpr (!ALIGN_EPI) { if (wr == 0) PG8_BAR; }
    PG8_BAR;
#undef PG8_SA
#undef PG8_SB
#undef PG8_STAGE
#undef PG8_LDA
#undef PG8_LDB
#undef PG8_MMA
#undef PG8_WAIT_V
#undef PG8_WAIT_L
#undef PG8_BAR
#undef PG8_SCHED
}

struct EpiBf16 {
    static constexpr bool PERM = true;
    bf16_t* O; int ldc, pad;
    __device__ __forceinline__ void operator()(const f32x4 (&acc)[2][2][4][2], const Unit& u, int wr_, int wc_, int fr_, int fq_) const {
        const int ln_ = lane_id(), fr = ln_ & 15, fq = ln_ >> 4; (void)fr_; (void)fq_; const int wr = wr_, wc = wc_;
        const int row0 = u.pm * BM + wr * 64 + fr, col0 = u.pn * BM + wc * 32 + 8 * fq;
#pragma unroll
        for (int ai = 0; ai < 2; ++ai)
#pragma unroll
            for (int m = 0; m < 4; ++m) { bf16_t* rowp = O + (size_t)(row0 + ai * HALF + m * 16) * ldc + col0;
#pragma unroll
                for (int bj = 0; bj < 2; ++bj) { const f32x4 v0 = acc[ai][bj][m][0], v1 = acc[ai][bj][m][1];
                    u32x4 w; w.x = cvt_pk_bf16(v0[0], v0[1]); w.y = cvt_pk_bf16(v0[2], v0[3]); w.z = cvt_pk_bf16(v1[0], v1[1]); w.w = cvt_pk_bf16(v1[2], v1[3]);
                    *(u32x4*)(rowp + bj * HALF) = w; } }
    }
};
struct EpiBf16Sig {
    static constexpr bool PERM = true;
    bf16_t* O; unsigned* cnt; int ldc, pad;
    __device__ __forceinline__ void operator()(const f32x4 (&acc)[2][2][4][2], const Unit& u, int wr_, int wc_, int fr_, int fq_) const {
        const int ln_ = lane_id(), fr = ln_ & 15, fq = ln_ >> 4; (void)fr_; (void)fq_; const int wr = wr_, wc = wc_;
        const int row0 = u.pm * BM + wr * 64 + fr, col0 = u.pn * BM + wc * 32 + 8 * fq;
#pragma unroll
        for (int ai = 0; ai < 2; ++ai)
#pragma unroll
            for (int m = 0; m < 4; ++m) { bf16_t* rowp = O + (size_t)(row0 + ai * HALF + m * 16) * ldc + col0;
#pragma unroll
                for (int bj = 0; bj < 2; ++bj) { const f32x4 v0 = acc[ai][bj][m][0], v1 = acc[ai][bj][m][1];
                    u32x4 w; w.x = cvt_pk_bf16(v0[0], v0[1]); w.y = cvt_pk_bf16(v0[2], v0[3]); w.z = cvt_pk_bf16(v1[0], v1[1]); w.w = cvt_pk_bf16(v1[2], v1[3]);
                    *(u32x4*)(rowp + bj * HALF) = w; } }
        asm volatile("s_waitcnt vmcnt(0)" ::: "memory"); __builtin_amdgcn_s_barrier(); asm volatile("" ::: "memory");
        if ((wr * 4 + wc) == 0 && ln_ == 0) { __builtin_amdgcn_fence(__ATOMIC_RELEASE, "agent"); asm volatile("s_waitcnt vmcnt(0)" ::: "memory");
            (void)__hip_atomic_fetch_add(cnt + 64 * u.pm, 1u, __ATOMIC_RELAXED, __HIP_MEMORY_SCOPE_AGENT); }
    }
};
struct EpiP1 {
    static constexpr bool PERM = true;
    bf16_t* O; const float* rstd; float* dtf;
    __device__ __forceinline__ void operator()(const f32x4 (&acc)[2][2][4][2], const Unit& u, int wr_, int wc_, int fr_, int fq_) const {
        const int ln_ = lane_id(), fr = ln_ & 15, fq = ln_ >> 4; (void)fr_; (void)fq_; const int wr = wr_, wc = wc_;
        const int row0 = u.pm * BM + wr * 64 + fr, col0 = u.pn * BM + wc * 32 + 8 * fq;
        const bool isdt = (u.pn == C_DT / 256) && (wc * 32 + 8 * fq == C_DT % 256);
#pragma unroll
        for (int ai = 0; ai < 2; ++ai)
#pragma unroll
            for (int m = 0; m < 4; ++m) { const int row = row0 + ai * HALF + m * 16; const f32x4 q0 = *(const f32x4*)(rstd + (size_t)row * 8), q1 = *(const f32x4*)(rstd + (size_t)row * 8 + 4);
                const float rs = frsq((((q0.x + q0.y) + (q0.z + q0.w)) + ((q1.x + q1.y) + (q1.z + q1.w))) * (1.0f / DM) + EPS); bf16_t* rowp = O + (size_t)row * NP + col0;
#pragma unroll
                for (int bj = 0; bj < 2; ++bj) { const f32x4 v0 = acc[ai][bj][m][0] * rs, v1 = acc[ai][bj][m][1] * rs;
                    u32x4 w; w.x = cvt_pk_bf16(v0[0], v0[1]); w.y = cvt_pk_bf16(v0[2], v0[3]); w.z = cvt_pk_bf16(v1[0], v1[1]); w.w = cvt_pk_bf16(v1[2], v1[3]);
                    *(u32x4*)(rowp + bj * HALF) = w;
                    if (bj == 0 && isdt) { *(f32x4*)(dtf + (size_t)row * 8) = v0; *(f32x4*)(dtf + (size_t)row * 8 + 4) = v1; } } }
    }
};
struct EpiRes {
    static constexpr bool PERM = false;
    const float* base; float* out;
    __device__ __forceinline__ void operator()(const f32x4 (&acc)[2][2][4][2], const Unit& u, int wr_, int wc_, int fr_, int fq_) const {
        const int ln_ = lane_id(), fr = ln_ & 15, fq = ln_ >> 4; (void)fr_; (void)fq_; const int wr = wr_, wc = wc_;
        const int row0 = u.pm * BM + wr * 64 + fr, col0 = u.pn * BM + wc * 32 + 4 * fq;
#pragma unroll
        for (int ai = 0; ai < 2; ++ai)
#pragma unroll
            for (int m = 0; m < 4; ++m) { const size_t off = (size_t)(row0 + ai * HALF + m * 16) * DM + col0;
#pragma unroll
                for (int bj = 0; bj < 2; ++bj)
#pragma unroll
                    for (int n = 0; n < 2; ++n) { const size_t ix = off + bj * HALF + n * 16; const f32x4 b = *(const f32x4*)(base + ix); *(f32x4*)(out + ix) = b + acc[ai][bj][m][n]; } }
    }
};
struct EpiRes2 {
    static constexpr bool PERM = false;
    const float* base; float* out; bf16_t* hb; float* rsq; LAS float* xs;
    __device__ __forceinline__ void operator()(const f32x4 (&acc)[2][2][4][2], const Unit& u, int wr_, int wc_, int fr_, int fq_) const {
        const int ln_ = lane_id(), fr = ln_ & 15, fq = ln_ >> 4; (void)fr_; (void)fq_; const int wr = wr_, wc = wc_;
        const int row0 = u.pm * BM + wr * 64 + fr, col0 = u.pn * BM + wc * 32 + 4 * fq;
#pragma unroll
        for (int ai = 0; ai < 2; ++ai)
#pragma unroll
            for (int m = 0; m < 4; ++m) { const size_t off = (size_t)(row0 + ai * HALF + m * 16) * DM + col0; float q = 0.f;
#pragma unroll
                for (int bj = 0; bj < 2; ++bj)
#pragma unroll
                    for (int n = 0; n < 2; ++n) { const size_t ix = off + bj * HALF + n * 16; const f32x4 v = *(const f32x4*)(base + ix) + acc[ai][bj][m][n]; *(f32x4*)(out + ix) = v;
                        u32x2 w; w.x = cvt_pk_bf16(v.x, v.y); w.y = cvt_pk_bf16(v.z, v.w); *(u32x2*)(hb + ix) = w;
                        q += (v.x * v.x + v.y * v.y) + (v.z * v.z + v.w * v.w); }
                q += swz_xor<16>(q);
                { auto r = __builtin_amdgcn_permlane32_swap(__float_as_uint(q), __float_as_uint(q), false, false); q = __uint_as_float(r[0]) + __uint_as_float(r[1]); }
                if (fq == 0) xs[(ai * HALF + wr * 64 + m * 16 + fr) * 4 + wc] = q; }
        asm volatile("s_waitcnt lgkmcnt(0)" ::: "memory"); __builtin_amdgcn_s_barrier(); asm volatile("" ::: "memory");
        const int tid = (wr * 4 + wc) * 64 + ln_;
        if (tid < 256) { const f32x4 p = *(const LAS f32x4*)(xs + tid * 4); rsq[(size_t)(u.pm * BM + tid) * 8 + u.pn] = (p.x + p.y) + (p.z + p.w); }
    }
};
struct EpiRes3 {
    static constexpr bool PERM = true;
    const float* base; float* out; bf16_t* hb; float* rsq; LAS float* xs; int mode;
    __device__ __forceinline__ void operator()(const f32x4 (&acc)[2][2][4][2], const Unit& u, int wr_, int wc_, int fr_, int fq_) const {
        const int ln_ = lane_id(), fr = ln_ & 15, fq = ln_ >> 4; (void)fr_; (void)fq_; const int wr = wr_, wc = wc_;
        const int row0 = u.pm * BM + wr * 64 + fr, col0 = u.pn * BM + wc * 32 + 8 * fq;
#pragma unroll
        for (int ai = 0; ai < 2; ++ai)
#pragma unroll
            for (int m = 0; m < 4; ++m) { const size_t off = (size_t)(row0 + ai * HALF + m * 16) * DM + col0; float q = 0.f;
#pragma unroll
                for (int bj = 0; bj < 2; ++bj) { const size_t ix = off + bj * HALF; f32x4 b0, b1;
                    if (mode == 0) { b0 = *(const f32x4*)(base + ix); b1 = *(const f32x4*)(base + ix + 4); }
                    else { const u32x4 w0 = *(const u32x4*)(hb + ix);
                        b0 = (f32x4){__uint_as_float(w0.x << 16), __uint_as_float(w0.x & 0xffff0000u), __uint_as_float(w0.y << 16), __uint_as_float(w0.y & 0xffff0000u)};
                        b1 = (f32x4){__uint_as_float(w0.z << 16), __uint_as_float(w0.z & 0xffff0000u), __uint_as_float(w0.w << 16), __uint_as_float(w0.w & 0xffff0000u)}; }
                    const f32x4 v0 = b0 + acc[ai][bj][m][0], v1 = b1 + acc[ai][bj][m][1];
                    if (mode == 2) { *(f32x4*)(out + ix) = v0; *(f32x4*)(out + ix + 4) = v1; }
                    else { u32x4 w; w.x = cvt_pk_bf16(v0.x, v0.y); w.y = cvt_pk_bf16(v0.z, v0.w); w.z = cvt_pk_bf16(v1.x, v1.y); w.w = cvt_pk_bf16(v1.z, v1.w); *(u32x4*)(hb + ix) = w; }
                    q += ((v0.x * v0.x + v0.y * v0.y) + (v0.z * v0.z + v0.w * v0.w)) + ((v1.x * v1.x + v1.y * v1.y) + (v1.z * v1.z + v1.w * v1.w)); }
                q += swz_xor<16>(q);
                { auto r = __builtin_amdgcn_permlane32_swap(__float_as_uint(q), __float_as_uint(q), false, false); q = __uint_as_float(r[0]) + __uint_as_float(r[1]); }
                if (fq == 0) xs[(ai * HALF + wr * 64 + m * 16 + fr) * 4 + wc] = q; }
        asm volatile("s_waitcnt lgkmcnt(0)" ::: "memory"); __builtin_amdgcn_s_barrier(); asm volatile("" ::: "memory");
        const int tid = (wr * 4 + wc) * 64 + ln_;
        if (tid < 256) { const f32x4 p = *(const LAS f32x4*)(xs + tid * 4); rsq[(size_t)(u.pm * BM + tid) * 8 + u.pn] = (p.x + p.y) + (p.z + p.w); }
    }
};
struct EpiGlu {
    static constexpr bool PERM = true;
    const bf16_t* yg; const bf16_t* proj; const float* bias; bf16_t* mix;
    __device__ __forceinline__ void operator()(const f32x4 (&acc)[2][2][4][2], const Unit& u, int wr_, int wc_, int fr_, int fq_) const {
        const int ln_ = lane_id(), fr = ln_ & 15, fq = ln_ >> 4; (void)fr_; (void)fq_; const int wr = wr_, wc = wc_;
        const int row0 = u.pm * BM + wr * 64 + fr, col0 = u.pn * BM + wc * 32 + 8 * fq;
        f32x4 bs[2][2];
#pragma unroll
        for (int bj = 0; bj < 2; ++bj) { bs[bj][0] = *(const f32x4*)(bias + col0 + bj * HALF); bs[bj][1] = *(const f32x4*)(bias + col0 + bj * HALF + 4); }
#pragma unroll
        for (int ai = 0; ai < 2; ++ai)
#pragma unroll
            for (int mh = 0; mh < 2; ++mh) { u32x4 yv[2][2], gv[2][2];
#pragma unroll
                for (int mm = 0; mm < 2; ++mm)
#pragma unroll
                    for (int bj = 0; bj < 2; ++bj) { const int row = row0 + ai * HALF + (2 * mh + mm) * 16, col = col0 + bj * HALF;
                        yv[mm][bj] = *(const u32x4*)(yg + (size_t)row * 512 + col); gv[mm][bj] = *(const u32x4*)(proj + (size_t)row * NP + C_S5G + col); }
#pragma unroll
                for (int mm = 0; mm < 2; ++mm)
#pragma unroll
                    for (int bj = 0; bj < 2; ++bj) { const int m = 2 * mh + mm, row = row0 + ai * HALF + m * 16, col = col0 + bj * HALF;
                        float o[8];
#pragma unroll
                        for (int j = 0; j < 8; ++j) { const unsigned yw = yv[mm][bj][j >> 1], gw = gv[mm][bj][j >> 1];
                            const float y = (j & 1) ? __uint_as_float(yw & 0xffff0000u) : __uint_as_float(yw << 16);
                            const float gt = (j & 1) ? __uint_as_float(gw & 0xffff0000u) : __uint_as_float(gw << 16);
                            const float a = (j < 4 ? acc[ai][bj][m][0][j & 3] : acc[ai][bj][m][1][j & 3]) + (j < 4 ? bs[bj][0][j & 3] : bs[bj][1][j & 3]);
                            o[j] = y * sigmoidf_(a) * siluf_(gt); }
                        u32x4 w; w.x = cvt_pk_bf16(o[0], o[1]); w.y = cvt_pk_bf16(o[2], o[3]); w.z = cvt_pk_bf16(o[4], o[5]); w.w = cvt_pk_bf16(o[6], o[7]);
                        *(u32x4*)(mix + (size_t)row * DM + 512 + col) = w; } }
    }
};
}


__device__ __forceinline__ void wtrans_tile(const float* s, int Nsrc, const float* sc, int mode, bf16_t* d, int K, int n0, int k0, LAS unsigned char* lds, int tid) {
    LAS bf16_t* T = (LAS bf16_t*)lds;
    const int q = tid & 63, kp = tid >> 6;
    int sn = n0 + 4 * q; if (mode == 1) sn = win_src_col(sn);
#pragma unroll
    for (int i = 0; i < 4; ++i) { const int k = 2 * (kp + 8 * i);
        f32x4 a = (f32x4){0.f, 0.f, 0.f, 0.f}, b = a;
        if (sn >= 0) { a = *(const f32x4*)(s + (size_t)(k0 + k) * Nsrc + sn); b = *(const f32x4*)(s + (size_t)(k0 + k + 1) * Nsrc + sn);
            if (sc) { const float s0 = sc[k0 + k], s1 = sc[k0 + k + 1]; a = a * s0; b = b * s1; } }
        const int ks_ = (((k >> 3) ^ (q & 7)) << 3) | (k & 7);
        *(LAS unsigned*)(T + (4 * q + 0) * 72 + ks_) = pk2(a.x, b.x); *(LAS unsigned*)(T + (4 * q + 1) * 72 + ks_) = pk2(a.y, b.y);
        *(LAS unsigned*)(T + (4 * q + 2) * 72 + ks_) = pk2(a.z, b.z); *(LAS unsigned*)(T + (4 * q + 3) * 72 + ks_) = pk2(a.w, b.w); }
    __syncthreads();
#pragma unroll
    for (int i = 0; i < 4; ++i) { const int ci = tid + 512 * i, n = ci >> 3, cc = ci & 7;
        *(u32x4*)(d + (size_t)(n0 + n) * K + k0 + cc * 8) = *(const LAS u32x4*)(T + n * 72 + ((cc ^ ((n >> 2) & 7)) * 8)); }
    __syncthreads();
}
__device__ __forceinline__ void s5prep_item(int i, const float* a_re, const float* a_im, const float* log_dt, const float* b_re, const float* b_im, float* abar, float* bbar, float* abar64, bf16_t* bmp) {
    const int lg = i / 64;
    const double are = a_re[i], aim = a_im[i], delta = exp((double)log_dt[lg]);
    const double mag = exp(are * delta), abr = mag * cos(aim * delta), abi = mag * sin(aim * delta), den = are * are + aim * aim;
    const double cr = ((abr - 1.0) * are + abi * aim) / den, ci = (abi * are - (abr - 1.0) * aim) / den;
    abar[2 * i] = (float)abr; abar[2 * i + 1] = (float)abi;
    { const double m64 = exp(64.0 * are * delta); abar64[2 * i] = (float)(m64 * cos(64.0 * aim * delta)); abar64[2 * i + 1] = (float)(m64 * sin(64.0 * aim * delta)); }
#pragma unroll
    for (int j = 0; j < 16; ++j) { const double br = b_re[(size_t)i * 16 + j], bi = b_im[(size_t)i * 16 + j];
        bbar[(size_t)i * 32 + j] = (float)(cr * br - ci * bi); bbar[(size_t)i * 32 + 16 + j] = (float)(cr * bi + ci * br); }
    {
        const int n = i & 63; bf16_t* r0 = bmp + ((size_t)lg * 128 + n) * 32; bf16_t* r1 = bmp + ((size_t)lg * 128 + 64 + n) * 32;
#pragma unroll
        for (int j = 0; j < 16; ++j) { r0[j] = (bf16_t)f2bf(bbar[(size_t)i * 32 + j]); r1[j] = (bf16_t)f2bf(bbar[(size_t)i * 32 + 16 + j]); r0[16 + j] = 0; r1[16 + j] = 0; } }
}
__device__ __forceinline__ void s5prep_lane(int i, int j, const float* a_re, const float* a_im, const float* log_dt, const float* b_re, const float* b_im, float* abar, float* bbar, float* abar64, bf16_t* bmp) {
    const int lg = i / 64;
    const double are = a_re[i], aim = a_im[i], delta = exp((double)log_dt[lg]);
    const double mag = exp(are * delta), abr = mag * cos(aim * delta), abi = mag * sin(aim * delta), den = are * are + aim * aim;
    const double cr = ((abr - 1.0) * are + abi * aim) / den, ci = (abi * are - (abr - 1.0) * aim) / den;
    if (j == 0) { abar[2 * i] = (float)abr; abar[2 * i + 1] = (float)abi;
        const double m64 = exp(64.0 * are * delta); abar64[2 * i] = (float)(m64 * cos(64.0 * aim * delta)); abar64[2 * i + 1] = (float)(m64 * sin(64.0 * aim * delta)); }
    const double br = b_re[(size_t)i * 16 + j], bi = b_im[(size_t)i * 16 + j];
    const float v0 = (float)(cr * br - ci * bi), v1 = (float)(cr * bi + ci * br);
    bbar[(size_t)i * 32 + j] = v0; bbar[(size_t)i * 32 + 16 + j] = v1;
    const int n = i & 63; bf16_t* r0 = bmp + ((size_t)lg * 128 + n) * 32; bf16_t* r1 = bmp + ((size_t)lg * 128 + 64 + n) * 32;
    r0[j] = (bf16_t)f2bf(v0); r1[j] = (bf16_t)f2bf(v1); r0[16 + j] = 0; r1[16 + j] = 0;
}
__device__ __forceinline__ void k_rowprep(const float* h, bf16_t* hb, float* rstd, int lane, int gw, int ngw) {
    for (int row = gw; row < TOK; row += ngw) {
        const f32x4* xr = (const f32x4*)(h + (size_t)row * DM) + lane; f32x4 v[8]; float s = 0.f;
#pragma unroll
        for (int j = 0; j < 8; ++j) { v[j] = xr[64 * j]; s += (v[j].x * v[j].x + v[j].y * v[j].y) + (v[j].z * v[j].z + v[j].w * v[j].w); }
        s = wave_sum(s);
        if (lane < 8) rstd[(size_t)row * 8 + lane] = (lane == 0) ? s : 0.f;
        u32x2* o = (u32x2*)(hb + (size_t)row * DM) + lane;
#pragma unroll
        for (int j = 0; j < 8; ++j) { u32x2 w; w.x = pk2(v[j].x, v[j].y); w.y = pk2(v[j].z, v[j].w); o[64 * j] = w; }
    }
}

struct LayerP {
    const float *conv_w, *conv_b, *dt_bias, *a_log, *ssd_d, *ssd_norm_w;
    const float *s5_c_re, *s5_c_im, *s5_d, *abar, *bbar;
    const float *gla_w2, *gla_gb, *gla_norm_w;
    const float *qh_w, *kh_w;
    const int* pos;
    const bf16_t* proj; const float* dtf;
    float *xbcc, *dtv, *ys, *hs, *eg, *og;
    bf16_t *yg, *mix, *qraw, *kvraw, *qf, *kf, *vf, *vt;
    bf16_t *xbcn, *xT, *hin; float *csv, *cse, *sst; unsigned* cnt_ssd;
    bf16_t *qt, *kt, *vT2, *gin; float *glb, *gst; unsigned* cnt_gla; unsigned* cnt_mla;
    const float* abar64; float *s5st, *s5in; unsigned* cnt_s5; const bf16_t *bmp, *cmp; unsigned* cnt_s5b;
};
__device__ __forceinline__ void mla_fin4(const LayerP& P, LAS unsigned char* lds, int lane, int wave, int slice0) {
    { const int tid = wave * 64 + lane; const u32x4* gq = (const u32x4*)(P.qraw + (size_t)slice0 * 768); const u32x4* gk = (const u32x4*)(P.kvraw + (size_t)slice0 * 1024); u32x4 tq[6], tk[8];
#pragma unroll
      for (int i = 0; i < 6; ++i) tq[i] = gq[tid + 512 * i];
#pragma unroll
      for (int i = 0; i < 8; ++i) tk[i] = gk[tid + 512 * i];
#pragma unroll
      for (int i = 0; i < 6; ++i) *(LAS u32x4*)(lds + (size_t)(tid + 512 * i) * 16) = tq[i];
#pragma unroll
      for (int i = 0; i < 8; ++i) *(LAS u32x4*)(lds + 49152 + (size_t)(tid + 512 * i) * 16) = tk[i];
      __syncthreads(); }
    const int tok0 = slice0 + wave * 4;
    const int b = tok0 / SEQ, s0 = tok0 % SEQ;
    bf16_t qraw_[4][4][3], kraw_[4][4][4];
#pragma unroll
    for (int h = 0; h < 4; ++h)
#pragma unroll
        for (int t = 0; t < 4; ++t) { const LAS bf16_t* qr = (const LAS bf16_t*)lds + (wave * 4 + t) * 768 + h * 192 + lane; const LAS bf16_t* kr = (const LAS bf16_t*)(lds + 49152) + (wave * 4 + t) * 1024 + h * 256 + lane;
            qraw_[h][t][0] = qr[0]; qraw_[h][t][1] = qr[64]; qraw_[h][t][2] = qr[128]; kraw_[h][t][0] = kr[0]; kraw_[h][t][1] = kr[64]; kraw_[h][t][2] = kr[128]; kraw_[h][t][3] = kr[192]; }
    float kpe[4], posf[4]; u32x4 cw[4];
#pragma unroll
    for (int t = 0; t < 4; ++t) { const bf16_t* pr = P.proj + (size_t)(tok0 + t) * NP;
        cw[t] = *(const u32x4*)(pr + C_CQ + lane * 8); kpe[t] = bf2f(pr[C_KPE + lane]); posf[t] = (float)P.pos[tok0 + t]; }
    float rq[4], rk[4], cs[4], sn[4];
    const float inv_freq = __builtin_amdgcn_exp2f(-(float)(lane & 31) * (13.287712379549449f / 32.0f));
#pragma unroll
    for (int t = 0; t < 4; ++t) { float sq = 0.f;
#pragma unroll
        for (int j = 0; j < 4; ++j) { const float lo = __uint_as_float(cw[t][j] << 16), hi = __uint_as_float(cw[t][j] & 0xffff0000u); sq += lo * lo + hi * hi; }
        rq[t] = (lane < 48) ? sq : 0.f; rk[t] = (lane < 48) ? 0.f : sq;
        const float rev = __builtin_amdgcn_fractf(posf[t] * inv_freq * 0.15915494309189535f); cs[t] = __builtin_amdgcn_cosf(rev); sn[t] = __builtin_amdgcn_sinf(rev); }
#pragma unroll
    for (int t = 0; t < 4; ++t) { rq[t] = frsq(wave_sum(rq[t]) * (1.0f / 384.f) + EPS); rk[t] = frsq(wave_sum(rk[t]) * (1.0f / 128.f) + EPS); }
    const float wq0 = P.qh_w[lane], wq1 = P.qh_w[64 + lane], wq2 = P.qh_w[128 + lane], wk0 = P.kh_w[lane], wk1 = P.kh_w[64 + lane], wk2 = P.kh_w[128 + lane];
#pragma unroll
    for (int h = 0; h < 4; ++h) {
        float q[4][3], k[4][2], v[4][2];
#pragma unroll
        for (int t = 0; t < 4; ++t) { q[t][0] = bf2f(qraw_[h][t][0]); q[t][1] = bf2f(qraw_[h][t][1]); q[t][2] = bf2f(qraw_[h][t][2]); k[t][0] = bf2f(kraw_[h][t][0]); k[t][1] = bf2f(kraw_[h][t][1]); v[t][0] = bf2f(kraw_[h][t][2]); v[t][1] = bf2f(kraw_[h][t][3]); }
        float nq[4], nk[4];
#pragma unroll
        for (int t = 0; t < 4; ++t) { q[t][0] *= rq[t]; q[t][1] *= rq[t]; q[t][2] *= rq[t]; k[t][0] *= rk[t]; k[t][1] *= rk[t];
            nq[t] = q[t][0] * q[t][0] + q[t][1] * q[t][1] + q[t][2] * q[t][2]; nk[t] = k[t][0] * k[t][0] + k[t][1] * k[t][1] + kpe[t] * kpe[t]; }
#pragma unroll
        for (int t = 0; t < 4; ++t) { nq[t] = frsq(wave_sum(nq[t]) * (1.0f / 192.f) + EPS); nk[t] = frsq(wave_sum(nk[t]) * (1.0f / 192.f) + EPS); }
#pragma unroll
        for (int t = 0; t < 4; ++t) { const size_t ob = ((size_t)(b * 4 + h) * SEQ + s0 + t) * 192;
            const float a0 = q[t][0] * nq[t] * wq0, a1 = q[t][1] * nq[t] * wq1, a2 = q[t][2] * nq[t] * wq2, oa = xor32_other(a2, lane);
            const float ra = (lane < 32) ? (a2 * cs[t] - oa * sn[t]) : (a2 * cs[t] + oa * sn[t]);
            bf16_t* qo = P.qf + ob; qo[lane] = (bf16_t)f2bf(a0); qo[64 + lane] = (bf16_t)f2bf(a1); qo[128 + lane] = (bf16_t)f2bf(ra);
            const float b0 = k[t][0] * nk[t] * wk0, b1 = k[t][1] * nk[t] * wk1, b2 = kpe[t] * nk[t] * wk2, ob2 = xor32_other(b2, lane);
            const float rb = (lane < 32) ? (b2 * cs[t] - ob2 * sn[t]) : (b2 * cs[t] + ob2 * sn[t]);
            bf16_t* ko = P.kf + ob; ko[lane] = (bf16_t)f2bf(b0); ko[64 + lane] = (bf16_t)f2bf(b1); ko[128 + lane] = (bf16_t)f2bf(rb); }
        bf16_t* vo = P.vt + (size_t)(b * 4 + h) * 128 * SEQ + (size_t)(s0 >> 6) * (128 * 64) + (s0 & 63);
        u32x2 w0, w1; w0.x = pk2(v[0][0] * rk[0], v[1][0] * rk[1]); w0.y = pk2(v[2][0] * rk[2], v[3][0] * rk[3]); w1.x = pk2(v[0][1] * rk[0], v[1][1] * rk[1]); w1.y = pk2(v[2][1] * rk[2], v[3][1] * rk[3]);
        *(u32x2*)(vo + (size_t)lane * 64) = w0; *(u32x2*)(vo + (size_t)(64 + lane) * 64) = w1;
    }
}

__device__ __forceinline__ void job_publish(unsigned* flag, int tid) {
    asm volatile("s_waitcnt vmcnt(0)" ::: "memory");
    __syncthreads();
    if (tid == 0) { __builtin_amdgcn_fence(__ATOMIC_RELEASE, "agent"); asm volatile("s_waitcnt vmcnt(0)" ::: "memory");
        (void)__hip_atomic_fetch_add(flag, 1u, __ATOMIC_RELAXED, __HIP_MEMORY_SCOPE_AGENT); }
}
__device__ __forceinline__ void job_wait(unsigned* flag, unsigned need, int tid) {
    if (tid == 0) { unsigned sp = 0;
        while (__hip_atomic_load(flag, __ATOMIC_RELAXED, __HIP_MEMORY_SCOPE_AGENT) < need) { __builtin_amdgcn_s_sleep(2); if (++sp > (1u << 24)) break; }
        __builtin_amdgcn_fence(__ATOMIC_ACQUIRE, "agent"); asm volatile("s_waitcnt vmcnt(0)" ::: "memory"); }
    __syncthreads();
}
__device__ __forceinline__ int queue_pop(unsigned* q, volatile LAS unsigned* slot, int tid) {
    if (tid == 448) slot[0] = __hip_atomic_fetch_add(q, 1u, __ATOMIC_RELAXED, __HIP_MEMORY_SCOPE_AGENT);
    __syncthreads(); const unsigned v = slot[0]; __syncthreads(); return __builtin_amdgcn_readfirstlane((int)v);
}
__device__ __forceinline__ u32x2 pk4(const f32x4& v) { u32x2 w; w.x = pk2(v.x, v.y); w.y = pk2(v.z, v.w); return w; }

constexpr int SA_XT = 0, SA_BT = 8 * 64 * 72 * 2, SA_AA = SA_BT + 2 * 64 * 72 * 2, SA_WW = SA_AA + 2048, SA_FLAG = SA_WW + 2048;
__device__ __forceinline__ bf16x8 scale_frag(bf16x8 v, const float (&w)[8]) {
    bf16x8 o;
#pragma unroll
    for (int j = 0; j < 8; j += 2) { const unsigned pk = pk2(bf2f((bf16_t)v[j]) * w[j], bf2f((bf16_t)v[j + 1]) * w[j + 1]); o[j] = (short)(pk & 0xffffu); o[j + 1] = (short)(pk >> 16); }
    return o;
}
__device__ __forceinline__ void ssd_passA(const LayerP& P, LAS unsigned char* lds, int item, int wave, int lane, bool arrive = true) {
    const int b = item >> 5, c = item & 31, tid = wave * 64 + lane, s0 = c * 64; const size_t tok0 = (size_t)b * SEQ + s0;
    LAS bf16_t* XT = (LAS bf16_t*)(lds + SA_XT); LAS bf16_t* BT = (LAS bf16_t*)(lds + SA_BT); LAS float* AA = (LAS float*)(lds + SA_AA); LAS float* WW = (LAS float*)(lds + SA_WW);
    volatile LAS unsigned* FLG = (volatile LAS unsigned*)(lds + SA_FLAG);
    if (tid < 384) {
        const int cc = tid % 96, seg = tid / 96, ch0 = cc * 8, t0 = seg * 16;
        u32x4 raw[19];
#pragma unroll
        for (int i = 0; i < 19; ++i) { const int row = t0 - 3 + i;
            raw[i] = (s0 + row >= 0) ? *(const u32x4*)(P.proj + (size_t)((long)tok0 + row) * NP + C_XBC + ch0) : (u32x4){0u, 0u, 0u, 0u}; }
        float w[4][8], bb[8];
#pragma unroll
        for (int k = 0; k < 4; ++k) { const f32x4 a = *(const f32x4*)(P.conv_w + k * 768 + ch0), b2 = *(const f32x4*)(P.conv_w + k * 768 + ch0 + 4);
            w[k][0] = a.x; w[k][1] = a.y; w[k][2] = a.z; w[k][3] = a.w; w[k][4] = b2.x; w[k][5] = b2.y; w[k][6] = b2.z; w[k][7] = b2.w; }
        { const f32x4 a = *(const f32x4*)(P.conv_b + ch0), b2 = *(const f32x4*)(P.conv_b + ch0 + 4); bb[0] = a.x; bb[1] = a.y; bb[2] = a.z; bb[3] = a.w; bb[4] = b2.x; bb[5] = b2.y; bb[6] = b2.z; bb[7] = b2.w; }
        LAS bf16_t* TT = (ch0 < 512) ? (XT + ch0 * 72) : (BT + (ch0 - 512) * 72);
#pragma unroll
        for (int t = 0; t < 16; ++t) {
            float o[8];
#pragma unroll
            for (int c = 0; c < 8; ++c) { float a = bb[c];
#pragma unroll
                for (int k = 0; k < 4; ++k) { const unsigned wd = raw[t + k][c >> 1]; const float x = (c & 1) ? __uint_as_float(wd & 0xffff0000u) : __uint_as_float(wd << 16); a += w[k][c] * x; }
                o[c] = siluf_(a); }
            u32x4 pk; pk.x = pk2(o[0], o[1]); pk.y = pk2(o[2], o[3]); pk.z = pk2(o[4], o[5]); pk.w = pk2(o[6], o[7]);
            *(u32x4*)(P.xbcn + (tok0 + t0 + t) * 768 + ch0) = pk;
            if (ch0 < 640) {
#pragma unroll
                for (int c = 0; c < 8; ++c) TT[c * 72 + (((((t0 + t) >> 3) ^ (cc & 7)) << 3) | ((t0 + t) & 7))] = (bf16_t)((c & 1) ? (pk[c >> 1] >> 16) : (pk[c >> 1] & 0xffffu)); }
        }
    }
    {
        const int h = wave; const float A = -fexp(P.a_log[h]);
        const float dt = softplusf_(P.dtf[(tok0 + lane) * 8 + h] + P.dt_bias[h]);
        AA[h * 64 + lane] = dt * A;
        asm volatile("s_waitcnt lgkmcnt(0)" ::: "memory");
        float cs = 0.f;
        for (int s = 0; s < 64; ++s) { const float av = AA[h * 64 + s]; cs += (s <= lane) ? av : 0.f; }
        const float cend = __int_as_float(__builtin_amdgcn_readlane(__float_as_int(cs), 63));
        P.dtv[(tok0 + lane) * 8 + h] = dt; P.csv[(tok0 + lane) * 8 + h] = cs;
        WW[h * 64 + lane] = fexp(cend - cs) * dt;
        if (lane == 63) P.cse[(size_t)(b * 32 + c) * 8 + h] = cs;
    }
    __syncthreads();
#pragma unroll
    for (int k = 0; k < 8; ++k) { const int ci = tid + 512 * k, row = ci >> 3, cc = ci & 7;
        const u32x4 v = *(const LAS u32x4*)(XT + row * 72 + ((cc ^ ((row >> 3) & 7)) * 8));
        *(u32x4*)(P.xT + ((size_t)(b * 8 + (row >> 6)) * 64 + (row & 63)) * SEQ + s0 + cc * 8) = v; }
    {
        const int h = wave, g = h >> 2, fr = lane & 15, fq = lane >> 4;
        f32x4 acc[4][4];
#pragma unroll
        for (int i = 0; i < 4; ++i)
#pragma unroll
            for (int j = 0; j < 4; ++j) acc[i][j] = (f32x4){0.f, 0.f, 0.f, 0.f};
#pragma unroll
        for (int ks = 0; ks < 2; ++ks) {
            float wv[8];
#pragma unroll
            for (int j = 0; j < 8; ++j) wv[j] = WW[h * 64 + ks * 32 + fq * 8 + j];
            bf16x8 bfr[4];
#pragma unroll
            for (int nt = 0; nt < 4; ++nt) { const int brow = g * 64 + nt * 16 + fr; bfr[nt] = *(const LAS bf16x8*)(BT + brow * 72 + (((ks * 4 + fq) ^ ((brow >> 3) & 7)) * 8)); }
#pragma unroll
            for (int pt = 0; pt < 4; ++pt) { const int xrow = h * 64 + pt * 16 + fr; const bf16x8 af = scale_frag(*(const LAS bf16x8*)(XT + xrow * 72 + (((ks * 4 + fq) ^ ((xrow >> 3) & 7)) * 8)), wv);
#pragma unroll
                for (int nt = 0; nt < 4; ++nt) acc[pt][nt] = __builtin_amdgcn_mfma_f32_16x16x32_bf16(af, bfr[nt], acc[pt][nt], 0, 0, 0); }
        }
        float* so = P.sst + ((size_t)(b * 32 + c) * 8 + h) * 4096;
#pragma unroll
        for (int pt = 0; pt < 4; ++pt)
#pragma unroll
            for (int nt = 0; nt < 4; ++nt)
#pragma unroll
                for (int r = 0; r < 4; ++r) so[(pt * 16 + fq * 4 + r) * 64 + nt * 16 + fr] = acc[pt][nt][r];
    }
    job_publish(P.cnt_ssd + 64 * (item >> 5), wave * 64 + lane);
}
constexpr int SB_M = 0, SB_RS = 8 * 64 * 72 * 2;
__device__ __forceinline__ void ssd_passB(const LayerP& P, LAS unsigned char* lds, int item, int wave, int lane) {
    const int b = item >> 5, c = item & 31, s0 = c * 64, h = wave, g = h >> 2, fr = lane & 15, fq = lane >> 4; const size_t tok0 = (size_t)b * SEQ + s0;
    LAS bf16_t* Mw = (LAS bf16_t*)(lds + SB_M) + wave * 64 * 72; LAS float* RS = (LAS float*)(lds + SB_RS);
    bf16x8 cfr[4][2], bfr[4][2];
#pragma unroll
    for (int t = 0; t < 4; ++t)
#pragma unroll
        for (int ks = 0; ks < 2; ++ks) {
            cfr[t][ks] = *(const bf16x8*)(P.xbcn + (tok0 + t * 16 + fr) * 768 + 640 + g * 64 + ks * 32 + fq * 8);
            bfr[t][ks] = *(const bf16x8*)(P.xbcn + (tok0 + t * 16 + fr) * 768 + 512 + g * 64 + ks * 32 + fq * 8); }
    float cst[4][4], css[4], dts[4];
#pragma unroll
    for (int tt = 0; tt < 4; ++tt)
#pragma unroll
        for (int r = 0; r < 4; ++r) cst[tt][r] = P.csv[(tok0 + tt * 16 + fq * 4 + r) * 8 + h];
#pragma unroll
    for (int st = 0; st < 4; ++st) { css[st] = P.csv[(tok0 + st * 16 + fr) * 8 + h]; dts[st] = P.dtv[(tok0 + st * 16 + fr) * 8 + h]; }
#pragma unroll
    for (int tt = 0; tt < 4; ++tt)
#pragma unroll
        for (int st = 0; st < 4; ++st) {
            f32x4 G = (f32x4){0.f, 0.f, 0.f, 0.f};
            if (st <= tt) {
#pragma unroll
                for (int ks = 0; ks < 2; ++ks) G = __builtin_amdgcn_mfma_f32_16x16x32_bf16(cfr[tt][ks], bfr[st][ks], G, 0, 0, 0);
            }
#pragma unroll
            for (int r = 0; r < 4; ++r) { const int t = tt * 16 + fq * 4 + r, s = st * 16 + fr;
                const float v = (st <= tt && s <= t) ? G[r] * fexp(cst[tt][r] - css[st]) * dts[st] : 0.f;
                Mw[t * 72 + s] = (bf16_t)f2bf(v); }
        }
    u32x4 xc[8], zc[8];
#pragma unroll
    for (int k = 0; k < 8; ++k) { const size_t tok = tok0 + (lane >> 3) + 8 * k; xc[k] = *(const u32x4*)(P.xbcn + tok * 768 + h * 64 + (lane & 7) * 8); zc[k] = *(const u32x4*)(P.proj + tok * NP + C_Z + h * 64 + (lane & 7) * 8); }
    f32x4 Y[4][4];
    {
        const bf16_t* hb = P.hin + ((size_t)(b * 32 + c) * 8 + h) * 4096;
        bf16x8 hfr[4][2];
#pragma unroll
        for (int pt = 0; pt < 4; ++pt)
#pragma unroll
            for (int ks = 0; ks < 2; ++ks) hfr[pt][ks] = *(const bf16x8*)(hb + (pt * 16 + fr) * 64 + ks * 32 + fq * 8);
#pragma unroll
        for (int tt = 0; tt < 4; ++tt)
#pragma unroll
            for (int pt = 0; pt < 4; ++pt) { f32x4 a = (f32x4){0.f, 0.f, 0.f, 0.f};
#pragma unroll
                for (int ks = 0; ks < 2; ++ks) a = __builtin_amdgcn_mfma_f32_16x16x32_bf16(cfr[tt][ks], hfr[pt][ks], a, 0, 0, 0);
#pragma unroll
                for (int r = 0; r < 4; ++r) a[r] *= fexp(cst[tt][r]);
                Y[tt][pt] = a; }
    }
    {
        bf16x8 xfr[4][2];
#pragma unroll
        for (int pt = 0; pt < 4; ++pt)
#pragma unroll
            for (int ks = 0; ks < 2; ++ks) xfr[pt][ks] = *(const bf16x8*)(P.xT + ((size_t)(b * 8 + h) * 64 + pt * 16 + fr) * SEQ + s0 + ks * 32 + fq * 8);
        asm volatile("s_waitcnt lgkmcnt(0)" ::: "memory");
#pragma unroll
        for (int tt = 0; tt < 4; ++tt)
#pragma unroll
            for (int ks = 0; ks < 2; ++ks) { if (ks * 32 > tt * 16 + 15) continue;
                const bf16x8 af = *(const LAS bf16x8*)(Mw + (tt * 16 + fr) * 72 + ks * 32 + fq * 8);
#pragma unroll
                for (int pt = 0; pt < 4; ++pt) Y[tt][pt] = __builtin_amdgcn_mfma_f32_16x16x32_bf16(af, xfr[pt][ks], Y[tt][pt], 0, 0, 0); }
    }
#pragma unroll
    for (int tt = 0; tt < 4; ++tt)
#pragma unroll
        for (int pt = 0; pt < 4; ++pt)
#pragma unroll
            for (int r = 0; r < 4; ++r) Mw[(tt * 16 + fq * 4 + r) * 72 + pt * 16 + fr] = (bf16_t)f2bf(Y[tt][pt][r]);
    asm volatile("s_waitcnt lgkmcnt(0)" ::: "memory");
    const float Dh = P.ssd_d[h];
    const int ck = lane & 7, tq = lane >> 3;
    float nw[8];
    { const f32x4 a = *(const f32x4*)(P.ssd_norm_w + h * 64 + ck * 8), b2 = *(const f32x4*)(P.ssd_norm_w + h * 64 + ck * 8 + 4); nw[0] = a.x; nw[1] = a.y; nw[2] = a.z; nw[3] = a.w; nw[4] = b2.x; nw[5] = b2.y; nw[6] = b2.z; nw[7] = b2.w; }
    float v[8][8];
#pragma unroll
    for (int k = 0; k < 8; ++k) { const int t = tq + 8 * k; const u32x4 yv = *(const LAS u32x4*)(Mw + t * 72 + ck * 8); float q = 0.f;
#pragma unroll
        for (int jj = 0; jj < 8; ++jj) { const unsigned yw = yv[jj >> 1], xw = xc[k][jj >> 1], zw = zc[k][jj >> 1];
            const float y = (jj & 1) ? __uint_as_float(yw & 0xffff0000u) : __uint_as_float(yw << 16), x = (jj & 1) ? __uint_as_float(xw & 0xffff0000u) : __uint_as_float(xw << 16), z = (jj & 1) ? __uint_as_float(zw & 0xffff0000u) : __uint_as_float(zw << 16);
            const float vv = (y + Dh * x) * siluf_(z); v[k][jj] = vv; q += vv * vv; }
        q += swz_xor<1>(q); q += swz_xor<2>(q); q += swz_xor<4>(q);
        if (ck == 0) RS[h * 64 + t] = q; }
    __syncthreads();
#pragma unroll
    for (int k = 0; k < 8; ++k) { const int t = tq + 8 * k; float tot = 0.f;
#pragma unroll
        for (int hh = 0; hh < 8; ++hh) tot += RS[hh * 64 + t];
        const float rn = frsq(tot * (1.0f / 512.f) + EPS);
        u32x4 w; w.x = pk2(v[k][0] * rn * nw[0], v[k][1] * rn * nw[1]); w.y = pk2(v[k][2] * rn * nw[2], v[k][3] * rn * nw[3]); w.z = pk2(v[k][4] * rn * nw[4], v[k][5] * rn * nw[5]); w.w = pk2(v[k][6] * rn * nw[6], v[k][7] * rn * nw[7]);
        *(u32x4*)(P.mix + (tok0 + t) * DM + h * 64 + ck * 8) = w; }
    __syncthreads();
}

constexpr int GA_KH = 0, GA_VT = 256 * 72 * 2, GA_HT = GA_VT + 512 * 72 * 2, GA_FLAG = GA_HT + 2048, GA_GL = GA_FLAG + 64;
__device__ __forceinline__ float logsig16(float x) { return (fminf(x, 0.f) - log1p_small(fexp(-fabsf(x)))) * (1.0f / 16.0f); }
__device__ __forceinline__ void gla_passA(const LayerP& P, LAS unsigned char* lds, int item, int wave, int lane, bool arrive = true) {
    const int b = item >> 5, c = item & 31, tid = wave * 64 + lane, s0 = c * 64; const size_t tok0 = (size_t)b * SEQ + s0;
    LAS bf16_t* KH = (LAS bf16_t*)(lds + GA_KH); LAS bf16_t* VT = (LAS bf16_t*)(lds + GA_VT); LAS float* HT = (LAS float*)(lds + GA_HT);
    volatile LAS unsigned* FLG = (volatile LAS unsigned*)(lds + GA_FLAG);
    const int j = tid & 255, half = tid >> 8;
    LAS bf16_t* QS = (LAS bf16_t*)(lds + GA_VT); LAS bf16_t* KS = QS + 64 * 256; LAS bf16_t* GL = (LAS bf16_t*)(lds + GA_GL);
    u32x4 vreg[8], qreg[4], kreg[4], greg = (u32x4){0u, 0u, 0u, 0u};
#pragma unroll
    for (int k = 0; k < 8; ++k) { const int ci = tid + 512 * k; vreg[k] = *(const u32x4*)(P.proj + (tok0 + (ci >> 6)) * NP + C_GV + (ci & 63) * 8); }
#pragma unroll
    for (int k = 0; k < 4; ++k) { const int ci = tid + 512 * k; qreg[k] = *(const u32x4*)(P.proj + (tok0 + (ci >> 5)) * NP + C_GQ + (ci & 31) * 8); kreg[k] = *(const u32x4*)(P.proj + (tok0 + (ci >> 5)) * NP + C_GK + (ci & 31) * 8); }
    if (tid < 128) greg = *(const u32x4*)(P.proj + (tok0 + (tid >> 1)) * NP + C_GLR + (tid & 1) * 8);
    float w2[16];
#pragma unroll
    for (int r = 0; r < 16; ++r) w2[r] = P.gla_w2[r * 256 + j];
    const float gb = P.gla_gb[j];
#pragma unroll
    for (int k = 0; k < 4; ++k) { const int ci = tid + 512 * k; *(LAS u32x4*)(QS + (ci >> 5) * 256 + (ci & 31) * 8) = qreg[k]; *(LAS u32x4*)(KS + (ci >> 5) * 256 + (ci & 31) * 8) = kreg[k]; }
    if (tid < 128) *(LAS u32x4*)(GL + (tid >> 1) * 16 + (tid & 1) * 8) = greg;
    __syncthreads();
    float gl[32]; float run = 0.f;
#pragma unroll
    for (int i = 0; i < 32; ++i) { const int t = half * 32 + i; const u32x4 g0 = *(const LAS u32x4*)(GL + t * 16), g1 = *(const LAS u32x4*)(GL + t * 16 + 8);
        float x = gb;
#pragma unroll
        for (int r = 0; r < 8; ++r) { const unsigned wlo = g0[r >> 1], whi = g1[r >> 1];
            x += ((r & 1) ? __uint_as_float(wlo & 0xffff0000u) : __uint_as_float(wlo << 16)) * w2[r] + ((r & 1) ? __uint_as_float(whi & 0xffff0000u) : __uint_as_float(whi << 16)) * w2[8 + r]; }
        gl[i] = logsig16(x); run += gl[i]; }
    HT[half * 256 + j] = run;
    __syncthreads();
    const float off = half ? HT[j] : 0.f, blast = HT[j] + HT[256 + j];
    if (half == 0) P.glb[(size_t)(b * 32 + c) * 256 + j] = blast;
    run = off;
#pragma unroll
    for (int i = 0; i < 32; ++i) { const int t = half * 32 + i; const size_t tok = tok0 + t;
        run += gl[i];
        const float q = bf2f(QS[t * 256 + j]), k = bf2f(KS[t * 256 + j]);
        P.qt[tok * 256 + j] = (bf16_t)f2bf(q * 0.125f * fexp(run));
        P.kt[tok * 256 + j] = (bf16_t)f2bf(k * fexp(-run));
        KH[j * 72 + t] = (bf16_t)f2bf(k * fexp(blast - run)); }
    __syncthreads();
#pragma unroll
    for (int k = 0; k < 8; ++k) { const int ci = tid + 512 * k, t = ci >> 6, e0 = (ci & 63) * 8;
#pragma unroll
        for (int cI = 0; cI < 8; ++cI) VT[(e0 + cI) * 72 + ((((t >> 3) ^ ((e0 >> 3) & 7)) << 3) | (t & 7))] = (bf16_t)((cI & 1) ? (vreg[k][cI >> 1] >> 16) : (vreg[k][cI >> 1] & 0xffffu)); }
    __syncthreads();
#pragma unroll
    for (int k = 0; k < 8; ++k) { const int ci = tid + 512 * k, row = ci >> 3, cc = ci & 7;
        const u32x4 v = *(const LAS u32x4*)(VT + row * 72 + ((cc ^ ((row >> 3) & 7)) * 8));
        *(u32x4*)(P.vT2 + ((size_t)(b * 4 + (row >> 7)) * 128 + (row & 127)) * SEQ + s0 + cc * 8) = v; }
    {
        const int h = wave >> 1, eh = wave & 1, fr = lane & 15, fq = lane >> 4;
        f32x4 acc[4][4];
#pragma unroll
        for (int i = 0; i < 4; ++i)
#pragma unroll
            for (int jj = 0; jj < 4; ++jj) acc[i][jj] = (f32x4){0.f, 0.f, 0.f, 0.f};
#pragma unroll
        for (int ks = 0; ks < 2; ++ks) {
            bf16x8 kf[4];
#pragma unroll
            for (int dt = 0; dt < 4; ++dt) kf[dt] = *(const LAS bf16x8*)(KH + (h * 64 + dt * 16 + fr) * 72 + ks * 32 + fq * 8);
#pragma unroll
            for (int et = 0; et < 4; ++et) { const int vrow = h * 128 + eh * 64 + et * 16 + fr; const bf16x8 vf = *(const LAS bf16x8*)(VT + vrow * 72 + (((ks * 4 + fq) ^ ((vrow >> 3) & 7)) * 8));
#pragma unroll
                for (int dt = 0; dt < 4; ++dt) acc[et][dt] = __builtin_amdgcn_mfma_f32_16x16x32_bf16(vf, kf[dt], acc[et][dt], 0, 0, 0); }
        }
        float* so = P.gst + ((size_t)(b * 32 + c) * 4 + h) * 8192 + eh * 4096;
#pragma unroll
        for (int et = 0; et < 4; ++et)
#pragma unroll
            for (int dt = 0; dt < 4; ++dt)
#pragma unroll
                for (int r = 0; r < 4; ++r) so[(et * 16 + fq * 4 + r) * 64 + dt * 16 + fr] = acc[et][dt][r];
    }
    job_publish(P.cnt_gla + 64 * (item >> 5), wave * 64 + lane);
}
__device__ __forceinline__ void gla_passB(const LayerP& P, LAS unsigned char* lds, int item, int wave, int lane) {
    const int b = item >> 5, c = item & 31, s0 = c * 64, h = wave >> 1, half = wave & 1, fr = lane & 15, fq = lane >> 4; const size_t tok0 = (size_t)b * SEQ + s0;
    LAS bf16_t* Pw = (LAS bf16_t*)lds + wave * 32 * 72;
    bf16x8 qfr[2][2];
#pragma unroll
    for (int tt = 0; tt < 2; ++tt)
#pragma unroll
        for (int ks = 0; ks < 2; ++ks) qfr[tt][ks] = *(const bf16x8*)(P.qt + (tok0 + (half * 2 + tt) * 16 + fr) * 256 + h * 64 + ks * 32 + fq * 8);
    {
        bf16x8 kfr[4][2];
#pragma unroll
        for (int st = 0; st < 4; ++st)
#pragma unroll
            for (int ks = 0; ks < 2; ++ks) kfr[st][ks] = *(const bf16x8*)(P.kt + (tok0 + st * 16 + fr) * 256 + h * 64 + ks * 32 + fq * 8);
#pragma unroll
        for (int tt = 0; tt < 2; ++tt)
#pragma unroll
            for (int st = 0; st < 4; ++st) { const int tg = half * 2 + tt;
                f32x4 G = (f32x4){0.f, 0.f, 0.f, 0.f};
                if (st <= tg) {
#pragma unroll
                    for (int ks = 0; ks < 2; ++ks) G = __builtin_amdgcn_mfma_f32_16x16x32_bf16(qfr[tt][ks], kfr[st][ks], G, 0, 0, 0);
                }
#pragma unroll
                for (int r = 0; r < 4; ++r) { const float v = (st < tg || (st == tg && fr <= fq * 4 + r)) ? G[r] : 0.f;
                    Pw[(tt * 16 + fq * 4 + r) * 72 + st * 16 + fr] = (bf16_t)f2bf(v); } }
    }
    u32x4 gc[8];
#pragma unroll
    for (int k = 0; k < 8; ++k) gc[k] = *(const u32x4*)(P.proj + (tok0 + half * 32 + (lane >> 4) + 4 * k) * NP + C_GG + h * 128 + (lane & 15) * 8);
    f32x4 O[2][8];
    {
        const bf16_t* gb = P.gin + ((size_t)(b * 32 + c) * 4 + h) * 8192;
#pragma unroll
        for (int et = 0; et < 8; ++et) { const bf16x8 g0 = *(const bf16x8*)(gb + (et * 16 + fr) * 64 + fq * 8), g1 = *(const bf16x8*)(gb + (et * 16 + fr) * 64 + 32 + fq * 8);
#pragma unroll
            for (int tt = 0; tt < 2; ++tt) { f32x4 a = (f32x4){0.f, 0.f, 0.f, 0.f};
                a = __builtin_amdgcn_mfma_f32_16x16x32_bf16(qfr[tt][0], g0, a, 0, 0, 0); a = __builtin_amdgcn_mfma_f32_16x16x32_bf16(qfr[tt][1], g1, a, 0, 0, 0); O[tt][et] = a; } }
    }
    asm volatile("s_waitcnt lgkmcnt(0)" ::: "memory");
#pragma unroll
    for (int ks = 0; ks < 2; ++ks) { if (ks * 32 > (half * 2 + 1) * 16 + 15) continue;
        bf16x8 pf[2];
#pragma unroll
        for (int tt = 0; tt < 2; ++tt) pf[tt] = *(const LAS bf16x8*)(Pw + (tt * 16 + fr) * 72 + ks * 32 + fq * 8);
#pragma unroll
        for (int et = 0; et < 8; ++et) { const bf16x8 vf = *(const bf16x8*)(P.vT2 + ((size_t)(b * 4 + h) * 128 + et * 16 + fr) * SEQ + s0 + ks * 32 + fq * 8);
#pragma unroll
            for (int tt = 0; tt < 2; ++tt) O[tt][et] = __builtin_amdgcn_mfma_f32_16x16x32_bf16(pf[tt], vf, O[tt][et], 0, 0, 0); } }
    LAS bf16_t* OT = (LAS bf16_t*)(lds + 8 * 32 * 72 * 2) + wave * 32 * 136;
#pragma unroll
    for (int tt = 0; tt < 2; ++tt)
#pragma unroll
        for (int r = 0; r < 4; ++r) { float q = 0.f;
#pragma unroll
            for (int et = 0; et < 8; ++et) q += O[tt][et][r] * O[tt][et][r];
            q = xsum16(q); const float rn = frsq(q * (1.0f / 128.f) + EPS);
#pragma unroll
            for (int et = 0; et < 8; ++et) OT[(tt * 16 + fq * 4 + r) * 136 + et * 16 + fr] = (bf16_t)f2bf(O[tt][et][r] * rn); }
    asm volatile("s_waitcnt lgkmcnt(0)" ::: "memory");
    {
        const int ck = lane & 15, tq = lane >> 4;
        float nw[8];
        { const f32x4 a = *(const f32x4*)(P.gla_norm_w + ck * 8), b2 = *(const f32x4*)(P.gla_norm_w + ck * 8 + 4); nw[0] = a.x; nw[1] = a.y; nw[2] = a.z; nw[3] = a.w; nw[4] = b2.x; nw[5] = b2.y; nw[6] = b2.z; nw[7] = b2.w; }
#pragma unroll
        for (int k = 0; k < 8; ++k) { const int t = tq + 4 * k; const u32x4 yv = *(const LAS u32x4*)(OT + t * 136 + ck * 8); float o8[8];
#pragma unroll
            for (int jj = 0; jj < 8; ++jj) { const unsigned yw = yv[jj >> 1], gw = gc[k][jj >> 1];
                const float y = (jj & 1) ? __uint_as_float(yw & 0xffff0000u) : __uint_as_float(yw << 16), g = (jj & 1) ? __uint_as_float(gw & 0xffff0000u) : __uint_as_float(gw << 16);
                o8[jj] = y * nw[jj] * siluf_(g); }
            u32x4 w; w.x = pk2(o8[0], o8[1]); w.y = pk2(o8[2], o8[3]); w.z = pk2(o8[4], o8[5]); w.w = pk2(o8[6], o8[7]);
            *(u32x4*)(P.mix + (tok0 + half * 32 + t) * DM + 1024 + h * 128 + ck * 8) = w; }
    }
    __syncthreads();
}

constexpr int S5_BUT = 128 * 20 * 4;
constexpr int S5W_BYTES = S5_BUT + 16 * 136 * 2, S5_FLAG = 8 * S5W_BYTES;
struct S5G { bf16x8 bb[8]; bf16x8 ua[4]; bf16x8 cb[4]; float ar, ai, hr, hi, dsk; };
template <bool PB> __device__ __forceinline__ void s5_load_group(const LayerP& P, int b, int c, size_t tok0, int g, int lane, S5G& G) {
    const int fr = lane & 15, fq = lane >> 4;
    G.ar = P.abar[(g * 64 + lane) * 2]; G.ai = P.abar[(g * 64 + lane) * 2 + 1];
#pragma unroll
    for (int nt = 0; nt < 8; ++nt) G.bb[nt] = *(const bf16x8*)(P.bmp + ((size_t)(g * 128 + nt * 16 + fr)) * 32 + fq * 8);
#pragma unroll
    for (int sb = 0; sb < 4; ++sb) { G.ua[sb] = (bf16x8){0, 0, 0, 0, 0, 0, 0, 0}; if (fq < 2) G.ua[sb] = *(const bf16x8*)(P.proj + (tok0 + sb * 16 + fr) * NP + C_S5U + g * 16 + fq * 8); }
    if (PB) {
#pragma unroll
        for (int ks = 0; ks < 4; ++ks) G.cb[ks] = *(const bf16x8*)(P.cmp + (size_t)(g * 16 + fr) * 128 + ks * 32 + fq * 8);
        const size_t so = ((size_t)(b * 32 + c) * 32 + g) * 128; G.hr = P.s5in[so + lane]; G.hi = P.s5in[so + 64 + lane]; G.dsk = P.s5_d[g * 16 + fr];
    } else { G.hr = 0.f; G.hi = 0.f; G.dsk = 0.f; }
}
template <bool PB> __device__ __forceinline__ void s5_run_group(const LayerP& P, int b, int c, size_t tok0, int g, int lane, const S5G& G, LAS float* BU, LAS bf16_t* Hm) {
    const int fr = lane & 15, fq = lane >> 4;
    float hr = G.hr, hi = G.hi;
#pragma unroll
    for (int sb = 0; sb < 4; ++sb) {
#pragma unroll
        for (int nt = 0; nt < 8; ++nt) { const f32x4 a = __builtin_amdgcn_mfma_f32_16x16x32_bf16(G.ua[sb], G.bb[nt], (f32x4){0.f, 0.f, 0.f, 0.f}, 0, 0, 0);
            *(LAS f32x4*)(BU + (nt * 16 + fr) * 20 + fq * 4) = a; }
        asm volatile("s_waitcnt lgkmcnt(0)" ::: "memory");
        float ur[16], ui[16];
#pragma unroll
        for (int k4 = 0; k4 < 4; ++k4) { const f32x4 vr_ = *(const LAS f32x4*)(BU + lane * 20 + 4 * k4), vi_ = *(const LAS f32x4*)(BU + (64 + lane) * 20 + 4 * k4);
            ur[4 * k4] = vr_.x; ur[4 * k4 + 1] = vr_.y; ur[4 * k4 + 2] = vr_.z; ur[4 * k4 + 3] = vr_.w; ui[4 * k4] = vi_.x; ui[4 * k4 + 1] = vi_.y; ui[4 * k4 + 2] = vi_.z; ui[4 * k4 + 3] = vi_.w; }
#pragma unroll
        for (int t = 0; t < 16; ++t) { const float nr = G.ar * hr - G.ai * hi + ur[t], ni = G.ar * hi + G.ai * hr + ui[t]; hr = nr; hi = ni;
            if (PB) { Hm[t * 136 + lane] = (bf16_t)f2bf(hr); Hm[t * 136 + 64 + lane] = (bf16_t)f2bf(hi); } }
        asm volatile("s_waitcnt lgkmcnt(0)" ::: "memory");
        if (PB) {
            f32x4 acc = (f32x4){0.f, 0.f, 0.f, 0.f};
#pragma unroll
            for (int ks = 0; ks < 4; ++ks) { const bf16x8 af = *(const LAS bf16x8*)(Hm + fr * 136 + ks * 32 + fq * 8); acc = __builtin_amdgcn_mfma_f32_16x16x32_bf16(af, G.cb[ks], acc, 0, 0, 0); }
            if (fq < 2) {
#pragma unroll
                for (int jj = 0; jj < 8; ++jj) BU[fr * 132 + fq * 8 + jj] = bf2f((bf16_t)G.ua[sb][jj]); }
            asm volatile("s_waitcnt lgkmcnt(0)" ::: "memory");
#pragma unroll
            for (int r = 0; r < 4; ++r) { const size_t tok = tok0 + sb * 16 + fq * 4 + r;
                const float y = acc[r] + G.dsk * BU[(fq * 4 + r) * 132 + fr];
                P.yg[tok * 512 + g * 16 + fr] = (bf16_t)f2bf(gelu_tanh(y)); }
            asm volatile("s_waitcnt lgkmcnt(0)" ::: "memory");
        }
    }
    if (!PB) { float* so = P.s5st + ((size_t)(b * 32 + c) * 32 + g) * 128; so[lane] = hr; so[64 + lane] = hi; }
}
template <bool PB> __device__ __forceinline__ void s5_pass(const LayerP& P, LAS unsigned char* lds, int item, int wave, int lane) {
    const int b = item >> 5, c = item & 31; const size_t tok0 = (size_t)b * SEQ + c * 64;
    LAS float* BU = (LAS float*)(lds + wave * S5W_BYTES); LAS bf16_t* Hm = (LAS bf16_t*)(lds + wave * S5W_BYTES + S5_BUT);
    S5G A, B;
    s5_load_group<PB>(P, b, c, tok0, wave * 4 + 0, lane, A);
    s5_load_group<PB>(P, b, c, tok0, wave * 4 + 1, lane, B); s5_run_group<PB>(P, b, c, tok0, wave * 4 + 0, lane, A, BU, Hm);
    s5_load_group<PB>(P, b, c, tok0, wave * 4 + 2, lane, A); s5_run_group<PB>(P, b, c, tok0, wave * 4 + 1, lane, B, BU, Hm);
    s5_load_group<PB>(P, b, c, tok0, wave * 4 + 3, lane, B); s5_run_group<PB>(P, b, c, tok0, wave * 4 + 2, lane, A, BU, Hm);
    s5_run_group<PB>(P, b, c, tok0, wave * 4 + 3, lane, B, BU, Hm);
    if (!PB) job_publish(P.cnt_s5 + 64 * b, wave * 64 + lane);
    else job_publish(P.cnt_s5b + 64 * (b * 8 + (c >> 2)), wave * 64 + lane);
}
__device__ __forceinline__ void s5_passA(const LayerP& P, LAS unsigned char* lds, int item, int wave, int lane) { s5_pass<false>(P, lds, item, wave, lane); }
__device__ __forceinline__ void s5_passB(const LayerP& P, LAS unsigned char* lds, int item, int wave, int lane) { s5_pass<true>(P, lds, item, wave, lane); }

__device__ __forceinline__ void ssd_prefix_job(const LayerP& P, int job, int tid) {
    const int b = job >> 4, h = (job >> 1) & 7, hf = job & 1;
    job_wait(P.cnt_ssd + 64 * b, 32u, tid);
    f32x4 H = (f32x4){0.f, 0.f, 0.f, 0.f};
#pragma unroll 1
    for (int q = 0; q < 2; ++q) {
        f32x4 S[16]; float dec[16];
#pragma unroll
        for (int i = 0; i < 16; ++i) { const int c2 = q * 16 + i; const size_t base = ((size_t)(b * 32 + c2) * 8 + h) * 4096 + hf * 2048;
            S[i] = *(const f32x4*)(P.sst + base + tid * 4); dec[i] = P.cse[(size_t)(b * 32 + c2) * 8 + h]; }
#pragma unroll
        for (int i = 0; i < 16; ++i) { const int c2 = q * 16 + i; const size_t base = ((size_t)(b * 32 + c2) * 8 + h) * 4096 + hf * 2048;
            *(u32x2*)(P.hin + base + tid * 4) = pk4(H); H = H * fexp(dec[i]) + S[i]; }
    }
}
__device__ __forceinline__ void gla_prefix_job(const LayerP& P, int job, int tid) {
    const int b = job >> 4, h = (job >> 2) & 3, eh = (job >> 1) & 1, hf = job & 1;
    job_wait(P.cnt_gla + 64 * b, 32u, tid);
    f32x4 H = (f32x4){0.f, 0.f, 0.f, 0.f};
#pragma unroll 1
    for (int q = 0; q < 4; ++q) {
        f32x4 S[8], dc[8];
#pragma unroll
        for (int i = 0; i < 8; ++i) { const int c2 = q * 8 + i; const size_t base = ((size_t)(b * 32 + c2) * 4 + h) * 8192 + eh * 4096 + hf * 2048;
            S[i] = *(const f32x4*)(P.gst + base + tid * 4); dc[i] = *(const f32x4*)(P.glb + (size_t)(b * 32 + c2) * 256 + h * 64 + (tid & 15) * 4); }
#pragma unroll
        for (int i = 0; i < 8; ++i) { const int c2 = q * 8 + i; const size_t base = ((size_t)(b * 32 + c2) * 4 + h) * 8192 + eh * 4096 + hf * 2048;
            *(u32x2*)(P.gin + base + tid * 4) = pk4(H);
            const f32x4 d = (f32x4){fexp(dc[i].x), fexp(dc[i].y), fexp(dc[i].z), fexp(dc[i].w)}; H = H * d + S[i]; }
    }
}
__device__ __forceinline__ void s5_prefix_job(const LayerP& P, int job, int tid) {
    const int b = job >> 1, g = (job & 1) * 16 + (tid >> 5), n2 = (tid & 31) * 2;
    job_wait(P.cnt_s5 + 64 * b, 32u, tid);
    const f32x4 a = *(const f32x4*)(P.abar64 + (size_t)(g * 64 + n2) * 2);
    const f32x2v ar = (f32x2v){a.x, a.z}, ai = (f32x2v){a.y, a.w};
    f32x2v Hr = (f32x2v){0.f, 0.f}, Hi = Hr;
#pragma unroll 1
    for (int q = 0; q < 2; ++q) {
        f32x2v Sr[16], Si[16];
#pragma unroll
        for (int i = 0; i < 16; ++i) { const size_t o = ((size_t)(b * 32 + q * 16 + i) * 32 + g) * 128 + n2; Sr[i] = *(const f32x2v*)(P.s5st + o); Si[i] = *(const f32x2v*)(P.s5st + o + 64); }
#pragma unroll
        for (int i = 0; i < 16; ++i) { const size_t o = ((size_t)(b * 32 + q * 16 + i) * 32 + g) * 128 + n2;
            *(f32x2v*)(P.s5in + o) = Hr; *(f32x2v*)(P.s5in + o + 64) = Hi;
            const f32x2v nr = ar * Hr - ai * Hi + Sr[i], ni = ar * Hi + ai * Hr + Si[i]; Hr = nr; Hi = ni; }
    }
}

#ifndef PROBE_PHASE
#define PROBE_PHASE -1
#endif
#if PROBE_PHASE >= 0
#define SECT_BEGIN() const unsigned long long sb_ = __builtin_amdgcn_s_memrealtime()
#define SECT_END(k) do { if ((k) == PROBE_PHASE && p == 7) tacc += __builtin_amdgcn_s_memrealtime() - sb_; } while (0)
#else
#define SECT_BEGIN() do { } while (0)
#define SECT_END(k) do { } while (0)
#endif
typedef float f32x16 __attribute__((ext_vector_type(16)));
constexpr int A2_KP = 200, A2_VP = 68, A2_KB = 64 * A2_KP * 2, A2_VB = 128 * A2_VP * 2, A2_BUF = A2_KB + A2_VB, A2_SCR = 2 * A2_BUF;
__device__ __forceinline__ bf16x8 pack8(const f32x16& p, int b) {
    const unsigned a0 = pg8::cvt_pk_bf16(p[b + 0], p[b + 1]), a1 = pg8::cvt_pk_bf16(p[b + 2], p[b + 3]), a2 = pg8::cvt_pk_bf16(p[b + 4], p[b + 5]), a3 = pg8::cvt_pk_bf16(p[b + 6], p[b + 7]);
    const u32x4 w = (u32x4){a0, a1, a2, a3}; return __builtin_bit_cast(bf16x8, w);
}
__device__ __forceinline__ void attn2_unit(const LayerP& P, LAS unsigned char* lds, int unit, int wave, int lane, unsigned long long& tacc) {
    const int bh = unit >> 3, p = unit & 7, grp = wave >> 2, tid = wave * 64 + lane;
    const int qblk = 2 * p + grp, q0 = qblk * 128 + (wave & 3) * 32, ntiles = 4 * p + 4, jd = q0 >> 6;
    const int r32 = lane & 31, hi = lane >> 5;
    const bf16_t* Q = P.qf + (size_t)bh * SEQ * 192; const bf16_t* K = P.kf + (size_t)bh * SEQ * 192; const bf16_t* VT = P.vt + (size_t)bh * 128 * SEQ;
    LAS float* scr = (LAS float*)(lds + A2_SCR) + wave * 32;
    bf16x8 qb[12];
#pragma unroll
    for (int s = 0; s < 12; ++s) qb[s] = *(const bf16x8*)(Q + (size_t)(q0 + r32) * 192 + s * 16 + hi * 8);
    f32x16 o[4];
#pragma unroll
    for (int e = 0; e < 4; ++e)
#pragma unroll
        for (int r = 0; r < 16; ++r) o[e][r] = 0.f;
    float m = -1e30f, l = 0.f;
    u32x4 kr[3], vr[2];
#define A2_LOAD(j, T) do { _Pragma("unroll") for (int i = 0; i < 3; ++i) kr[i] = *(const u32x4*)(K + (size_t)(j) * 64 * 192 + ((T) + 512 * i) * 8); \
        _Pragma("unroll") for (int i = 0; i < 2; ++i) vr[i] = *(const u32x4*)(VT + (size_t)(j) * (128 * 64) + ((T) + 512 * i) * 8); } while (0)
#define A2_STORE(buf, T) do { LAS unsigned char* kb_ = lds + (buf) * A2_BUF; LAS unsigned char* vb_ = kb_ + A2_KB; \
        _Pragma("unroll") for (int i = 0; i < 3; ++i) { const int c_ = (T) + 512 * i; *(LAS u32x4*)(kb_ + ((c_ / 24) * A2_KP + (c_ % 24) * 8) * 2) = kr[i]; } \
        _Pragma("unroll") for (int i = 0; i < 2; ++i) { LAS u32x2* d_ = (LAS u32x2*)(vb_ + ((((T) >> 3) + 64 * i) * A2_VP + ((T) & 7) * 8) * 2); d_[0] = (u32x2){vr[i].x, vr[i].y}; d_[1] = (u32x2){vr[i].z, vr[i].w}; } } while (0)
    A2_LOAD(0, tid); A2_STORE(0, tid);
    if (ntiles > 1) A2_LOAD(1, tid);
    __syncthreads();
    const float SCL = 0.07216878364870322f * 1.4426950408889634f;
#pragma unroll 1
    for (int j = 0; j < ntiles; ++j) {
        int t_ = tid, r_ = r32, h_ = hi; asm volatile("" : "+v"(t_), "+v"(r_), "+v"(h_));
        { SECT_BEGIN(); if (j + 1 < ntiles) { A2_STORE((j + 1) & 1, t_); if (j + 2 < ntiles) A2_LOAD(j + 2, t_); } SECT_END(20); }
        if (j <= jd) {
            const LAS unsigned char* Kb = lds + (j & 1) * A2_BUF; const LAS unsigned char* Vb = Kb + A2_KB;
            f32x16 p0, p1;
#pragma unroll
            for (int r = 0; r < 16; ++r) { p0[r] = 0.f; p1[r] = 0.f; }
            SECT_BEGIN();
            {
                const unsigned ka = (unsigned)(uintptr_t)Kb + (unsigned)((r_ * A2_KP + h_ * 8) * 2);
                bf16x8 kf[12];
#define A2_KRD(dst, s, blk) asm volatile("ds_read_b128 %0, %1 offset:%2" : "=v"(dst) : "v"(ka), "i"((s) * 32 + (blk) * 32 * A2_KP * 2))
#define A2_KGRP(g, base) do { A2_KRD(kf[(base) + 0], 3 * (g) + 0, 0); A2_KRD(kf[(base) + 1], 3 * (g) + 0, 1); A2_KRD(kf[(base) + 2], 3 * (g) + 1, 0); A2_KRD(kf[(base) + 3], 3 * (g) + 1, 1); A2_KRD(kf[(base) + 4], 3 * (g) + 2, 0); A2_KRD(kf[(base) + 5], 3 * (g) + 2, 1); } while (0)
#define A2_KWAIT(n, base) asm volatile("s_waitcnt lgkmcnt(" #n ")" : "+v"(kf[(base) + 0]), "+v"(kf[(base) + 1]), "+v"(kf[(base) + 2]), "+v"(kf[(base) + 3]), "+v"(kf[(base) + 4]), "+v"(kf[(base) + 5]) :: "memory")
#define A2_KMMA(g, base) do { _Pragma("unroll") for (int t = 0; t < 3; ++t) { p0 = __builtin_amdgcn_mfma_f32_32x32x16_bf16(kf[(base) + 2 * t], qb[3 * (g) + t], p0, 0, 0, 0); p1 = __builtin_amdgcn_mfma_f32_32x32x16_bf16(kf[(base) + 2 * t + 1], qb[3 * (g) + t], p1, 0, 0, 0); } } while (0)
                A2_KGRP(0, 0);
                A2_KGRP(1, 6); A2_KWAIT(6, 0); __builtin_amdgcn_sched_barrier(0); A2_KMMA(0, 0); __builtin_amdgcn_sched_barrier(0);
                A2_KGRP(2, 0); A2_KWAIT(6, 6); __builtin_amdgcn_sched_barrier(0); A2_KMMA(1, 6); __builtin_amdgcn_sched_barrier(0);
                A2_KGRP(3, 6); A2_KWAIT(6, 0); __builtin_amdgcn_sched_barrier(0); A2_KMMA(2, 0); __builtin_amdgcn_sched_barrier(0);
                A2_KWAIT(0, 6); __builtin_amdgcn_sched_barrier(0); A2_KMMA(3, 6); __builtin_amdgcn_sched_barrier(0);
#undef A2_KRD
#undef A2_KGRP
#undef A2_KMMA
#undef A2_KWAIT
            }
            SECT_END(21);
#if PROBE_PHASE == 22
            const unsigned long long sb2_ = __builtin_amdgcn_s_memrealtime();
#endif
            if (j == jd) { const int qlim = (q0 & 63) + r_ - 4 * h_;
#pragma unroll
                for (int r = 0; r < 16; ++r) { const int cc = (r & 3) + 8 * (r >> 2);
                    p0[r] = (cc > qlim) ? -1e30f : p0[r]; p1[r] = (cc + 32 > qlim) ? -1e30f : p1[r]; }
            }
            float mx = -1e30f;
#pragma unroll
            for (int r = 0; r < 16; ++r) mx = fmaxf(mx, fmaxf(p0[r], p1[r]));
            { auto rr = __builtin_amdgcn_permlane32_swap(__float_as_uint(mx), __float_as_uint(mx), false, false); mx = fmaxf(__uint_as_float(rr[0]), __uint_as_float(rr[1])); }
            float mn = m, alpha = 1.0f;
            const bool grow = __builtin_amdgcn_ballot_w64(mx * SCL > m + 8.0f) != 0ull;
            if (grow) { mn = fmaxf(m, mx * SCL); alpha = __builtin_amdgcn_exp2f(m - mn); m = mn; }
            float rs = 0.f;
#pragma unroll
            for (int r = 0; r < 16; ++r) { p0[r] = __builtin_amdgcn_exp2f(__builtin_fmaf(p0[r], SCL, -mn)); p1[r] = __builtin_amdgcn_exp2f(__builtin_fmaf(p1[r], SCL, -mn)); rs += p0[r] + p1[r]; }
            l = l * alpha + rs;
            if (grow) {
                if (h_ == 0) scr[r_] = alpha;
                asm volatile("s_waitcnt lgkmcnt(0)" ::: "memory");
                const LAS float* sp = scr + 4 * h_;
#pragma unroll
                for (int r = 0; r < 16; ++r) { const float a = sp[(r & 3) + 8 * (r >> 2)];
#pragma unroll
                    for (int e = 0; e < 4; ++e) o[e][r] *= a; }
            }
#if PROBE_PHASE == 22
            if (p == 7) tacc += __builtin_amdgcn_s_memrealtime() - sb2_;
#endif
#if PROBE_PHASE == 23
            const unsigned long long sb3_ = __builtin_amdgcn_s_memrealtime();
#endif
            {
                const bf16x8 pa0 = pack8(p0, 0), pa1 = pack8(p0, 8), pa2 = pack8(p1, 0), pa3 = pack8(p1, 8);
                const unsigned va = (unsigned)(uintptr_t)Vb + (unsigned)((r_ * A2_VP + 4 * h_) * 2);
                u32x2 vf[2][8];
#define A2_VRD(dst, e, c) asm volatile("ds_read_b64 %0, %1 offset:%2" : "=v"(dst) : "v"(va), "i"(((e) * 32 * A2_VP + (c) * 8) * 2))
#define A2_VGRP(e, b) do { _Pragma("unroll") for (int c = 0; c < 8; ++c) A2_VRD(vf[b][c], e, c); } while (0)
#define A2_VWAIT(n, b) asm volatile("s_waitcnt lgkmcnt(" #n ")" : "+v"(vf[b][0]), "+v"(vf[b][1]), "+v"(vf[b][2]), "+v"(vf[b][3]), "+v"(vf[b][4]), "+v"(vf[b][5]), "+v"(vf[b][6]), "+v"(vf[b][7]) :: "memory")
#define A2_VMMA(e, b) do { \
        o[e] = __builtin_amdgcn_mfma_f32_32x32x16_bf16(pa0, __builtin_bit_cast(bf16x8, ((u32x4){vf[b][0].x, vf[b][0].y, vf[b][1].x, vf[b][1].y})), o[e], 0, 0, 0); \
        o[e] = __builtin_amdgcn_mfma_f32_32x32x16_bf16(pa1, __builtin_bit_cast(bf16x8, ((u32x4){vf[b][2].x, vf[b][2].y, vf[b][3].x, vf[b][3].y})), o[e], 0, 0, 0); \
        o[e] = __builtin_amdgcn_mfma_f32_32x32x16_bf16(pa2, __builtin_bit_cast(bf16x8, ((u32x4){vf[b][4].x, vf[b][4].y, vf[b][5].x, vf[b][5].y})), o[e], 0, 0, 0); \
        o[e] = __builtin_amdgcn_mfma_f32_32x32x16_bf16(pa3, __builtin_bit_cast(bf16x8, ((u32x4){vf[b][6].x, vf[b][6].y, vf[b][7].x, vf[b][7].y})), o[e], 0, 0, 0); } while (0)
                A2_VGRP(0, 0);
                A2_VGRP(1, 1); A2_VWAIT(8, 0); __builtin_amdgcn_sched_barrier(0); A2_VMMA(0, 0); __builtin_amdgcn_sched_barrier(0);
                A2_VGRP(2, 0); A2_VWAIT(8, 1); __builtin_amdgcn_sched_barrier(0); A2_VMMA(1, 1); __builtin_amdgcn_sched_barrier(0);
                A2_VGRP(3, 1); A2_VWAIT(8, 0); __builtin_amdgcn_sched_barrier(0); A2_VMMA(2, 0); __builtin_amdgcn_sched_barrier(0);
                A2_VWAIT(0, 1); __builtin_amdgcn_sched_barrier(0); A2_VMMA(3, 1); __builtin_amdgcn_sched_barrier(0);
#undef A2_VRD
#undef A2_VGRP
#undef A2_VMMA
#undef A2_VWAIT
            }
#if PROBE_PHASE == 23
            if (p == 7) tacc += __builtin_amdgcn_s_memrealtime() - sb3_;
#endif
        }
        { SECT_BEGIN(); __syncthreads(); SECT_END(24); }
    }
    { auto rr = __builtin_amdgcn_permlane32_swap(__float_as_uint(l), __float_as_uint(l), false, false); l = __uint_as_float(rr[0]) + __uint_as_float(rr[1]); }
    int r2 = r32, h2 = hi; asm volatile("" : "+v"(r2), "+v"(h2));
    if (h2 == 0) scr[r2] = 1.0f / l;
    asm volatile("s_waitcnt lgkmcnt(0)" ::: "memory");
    const int b = bh >> 2, h = bh & 3;
    LAS bf16_t* Wt = (LAS bf16_t*)(lds + wave * (32 * 136 * 2));
    { const bf16_t* gbase = P.proj + ((size_t)b * SEQ + q0) * NP + C_MG + h * 128; u32x4 gq[8]; const int ln3 = h2 * 32 + r2;
#pragma unroll
      for (int k = 0; k < 8; ++k) { const int ci = ln3 + 64 * k; gq[k] = *(const u32x4*)(gbase + (size_t)(ci >> 4) * NP + (ci & 15) * 8); }
#pragma unroll
      for (int k = 0; k < 8; ++k) { const int ci = ln3 + 64 * k; *(LAS u32x4*)(Wt + (ci >> 4) * 136 + (ci & 15) * 8) = gq[k]; } }
    asm volatile("s_waitcnt lgkmcnt(0)" ::: "memory");
    const LAS float* sp2 = scr + 4 * h2;
#pragma unroll
    for (int r = 0; r < 16; ++r) { const int qo = (r & 3) + 8 * (r >> 2); const float il = sp2[qo];
#pragma unroll
        for (int e = 0; e < 4; ++e) { LAS bf16_t* cell = Wt + (4 * h2 + qo) * 136 + e * 32 + r2; const float g = bf2f(*cell);
            *cell = (bf16_t)f2bf(o[e][r] * il * siluf_(g)); } }
    asm volatile("s_waitcnt lgkmcnt(0)" ::: "memory");
    { bf16_t* mbase = P.mix + ((size_t)b * SEQ + q0) * DM + 1536 + h * 128; const int ln3 = h2 * 32 + r2;
#pragma unroll
      for (int k = 0; k < 8; ++k) { const int ci = ln3 + 64 * k; *(u32x4*)(mbase + (size_t)(ci >> 4) * DM + (ci & 15) * 8) = *(const LAS u32x4*)(Wt + (ci >> 4) * 136 + (ci & 15) * 8); } }
    __syncthreads();
#undef A2_LOAD
#undef A2_STORE
}

#define XB_TMO      128
#define XB_XCNT(j)  (256  + 64 * (j))
#define XB_XSUB(j)  (1280 + 64 * (j))
#define XB_XGEN(j)  (2304 + 64 * (j))
#define XB_TOP      3328
#define XB_TOPGEN   3392
#define XCD_BAR_WORDS 3456
#define XB_SPIN_CAP (1u << 18)
__device__ __forceinline__ unsigned xb_ld(unsigned* p)              { return __hip_atomic_load(p, __ATOMIC_RELAXED, __HIP_MEMORY_SCOPE_AGENT); }
__device__ __forceinline__ unsigned xb_add(unsigned* p, unsigned v) { return __hip_atomic_fetch_add(p, v, __ATOMIC_RELAXED, __HIP_MEMORY_SCOPE_AGENT); }
__device__ __forceinline__ unsigned xb_xcc_id() { return (unsigned)__builtin_amdgcn_s_getreg((3 << 11) | 20) & 0xFu; }
#define XB_SPIN(cond, bar) do { unsigned _sp = 0; while (cond) { __builtin_amdgcn_s_sleep(1); \
    if ((++_sp & 255u) == 0u) { if (xb_ld(&(bar)[XB_TMO])) break; if (_sp > XB_SPIN_CAP) { atomicAdd(&(bar)[XB_TMO], 1u); break; } } } } while (0)
struct XcdBarrier { unsigned* bar; unsigned x; volatile LAS unsigned* st; };
__device__ __forceinline__ XcdBarrier xcd_barrier_post(unsigned* bar, volatile LAS unsigned* st, bool leader) {
    XcdBarrier b; b.bar = bar; b.x = xb_xcc_id(); b.st = st;
    if (leader) (void)xb_add(&bar[XB_XCNT(b.x)], 1u);
    return b;
}
__device__ __forceinline__ void xcd_barrier_complete(unsigned* bar, unsigned x, unsigned& nloc, unsigned& nx) {
    const unsigned G = gridDim.x * gridDim.y * gridDim.z;
    unsigned sum, cnt, mine, sp = 0u;
    for (;;) {
        sum = 0u; cnt = 0u; mine = 0u;
#pragma unroll
        for (unsigned j = 0; j < 16; ++j) { const unsigned c = xb_ld(&bar[XB_XCNT(j)]); sum += c; cnt += (c > 0u) ? 1u : 0u; mine = (j == x) ? c : mine; }
        if (sum == G) break;
        __builtin_amdgcn_s_sleep(1);
        if ((++sp & 255u) == 0u) { if (xb_ld(&bar[XB_TMO])) break; if (sp > XB_SPIN_CAP) { atomicAdd(&bar[XB_TMO], 1u); break; } }
    }
    nloc = mine > 0u ? mine : 1u; nx = cnt > 0u ? cnt : 1u;
}
__device__ __forceinline__ void xcd_barrier(const XcdBarrier& b, bool leader) {
    asm volatile("s_waitcnt vmcnt(0)" ::: "memory");
    __syncthreads();
    if (leader) {
        unsigned* bar = b.bar;
        __builtin_amdgcn_s_waitcnt(0);
        unsigned nloc = b.st[0], nx = b.st[1];
        if (nloc == 0u) { xcd_barrier_complete(bar, b.x, nloc, nx); b.st[0] = nloc; b.st[1] = nx; }
        const unsigned old = xb_add(&bar[XB_XSUB(b.x)], 1u);
        const unsigned gen = old / nloc;
        if (old + 1u == (gen + 1u) * nloc) {
            __builtin_amdgcn_fence(__ATOMIC_RELEASE, "agent");
            asm volatile("s_waitcnt vmcnt(0)" ::: "memory");
            const unsigned og = xb_add(&bar[XB_TOP], 1u);
            const unsigned tg = og / nx;
            if (og + 1u == (tg + 1u) * nx) xb_add(&bar[XB_TOPGEN], 1u);
            else XB_SPIN(xb_ld(&bar[XB_TOPGEN]) == tg, bar);
            __builtin_amdgcn_fence(__ATOMIC_ACQUIRE, "agent");
            xb_add(&bar[XB_XGEN(b.x)], 1u);
            asm volatile("s_waitcnt vmcnt(0)" ::: "memory");
        } else {
            XB_SPIN(xb_ld(&bar[XB_XGEN(b.x)]) == gen, bar);
            __builtin_amdgcn_fence(__ATOMIC_ACQUIRE, "agent");
            asm volatile("s_waitcnt vmcnt(0)" ::: "memory");
        }
    }
    __syncthreads();
}

constexpr size_t MiB = 1u << 20;
constexpr size_t WS_CTL = 0, CTL_ZERO_BYTES = 262144;
constexpr size_t WS_WIN = 1 * MiB;
constexpr size_t WS_WOUT = WS_WIN + 80 * MiB;
constexpr size_t WS_WUQ = WS_WOUT + 32 * MiB;
constexpr size_t WS_WUKV = WS_WUQ + 3 * MiB;
constexpr size_t WS_WGLU = WS_WUKV + 1 * MiB;
constexpr size_t WS_ABAR = WS_WGLU + 2 * MiB;
constexpr size_t WS_BBAR = WS_ABAR + 1 * MiB;
constexpr size_t WS_HB = WS_BBAR + 2 * MiB;
constexpr size_t WS_RSTD = WS_HB + 32 * MiB;
constexpr size_t WS_PROJ = WS_RSTD + 1 * MiB;
constexpr size_t WS_DTF = WS_PROJ + 80 * MiB;
constexpr size_t WS_DTV = WS_DTF + 1 * MiB;
constexpr size_t WS_XBCC = WS_DTV + 1 * MiB;
constexpr size_t WS_YS = WS_XBCC + 24 * MiB;
constexpr size_t WS_MIX = WS_YS + 16 * MiB;
constexpr size_t WS_HS = WS_MIX + 32 * MiB;
constexpr size_t WS_YG = WS_HS + 128 * MiB;
constexpr size_t WS_EG = WS_YG + 8 * MiB;
constexpr size_t WS_OG = WS_EG + 8 * MiB;
constexpr size_t WS_QRAW = WS_OG + 16 * MiB;
constexpr size_t WS_KVRAW = WS_QRAW + 12 * MiB;
constexpr size_t WS_QF = WS_KVRAW + 16 * MiB;
constexpr size_t WS_KF = WS_QF + 12 * MiB;
constexpr size_t WS_VF = WS_KF + 12 * MiB;
constexpr size_t WS_SST = WS_VF + 8 * MiB;
constexpr size_t WS_HIN = WS_SST + 16 * MiB;
constexpr size_t WS_GST = WS_HIN + 8 * MiB;
constexpr size_t WS_GIN = WS_GST + 16 * MiB;
constexpr size_t WS_END = WS_GIN + 8 * MiB;
constexpr int CW_GLA = 10240, CW_S5 = 12288, CW_MLA = 16384, CW_Q = 24576, CW_S5B = 32768;
constexpr int CW_SSD = 8192;
constexpr int CW_BAR = 1024;

#ifndef PROBE_PHASE
#define PROBE_PHASE -1
#endif
#define PROBE_AMP 4
#ifndef GLU_SPLIT
#define GLU_SPLIT 0
#endif
#define GLU_Q_END (GLU_SPLIT ? 512 : 576)
#ifndef RACE_SCREEN
#define RACE_SCREEN 0
#endif
#ifndef PROBE_BLOCK
#define PROBE_BLOCK 0
#endif
#ifndef REP_D1
#define REP_D1 1
#endif
#ifndef REP_D2
#define REP_D2 1
#endif
#ifndef REP_D3
#define REP_D3 1
#endif
#ifndef REP_D4
#define REP_D4 1
#endif
#ifndef REP_F
#define REP_F 1
#endif
#ifndef REP_P
#define REP_P 1
#endif
#ifndef REP_A
#define REP_A 1
#endif
#ifndef REP_B
#define REP_B 1
#endif
#ifndef REP_C
#define REP_C 1
#endif
#ifndef REP_D
#define REP_D 1
#endif
#ifndef REP_E
#define REP_E 1
#endif
#ifndef REP_BAR
#define REP_BAR 1
#endif
constexpr int WT_PER_LAYER = 640 + 256 + 18 + 8 + 16;
struct MegaArgs { const float* in[30]; float* out; unsigned char* ws; };
constexpr int LDS_TAB = pg8::STAGE_BYTES + 64, LDS_XS = LDS_TAB + 256, LDS_TS = LDS_XS + 4096, LDS_TOTAL = LDS_TS + 64;

__global__ void __launch_bounds__(512, 2) mega_fwd(MegaArgs a) {
    __shared__ __attribute__((aligned(16))) unsigned char lds_raw[LDS_TOTAL];
    LAS unsigned char* lds = (LAS unsigned char*)lds_raw;
    const int wave_s = __builtin_amdgcn_readfirstlane((int)threadIdx.x >> 6);
    const int G = (int)gridDim.x, ngw = G * 8; const size_t gth = (size_t)G * 512;
#define IDS() int lane_ = lane_id(), wave_ = wave_s, bid_ = blockIdx.x; asm volatile("" : "+v"(lane_), "+s"(wave_), "+s"(bid_)); const int lane = lane_, wave = __builtin_amdgcn_readfirstlane(wave_), tid_ = wave * 64 + lane_, gw = __builtin_amdgcn_readfirstlane(bid_) * 8 + wave; (void)tid_; const size_t gtid = (size_t)bid_ * 512 + tid_; (void)lane; (void)gw; (void)gtid;
    volatile LAS unsigned* st = (volatile LAS unsigned*)(lds + pg8::STAGE_BYTES);
    { const int tid = wave_s * 64 + lane_id(); if (tid < 16) st[tid] = 0u; }
    __syncthreads();
    LAS unsigned long long* tab = (LAS unsigned long long*)(lds + LDS_TAB);
    { const int tid = wave_s * 64 + lane_id();
      if (tid < 30) tab[tid] = (unsigned long long)a.in[tid];
      if (tid == 30) tab[30] = (unsigned long long)a.out;
      if (tid == 31) tab[31] = (unsigned long long)a.ws; }
    __syncthreads();
#define TABP(i) ((const float*)uptr_(tab[i]))
#define WSP() ((unsigned char*)uptr_(tab[31]))
#define OUTP() ((float*)uptr_(tab[30]))
#if PROBE_PHASE >= 0
    unsigned long long t_last = __builtin_amdgcn_s_memrealtime();
#endif
    unsigned long long t_acc = 0ull;
    (void)xcd_barrier_post((unsigned*)(WSP() + WS_CTL) + CW_BAR, st, wave_s == 0 && lane_id() == 0);
#define GRID_BAR() do { XcdBarrier b2_; b2_.bar = (unsigned*)(WSP() + WS_CTL) + CW_BAR; b2_.x = xb_xcc_id(); b2_.st = st; int w_ = wave_s; asm volatile("" : "+s"(w_)); xcd_barrier(b2_, (w_ * 64 + lane_id()) == 0); } while (0)
#define FIN(i) TABP(i)
#if PROBE_PHASE >= 0
#define STAMP(k) do { const unsigned long long now_ = __builtin_amdgcn_s_memrealtime(); if ((k) == PROBE_PHASE) t_acc += now_ - t_last; t_last = now_; } while (0)
#else
#define STAMP(k) do { } while (0)
#endif
    for (int rep = 0; rep < REP_P; ++rep) {
        unsigned char* ws = WSP();
        bf16_t* win = (bf16_t*)(ws + WS_WIN); bf16_t* wout = (bf16_t*)(ws + WS_WOUT); bf16_t* wuq = (bf16_t*)(ws + WS_WUQ); bf16_t* wukv = (bf16_t*)(ws + WS_WUKV); bf16_t* wglu = (bf16_t*)(ws + WS_WGLU);
        float* abar = (float*)(ws + WS_ABAR); float* bbar = (float*)(ws + WS_BBAR);
        constexpr int T0 = 20 * 32 * 4, T1 = 8 * 32 * 4, T2 = 3 * 6 * 4, T3 = 4 * 2 * 4, T4 = 2 * 8 * 4, TT = T0 + T1 + T2 + T3 + T4;
        IDS();
#define WT_TILE(L_, r_in) do { int r = (r_in); const float* s = nullptr; const float* sc = nullptr; bf16_t* d = nullptr; int K = 0, Nsrc = 0, Ndst = 0, mode = 0, tn = 1; \
            if (r < 640) { s = FIN(3); sc = FIN(2); d = (bf16_t*)(ws + WS_WIN); K = DM; Nsrc = D_IN; Ndst = NP; mode = 1; tn = 20; } \
            else if ((r -= 640) < 256) { s = FIN(4); d = (bf16_t*)(ws + WS_WOUT); K = DM; Nsrc = DM; Ndst = DM; tn = 8; } \
            else if ((r -= 256) < 18) { s = FIN(25); sc = FIN(24); d = (bf16_t*)(ws + WS_WUQ); K = 384; Nsrc = 768; Ndst = 768; tn = 3; } \
            else if ((r -= 18) < 8) { s = FIN(27); sc = FIN(26); d = (bf16_t*)(ws + WS_WUKV); K = 128; Nsrc = 1024; Ndst = 1024; tn = 4; } \
            else { r -= 8; s = FIN(19); d = (bf16_t*)(ws + WS_WGLU); K = 512; Nsrc = 512; Ndst = 512; tn = 2; } \
            const int n0 = (r % tn) * 256, k0 = (r / tn) * 64; \
            wtrans_tile(s + (size_t)(L_) * K * Nsrc, Nsrc, sc ? sc + (size_t)(L_) * K : nullptr, mode, d + (size_t)(L_) * Ndst * K, K, n0, k0, lds, tid_); } while (0)
        (void)TT; (void)win; (void)wout; (void)wuq; (void)wukv; (void)wglu;
        for (int it = bid_; it < WT_PER_LAYER - 256; it += G) WT_TILE(0, it < 640 ? it : it + 256);
        for (size_t g_ = gtid; g_ < (size_t)(DEPTH * 32 * 64) * 16; g_ += gth) s5prep_lane((int)(g_ >> 4), (int)(g_ & 15), FIN(11), FIN(12), FIN(13), FIN(14), FIN(15), abar, bbar, (float*)(ws + WS_ABAR + 512 * 1024), (bf16_t*)(ws + WS_BBAR + 1 * MiB));
        for (size_t e = gtid; e < (size_t)DEPTH * 32 * 16 * 128; e += gth) { const size_t gi_ = e >> 7; const int np = (int)(e & 127);
            const float v = (np < 64) ? FIN(16)[gi_ * 64 + np] : -FIN(17)[gi_ * 64 + np - 64]; ((bf16_t*)(ws + WS_DTF + 512 * 1024))[e] = (bf16_t)f2bf(v); }
    }

#define MAKE_P() LayerP P; { unsigned char* ws = WSP(); \
        P.conv_w = FIN(5) + (size_t)lq * 4 * 768; P.conv_b = FIN(6) + (size_t)lq * 768; P.dt_bias = FIN(7) + lq * 8; P.a_log = FIN(8) + lq * 8; P.ssd_d = FIN(9) + lq * 8; P.ssd_norm_w = FIN(10) + lq * 512; \
        P.s5_c_re = FIN(16) + (size_t)lq * 32 * 16 * 64; P.s5_c_im = FIN(17) + (size_t)lq * 32 * 16 * 64; P.s5_d = FIN(18) + lq * 512; P.abar = (float*)(ws + WS_ABAR) + (size_t)lq * 32 * 64 * 2; P.bbar = (float*)(ws + WS_BBAR) + (size_t)lq * 32 * 64 * 32; \
        P.gla_w2 = FIN(21) + (size_t)lq * 16 * 256; P.gla_gb = FIN(22) + lq * 256; P.gla_norm_w = FIN(23) + lq * 128; \
        P.qh_w = FIN(28) + lq * 192; P.kh_w = FIN(29) + lq * 192; P.pos = (const int*)FIN(1); \
        P.proj = (bf16_t*)(ws + WS_PROJ); P.dtf = (float*)(ws + WS_DTF); \
        P.xbcc = (float*)(ws + WS_XBCC); P.dtv = (float*)(ws + WS_DTV); P.ys = (float*)(ws + WS_YS); P.hs = (float*)(ws + WS_HS); P.eg = (float*)(ws + WS_EG); P.og = (float*)(ws + WS_OG); \
        P.yg = (bf16_t*)(ws + WS_YG); P.mix = (bf16_t*)(ws + WS_MIX); P.qraw = (bf16_t*)(ws + WS_QRAW); P.kvraw = (bf16_t*)(ws + WS_KVRAW); \
        P.qf = (bf16_t*)(ws + WS_QF); P.kf = (bf16_t*)(ws + WS_KF); P.vf = (bf16_t*)(ws + WS_VF); P.vt = (bf16_t*)(ws + WS_VF); \
        P.xbcn = (bf16_t*)(ws + WS_XBCC); P.xT = (bf16_t*)(ws + WS_YS); P.hin = (bf16_t*)(ws + WS_HIN); P.csv = (float*)(ws + WS_DTV + 512 * 1024); P.cse = (float*)(ws + WS_DTV + 768 * 1024); P.sst = (float*)(ws + WS_SST); \
        P.cnt_ssd = (unsigned*)(ws + WS_CTL) + CW_SSD + lq * 8 * 64; \
        P.qt = (bf16_t*)(ws + WS_EG); P.kt = (bf16_t*)(ws + WS_EG + 4 * MiB); P.vT2 = (bf16_t*)(ws + WS_OG); P.glb = (float*)(ws + WS_OG + 8 * MiB); P.gst = (float*)(ws + WS_GST); P.gin = (bf16_t*)(ws + WS_GIN); \
        P.cnt_gla = (unsigned*)(ws + WS_CTL) + CW_GLA + lq * 8 * 64; P.cnt_mla = (unsigned*)(ws + WS_CTL) + CW_MLA + lq * 32 * 64; \
        P.abar64 = (const float*)(ws + WS_ABAR + 512 * 1024) + (size_t)lq * 32 * 64 * 2; P.bmp = (const bf16_t*)(ws + WS_BBAR + 1 * MiB) + (size_t)lq * 32 * 128 * 32; P.cmp = (const bf16_t*)(ws + WS_DTF + 512 * 1024) + (size_t)lq * 32 * 16 * 128; P.cnt_s5b = (unsigned*)(ws + WS_CTL) + CW_S5B + lq * 32 * 64; P.s5st = (float*)(ws + WS_HS); P.s5in = (float*)(ws + WS_HS + 4 * MiB); P.cnt_s5 = (unsigned*)(ws + WS_CTL) + CW_S5 + lq * 8 * 64; }
#define RUN_GEMM(EPI, gA, gBt, gN, gK, glda, gldb, ESET) do { pg8::Gemm g; g.A = (gA); g.Bt = (gBt); g.M = TOK; g.N = (gN); g.K = (gK); g.lda = (glda); g.ldb = (gldb); g.pad = 0; \
        pg8::EPI E; ESET; int bid_ = blockIdx.x; asm volatile("" : "+s"(bid_)); pg8::StaticOrder S; S.init(g.M, g.N, G, bid_); pg8::gemm_phase<pg8::EPI, pg8::StaticOrder, true>(lds, g, S, E, wave_s); } while (0)

#define HBUF_IN(q) FIN(0)
#define HBUF_OUT(q) OUTP()
#define LQ() int lq = l; asm volatile("" : "+s"(lq))
#pragma clang loop unroll(disable)
    for (int l = 0; l < DEPTH; ++l) {
        if (l == 0)
        { LQ(); IDS(); unsigned char* ws = WSP(); const float* hin = HBUF_IN(lq);
          k_rowprep(hin, (bf16_t*)(ws + WS_HB), (float*)(ws + WS_RSTD), lane, gw, ngw); }
        if (l == 0) { GRID_BAR(); STAMP(0); }
        { LQ(); unsigned char* ws = WSP();
          pg8::Gemm g; g.A = (const bf16_t*)(ws + WS_HB); g.Bt = (const bf16_t*)(ws + WS_WIN) + (size_t)lq * NP * DM; g.M = TOK; g.N = NP; g.K = DM; g.lda = DM; g.ldb = DM; g.pad = 0;
          pg8::EpiP1 E; E.O = (bf16_t*)(ws + WS_PROJ); E.rstd = (const float*)(ws + WS_RSTD); E.dtf = (float*)(ws + WS_DTF);
          int bid_ = blockIdx.x; asm volatile("" : "+s"(bid_)); pg8::P1Order S; S.G = G; S.c = bid_; S.nunits = (640 / G >= 2) ? 2 * G : 640;
          pg8::gemm_phase<pg8::EpiP1, pg8::P1Order, true>(lds, g, S, E, wave_s); }
        GRID_BAR(); STAMP(1);
        { LQ(); unsigned char* ws = WSP(); unsigned* qh = (unsigned*)(ws + WS_CTL) + CW_Q + (lq * 2 + 0) * 64;
          const int nb1 = 640, nleft = 0;
          { IDS(); const int L = ((640 / G >= 2) ? 2 * G : 640) + bid_;
            if (L < 640) {
                pg8::Gemm g; g.A = (const bf16_t*)(ws + WS_HB); g.Bt = (const bf16_t*)(ws + WS_WIN) + (size_t)lq * NP * DM; g.M = TOK; g.N = NP; g.K = DM; g.lda = DM; g.ldb = DM; g.pad = 0;
                pg8::EpiP1 E; E.O = (bf16_t*)(ws + WS_PROJ); E.rstd = (const float*)(ws + WS_RSTD); E.dtf = (float*)(ws + WS_DTF);
                pg8::OneUnit S; S.pm = L & 31; S.pn = pg8::p1_tile(L >> 5);
                pg8::gemm_phase<pg8::EpiP1, pg8::OneUnit, true>(lds, g, S, E, wave); } }
          for (;;) { IDS(); int ix = queue_pop(qh, st + 4, tid_); if (ix >= ((lq == 0) ? 1128 : 1000) + nleft) break; MAKE_P(); { for (int o_ = LDS_TS + tid_ * 16; o_ < LDS_TS + 64; o_ += 8192) *(LAS u32x4*)(lds + o_) = (u32x4){0u, 0u, 0u, 0u}; __syncthreads(); }
            if (RACE_SCREEN && ((bid_ * 7 + ix) % 5 == 0)) { for (int z_ = 0; z_ < 40; ++z_) __builtin_amdgcn_s_sleep(127); }
            if (ix < nleft) { const int L = nb1 + ix;
                pg8::Gemm g; g.A = (const bf16_t*)(ws + WS_HB); g.Bt = (const bf16_t*)(ws + WS_WIN) + (size_t)lq * NP * DM; g.M = TOK; g.N = NP; g.K = DM; g.lda = DM; g.ldb = DM; g.pad = 0;
                pg8::EpiP1 E; E.O = (bf16_t*)(ws + WS_PROJ); E.rstd = (const float*)(ws + WS_RSTD); E.dtf = (float*)(ws + WS_DTF);
                pg8::OneUnit S; S.pm = L & 31; S.pn = pg8::p1_tile(L >> 5);
                pg8::gemm_phase<pg8::EpiP1, pg8::OneUnit, true>(lds, g, S, E, wave); continue; }
            ix -= nleft;
            if (ix < 128) gla_passA(P, lds, ix, wave, lane);
            else if (ix < 256) ssd_passA(P, lds, ix - 128, wave, lane);
            else if (ix < 352) { const int un = ix - 256;
                pg8::Gemm g; g.M = TOK; g.pad = 0; g.lda = NP; g.A = (const bf16_t*)(ws + WS_PROJ) + C_CQ; g.Bt = (const bf16_t*)(ws + WS_WUQ) + (size_t)lq * 768 * 384; g.N = 768; g.K = 384; g.ldb = 384;
                pg8::EpiBf16Sig E; E.O = (bf16_t*)(ws + WS_QRAW); E.cnt = P.cnt_mla; E.ldc = 768; E.pad = 0;
                pg8::OneUnit S; S.pm = un / 3; S.pn = un % 3;
                pg8::gemm_phase<pg8::EpiBf16Sig, pg8::OneUnit, true>(lds, g, S, E, wave); }
            else if (ix < 480) { const int un = ix - 352;
                pg8::Gemm g; g.M = TOK; g.pad = 0; g.lda = NP; g.A = (const bf16_t*)(ws + WS_PROJ) + C_CKV; g.Bt = (const bf16_t*)(ws + WS_WUKV) + (size_t)lq * 1024 * 128; g.N = 1024; g.K = 128; g.ldb = 128;
                pg8::EpiBf16Sig E; E.O = (bf16_t*)(ws + WS_KVRAW); E.cnt = P.cnt_mla; E.ldc = 1024; E.pad = 0;
                pg8::OneUnit S; S.pm = un >> 2; S.pn = un & 3;
                pg8::gemm_phase<pg8::EpiBf16Sig, pg8::OneUnit, true>(lds, g, S, E, wave); }
            else if (ix < 608) s5_passA(P, lds, ix - 480, wave, lane);
            else if (ix >= 1000) { const int r0_ = 640 + (ix - 1000) * 2; WT_TILE(lq, r0_); WT_TILE(lq, r0_ + 1); }
            else if (ix >= 864) { const int jb = ix - 864; if (jb < 64) ssd_prefix_job(P, jb, tid_); else if (jb < 128) gla_prefix_job(P, jb - 64, tid_); else s5_prefix_job(P, jb - 128, tid_); }
            else { const int sl = ix - 608; job_wait(P.cnt_mla + 64 * (sl >> 3), 7u, tid_); mla_fin4(P, lds, lane, wave, sl * 32); }
 } }
        STAMP(13);
        GRID_BAR(); STAMP(2);
        { LQ(); unsigned char* ws = WSP(); unsigned* qh = (unsigned*)(ws + WS_CTL) + CW_Q + (lq * 2 + 1) * 64;
          const int qend_ = GLU_Q_END + ((lq + 1 < DEPTH) ? WT_PER_LAYER / 2 : 0);
          for (;;) { IDS(); const int ix = queue_pop(qh, st + 4, tid_); if (ix >= qend_) break; MAKE_P(); { for (int o_ = LDS_TS + tid_ * 16; o_ < LDS_TS + 64; o_ += 8192) *(LAS u32x4*)(lds + o_) = (u32x4){0u, 0u, 0u, 0u}; __syncthreads(); }
            if (RACE_SCREEN && ((bid_ * 3 + ix) % 7 == 0)) { for (int z_ = 0; z_ < 40; ++z_) __builtin_amdgcn_s_sleep(127); }
            if (ix < 128) attn2_unit(P, lds, (ix & 15) * 8 + (7 - (ix >> 4)), wave, lane, t_acc);
            else if (ix < 256) s5_passB(P, lds, ix - 128, wave, lane);
            else if (ix < 384) gla_passB(P, lds, ix - 256, wave, lane);
            else if (ix < 512) ssd_passB(P, lds, ix - 384, wave, lane);
            else if (ix >= GLU_Q_END) { const int r0_ = (ix - GLU_Q_END) * 2;
                WT_TILE(lq + 1, r0_); WT_TILE(lq + 1, r0_ + 1); }
            else { const int un = ix - 512, pm = un >> 1;
                job_wait(P.cnt_s5b + 64 * pm, 4u, tid_);
                pg8::Gemm g; g.M = TOK; g.pad = 0; g.A = (const bf16_t*)(ws + WS_YG); g.Bt = (const bf16_t*)(ws + WS_WGLU) + (size_t)lq * 512 * 512; g.N = 512; g.K = 512; g.lda = 512; g.ldb = 512;
                pg8::EpiGlu E; E.yg = (const bf16_t*)(ws + WS_YG); E.proj = (const bf16_t*)(ws + WS_PROJ); E.bias = FIN(20) + lq * 512; E.mix = (bf16_t*)(ws + WS_MIX);
                pg8::OneUnit S; S.pm = pm; S.pn = un & 1;
                pg8::gemm_phase<pg8::EpiGlu, pg8::OneUnit, true>(lds, g, S, E, wave); } } }
        STAMP(10);
        GRID_BAR(); STAMP(3);
#if GLU_SPLIT
        { LQ(); unsigned char* ws = WSP();
          RUN_GEMM(EpiGlu, (const bf16_t*)(ws + WS_YG), (const bf16_t*)(ws + WS_WGLU) + (size_t)lq * 512 * 512, 512, 512, 512, 512,
                   (E.yg = (const bf16_t*)(ws + WS_YG), E.proj = (const bf16_t*)(ws + WS_PROJ), E.bias = FIN(20) + lq * 512, E.mix = (bf16_t*)(ws + WS_MIX))); }
        GRID_BAR();
#endif
        { LQ(); unsigned char* ws = WSP(); const float* hin = HBUF_IN(lq);
          RUN_GEMM(EpiRes3, (const bf16_t*)(ws + WS_MIX), (const bf16_t*)(ws + WS_WOUT) + (size_t)lq * DM * DM, DM, DM, DM, DM, (E.base = hin, E.mode = (lq == 0) ? 0 : (lq == DEPTH - 1) ? 2 : 1, E.out = HBUF_OUT(lq), E.hb = (bf16_t*)(ws + WS_HB), E.rsq = (float*)(ws + WS_RSTD), E.xs = (LAS float*)(lds + LDS_XS))); }
        if (l + 1 < DEPTH) GRID_BAR();
        STAMP(5);
    }
#if PROBE_PHASE >= 0
    if ((blockIdx.x == PROBE_BLOCK || PROBE_PHASE >= 20) && wave_s == (PROBE_PHASE >= 20 ? 4 : 0)) { const unsigned long long t_end = __builtin_amdgcn_s_memrealtime() + PROBE_AMP * t_acc; while (__builtin_amdgcn_s_memrealtime() < t_end) __builtin_amdgcn_s_sleep(8); }
#endif
}

extern "C" void kernel_launch(void* const* d_in, const int* in_sizes, int n_in, void* d_out, int out_size, void* d_ws, size_t ws_size, hipStream_t stream) {
    static int grid = 0;
    if (grid == 0) {
        if (n_in != 30 || out_size != TOK * DM || ws_size < WS_END) { fprintf(stderr, "kernel_launch: unexpected shapes (n_in %d out %d ws %zu need %zu)\n", n_in, out_size, ws_size, (size_t)WS_END); grid = -1; return; }
        int dev = 0, cus = 0;
        if (hipGetDevice(&dev) != hipSuccess || hipDeviceGetAttribute(&cus, hipDeviceAttributeMultiprocessorCount, dev) != hipSuccess || cus <= 0) { fprintf(stderr, "kernel_launch: device query failed\n"); grid = -1; return; }
        grid = cus;
    }
    if (grid < 0) return;
    (void)hipMemsetAsync((char*)d_ws + WS_CTL, 0, CTL_ZERO_BYTES, stream);
    MegaArgs a{};
    for (int i = 0; i < 30; ++i) a.in[i] = (const float*)d_in[i];
    a.out = (float*)d_out; a.ws = (unsigned char*)d_ws;
    hipLaunchKernelGGL(mega_fwd, dim3(grid), dim3(512), 0, stream, a);
}
```
